# Optimizing an MI355X kernel written in HIP

```python
import math
import jax, jax.numpy as jnp
from jax import lax
import numpy as np

D_MODEL = 2048
BATCH = 2
SEQ = 4096
DEPTH = 1
DEC_BATCH = 4
DEC_SEQ = 4096
PAST_LEN = 128

RWKV_HEADS = 16
RWKV_HEAD_DIM = 64
RWKV_DIM = RWKV_HEADS * RWKV_HEAD_DIM
DECAY_LORA = 64
ICLR_LORA = 64
GATE_LORA = 128
S5_GROUPS = 32
S5_GROUP_CH = 16
S5_DIM = S5_GROUPS * S5_GROUP_CH
S5_STATE = 64
DT_MIN = 1e-3
DT_MAX = 1e-1
N_BRANCH = 2
D_FF = 5504
RMS_EPS = 1e-6
GN_EPS = 64e-5
R_OFF = 0
K_OFF = RWKV_DIM
V_OFF = 2 * RWKV_DIM
WLOW_OFF = 3 * RWKV_DIM
ALOW_OFF = WLOW_OFF + 2 * DECAY_LORA
GLOW_OFF = ALOW_OFF + 2 * ICLR_LORA
SHIFT_COLS = GLOW_OFF + GATE_LORA
U_OFF = SHIFT_COLS
GATE_OFF = U_OFF + S5_DIM
IN_COLS = GATE_OFF + N_BRANCH * D_MODEL

kernel_name = 'hybrid_rwkv7_s5_macaron_encoder'


def _rmsnorm(x, g):
    xf = x.astype(jnp.float32)
    y = xf * lax.rsqrt(jnp.mean(xf * xf, -1, keepdims=True) + RMS_EPS)
    return (y * g.astype(jnp.float32)).astype(x.dtype)


def _swiglu(x, w_gate, w_up, w_down):
    return (jax.nn.silu(x @ w_gate) * (x @ w_up)) @ w_down


def _centred_shift(p, mu):
    prev = jnp.pad(p[:, :-1], ((0, 0), (1, 0), (0, 0)))
    nxt = jnp.pad(p[:, 1:], ((0, 0), (0, 1), (0, 0)))
    return p + (0.5 * (prev + nxt) - p) * mu


def _rwkv_step(S, inp):
    r, w, k, v, kk, b = inp
    sa = jnp.einsum('bhvk,bhk->bhv', S, -kk)
    S = S * w[:, :, None, :] + sa[..., None] * b[:, :, None, :] + v[..., None] * k[:, :, None, :]
    y = jnp.einsum('bhvk,bhk->bhv', S, r)
    return S, y


def _rwkv_mixer(p, w0, w2, a0, a2, g2, k_k, k_a, r_k, ln_w, ln_b):
    Bsz, L = p.shape[0], p.shape[1]
    H, N = RWKV_HEADS, RWKV_HEAD_DIM
    pf = p.astype(jnp.float32)
    r = pf[..., R_OFF:K_OFF].reshape(Bsz, L, H, N)
    k = pf[..., K_OFF:V_OFF].reshape(Bsz, L, H, N)
    v = pf[..., V_OFF:WLOW_OFF].reshape(Bsz, L, H, N)
    wlow = jnp.tanh(pf[..., WLOW_OFF:ALOW_OFF]).reshape(Bsz, L, 2, DECAY_LORA)
    alow = pf[..., ALOW_OFF:GLOW_OFF].reshape(Bsz, L, 2, ICLR_LORA)
    glow = pf[..., GLOW_OFF:SHIFT_COLS]
    wpre = jnp.einsum('bldr,drc->dblc', wlow, w2) + w0[:, None, None, :]
    decay = jnp.exp(-jnp.exp(-jax.nn.softplus(-wpre) - 0.5)).reshape(2, Bsz, L, H, N)
    a = jax.nn.sigmoid(jnp.einsum('bldr,drc->dblc', alow, a2) + a0[:, None, None, :]).reshape(2, Bsz, L, H, N)
    kk = k * k_k.reshape(H, N)
    kk = kk * lax.rsqrt(jnp.sum(kk * kk, -1, keepdims=True) + 1e-12)
    k_dir = k[None] * (1.0 + (a - 1.0) * k_a.reshape(H, N))
    b_dir = kk[None] * a

    def both(t):
        return jnp.swapaxes(jnp.concatenate([t, jnp.flip(t, 1)], 0), 0, 1)

    def per_dir(t):
        return jnp.swapaxes(jnp.concatenate([t[0], jnp.flip(t[1], 1)], 0), 0, 1)

    xs = (both(r), per_dir(decay), per_dir(k_dir), both(v), both(kk), per_dir(b_dir))
    s0 = jnp.zeros((2 * Bsz, H, N, N), jnp.float32)
    _, ys = lax.scan(_rwkv_step, s0, xs)
    ys = jnp.swapaxes(ys, 0, 1)
    y = ys[:Bsz] + jnp.flip(ys[Bsz:], 1)
    mean = jnp.mean(y, -1, keepdims=True)
    var = jnp.mean(jnp.square(y - mean), -1, keepdims=True)
    y = (y - mean) * lax.rsqrt(var + GN_EPS) * ln_w.reshape(H, N) + ln_b.reshape(H, N)
    bonus = jnp.sum(r * (k_dir[0] + k_dir[1]) * r_k.reshape(H, N), -1, keepdims=True) * v
    y = (y + bonus).reshape(Bsz, L, RWKV_DIM)
    g = jax.nn.sigmoid(glow) @ g2
    return y * g


def _s5_combine(e1, e2):
    a1, b1 = e1
    a2, b2 = e2
    return a2 * a1, a2 * b1 + b2


def _s5_direction(ug, a_re, a_im, log_step, b_re, b_im):
    lam = lax.complex(a_re.astype(jnp.float32), a_im.astype(jnp.float32))
    dt = jnp.exp(log_step.astype(jnp.float32))[:, None]
    lam_bar = jnp.exp(lam * dt)
    b_bar = ((lam_bar - 1.0) / lam)[..., None] * lax.complex(b_re.astype(jnp.float32), b_im.astype(jnp.float32))
    bu = lax.complex(jnp.einsum('blgc,gpc->blgp', ug, jnp.real(b_bar)),
                     jnp.einsum('blgc,gpc->blgp', ug, jnp.imag(b_bar)))
    lam_seq = jnp.broadcast_to(lam_bar, bu.shape)
    _, states = lax.associative_scan(_s5_combine, (lam_seq, bu), axis=1)
    return states


def _s5_mixer(u, a_re, a_im, log_step, b_re, b_im, c_re, c_im, d_skip, w_glu, b_glu):
    Bsz, L = u.shape[0], u.shape[1]
    uf = u.astype(jnp.float32)
    ug = uf.reshape(Bsz, L, S5_GROUPS, S5_GROUP_CH)
    s_fwd = _s5_direction(ug, a_re[0], a_im[0], log_step[0], b_re[0], b_im[0])
    s_bwd = jnp.flip(_s5_direction(jnp.flip(ug, 1), a_re[1], a_im[1], log_step[1], b_re[1], b_im[1]), 1)
    st = s_fwd + s_bwd
    y = (jnp.einsum('blgp,gcp->blgc', jnp.real(st), c_re)
         - jnp.einsum('blgp,gcp->blgc', jnp.imag(st), c_im))
    y = y.reshape(Bsz, L, S5_DIM) + d_skip * uf
    y = jax.nn.gelu(y)
    return y * jax.nn.sigmoid(y @ w_glu + b_glu)


def _layer(x, norm_ffn1, ffn1_w_gate, ffn1_w_up, ffn1_w_down, norm_mix, w_in, shift_mu,
           rwkv_w0, rwkv_w2, rwkv_a0, rwkv_a2, rwkv_g2, rwkv_k_k, rwkv_k_a, rwkv_r_k,
           rwkv_ln_w, rwkv_ln_b, s5_a_re, s5_a_im, s5_log_step, s5_b_re, s5_b_im,
           s5_c_re, s5_c_im, s5_d, s5_w_glu, s5_b_glu, proj_rwkv, proj_s5, w_out,
           norm_ffn2, ffn2_w_gate, ffn2_w_up, ffn2_w_down):
    x = x + 0.5 * _swiglu(_rmsnorm(x, norm_ffn1), ffn1_w_gate, ffn1_w_up, ffn1_w_down)
    h = _rmsnorm(x, norm_mix)
    proj = h @ w_in
    p_rwkv = _centred_shift(proj[..., :SHIFT_COLS], shift_mu)
    y_rwkv = _rwkv_mixer(p_rwkv, rwkv_w0, rwkv_w2, rwkv_a0, rwkv_a2, rwkv_g2, rwkv_k_k,
                         rwkv_k_a, rwkv_r_k, rwkv_ln_w, rwkv_ln_b).astype(x.dtype) @ proj_rwkv
    y_s5 = _s5_mixer(proj[..., U_OFF:GATE_OFF], s5_a_re, s5_a_im, s5_log_step, s5_b_re, s5_b_im,
                     s5_c_re, s5_c_im, s5_d, s5_w_glu, s5_b_glu).astype(x.dtype) @ proj_s5
    gates = jax.nn.sigmoid(proj[..., GATE_OFF:]).reshape(x.shape[0], x.shape[1], N_BRANCH, D_MODEL)
    merged = gates[..., 0, :] * y_rwkv + gates[..., 1, :] * y_s5
    x = x + merged @ w_out
    x = x + 0.5 * _swiglu(_rmsnorm(x, norm_ffn2), ffn2_w_gate, ffn2_w_up, ffn2_w_down)
    return x


def _trunk(x, layer_params, norm_final):
    for l in range(DEPTH):
        x = _layer(x, *[p[l] for p in layer_params])
    return _rmsnorm(x, norm_final)


def setup_inputs(seed: int = 0) -> dict:
    key = jax.random.key(seed)
    ks = iter(jax.random.split(key, 48))
    f32 = jnp.float32

    def nrm(shape, scale):
        return jax.random.normal(next(ks), shape, f32) * scale

    def gain(shape):
        return 1.0 + 0.05 * jax.random.normal(next(ks), shape, f32)

    Lr, P, G, CH = DEPTH, S5_STATE, S5_GROUPS, S5_GROUP_CH
    n_idx = jnp.arange(P, dtype=f32)
    return {
        'x_prompt': nrm((BATCH, SEQ, D_MODEL), 1.0),
        'x_sample': nrm((DEC_BATCH, DEC_SEQ, D_MODEL), 1.0),
        'norm_ffn1': gain((Lr, D_MODEL)),
        'ffn1_w_gate': nrm((Lr, D_MODEL, D_FF), D_MODEL ** -0.5),
        'ffn1_w_up': nrm((Lr, D_MODEL, D_FF), D_MODEL ** -0.5),
        'ffn1_w_down': nrm((Lr, D_FF, D_MODEL), D_FF ** -0.5),
        'norm_mix': gain((Lr, D_MODEL)),
        'w_in': nrm((Lr, D_MODEL, IN_COLS), D_MODEL ** -0.5),
        'shift_mu': jax.random.uniform(next(ks), (Lr, SHIFT_COLS), f32),
        'rwkv_w0': jax.random.uniform(next(ks), (Lr, 2, RWKV_DIM), f32, -6.0, 1.0),
        'rwkv_w2': nrm((Lr, 2, DECAY_LORA, RWKV_DIM), 0.1 * DECAY_LORA ** -0.5),
        'rwkv_a0': nrm((Lr, 2, RWKV_DIM), 0.5),
        'rwkv_a2': nrm((Lr, 2, ICLR_LORA, RWKV_DIM), 0.5 * ICLR_LORA ** -0.5),
        'rwkv_g2': nrm((Lr, GATE_LORA, RWKV_DIM), GATE_LORA ** -0.5),
        'rwkv_k_k': 0.85 + nrm((Lr, RWKV_DIM), 0.05),
        'rwkv_k_a': gain((Lr, RWKV_DIM)),
        'rwkv_r_k': nrm((Lr, RWKV_DIM), 0.1),
        'rwkv_ln_w': gain((Lr, RWKV_DIM)),
        'rwkv_ln_b': nrm((Lr, RWKV_DIM), 0.02),
        's5_a_re': -0.5 + nrm((Lr, 2, G, P), 0.01),
        's5_a_im': math.pi * n_idx + nrm((Lr, 2, G, P), 0.01),
        's5_log_step': jax.random.uniform(next(ks), (Lr, 2, G), f32, math.log(DT_MIN), math.log(DT_MAX)),
        's5_b_re': nrm((Lr, 2, G, P, CH), (2.0 * CH) ** -0.5),
        's5_b_im': nrm((Lr, 2, G, P, CH), (2.0 * CH) ** -0.5),
        's5_c_re': nrm((Lr, G, CH, P), (2.0 * P) ** -0.5),
        's5_c_im': nrm((Lr, G, CH, P), (2.0 * P) ** -0.5),
        's5_d': nrm((Lr, S5_DIM), 1.0),
        's5_w_glu': nrm((Lr, S5_DIM, S5_DIM), S5_DIM ** -0.5),
        's5_b_glu': nrm((Lr, S5_DIM), 0.02),
        'proj_rwkv': nrm((Lr, RWKV_DIM, D_MODEL), RWKV_DIM ** -0.5),
        'proj_s5': nrm((Lr, S5_DIM, D_MODEL), S5_DIM ** -0.5),
        'w_out': nrm((Lr, D_MODEL, D_MODEL), D_MODEL ** -0.5),
        'norm_ffn2': gain((Lr, D_MODEL)),
        'ffn2_w_gate': nrm((Lr, D_MODEL, D_FF), D_MODEL ** -0.5),
        'ffn2_w_up': nrm((Lr, D_MODEL, D_FF), D_MODEL ** -0.5),
        'ffn2_w_down': nrm((Lr, D_FF, D_MODEL), D_FF ** -0.5),
        'norm_final': gain((D_MODEL,)),
    }


def reference(x_prompt, x_sample, norm_ffn1, ffn1_w_gate, ffn1_w_up, ffn1_w_down, norm_mix,
              w_in, shift_mu, rwkv_w0, rwkv_w2, rwkv_a0, rwkv_a2, rwkv_g2, rwkv_k_k, rwkv_k_a,
              rwkv_r_k, rwkv_ln_w, rwkv_ln_b, s5_a_re, s5_a_im, s5_log_step, s5_b_re, s5_b_im,
              s5_c_re, s5_c_im, s5_d, s5_w_glu, s5_b_glu, proj_rwkv, proj_s5, w_out,
              norm_ffn2, ffn2_w_gate, ffn2_w_up, ffn2_w_down, norm_final):
    layer_params = (norm_ffn1, ffn1_w_gate, ffn1_w_up, ffn1_w_down, norm_mix, w_in, shift_mu,
                    rwkv_w0, rwkv_w2, rwkv_a0, rwkv_a2, rwkv_g2, rwkv_k_k, rwkv_k_a, rwkv_r_k,
                    rwkv_ln_w, rwkv_ln_b, s5_a_re, s5_a_im, s5_log_step, s5_b_re, s5_b_im,
                    s5_c_re, s5_c_im, s5_d, s5_w_glu, s5_b_glu, proj_rwkv, proj_s5, w_out,
                    norm_ffn2, ffn2_w_gate, ffn2_w_up, ffn2_w_down)
    y_prompt = _trunk(x_prompt, layer_params, norm_final)
    y_sample = _trunk(x_sample, layer_params, norm_final)
    return (y_prompt, y_sample)
```

```cpp
#include <hip/hip_runtime.h>
#include <cstdio>
#include <cstdint>
#ifndef MK_SPLIT
#define MK_SPLIT 0
#endif
#define RWKV_REF 0
#define S5_REF 0
#define MK_CHECK 0
namespace pg8 {
#define PG8_LAS __attribute__((address_space(3)))
typedef unsigned short bf16_t;
typedef short bf16x8 __attribute__((ext_vector_type(8)));
typedef float f32x4 __attribute__((ext_vector_type(4)));
typedef unsigned u32x4 __attribute__((ext_vector_type(4)));
constexpr int BM = 256, BK = 64, HALF = 128, HTB = HALF * BK * 2  , STAGE_BYTES = 8 * HTB, NXCD = 8, WGM = 8;

__host__ __device__ __forceinline__ int lds_byte(int r, int c) { const int st = (r >> 4) * 2 + (c >> 5), rr = r & 15, cc = c & 31, ob = rr * 64 + cc * 2; return st * 1024 + (ob ^ (((ob >> 9) & 1) << 5)); }
__host__ __device__ __forceinline__ void stage_rc(int b, int& R, int& C) { const int st = b / 1024, sb = b % 1024, swz = sb ^ (((sb >> 9) & 1) << 5); R = (st >> 1) * 16 + swz / 64; C = (st & 1) * 32 + (swz % 64) / 2; }
__host__ __device__ __forceinline__ int perm32(int rho) { const int n = rho >> 4, i = rho & 15; return 8 * (i >> 2) + 4 * n + (i & 3); }

struct Unit { int pm, pn; };
struct Gemm { const bf16_t* A; const bf16_t* Bt; int M, N, K; int lda; };

struct StaticOrder {
    int nM, nN, nwg, G, c, fix, base, lim;
    __host__ __device__ void init(int M, int N, int G_, int c_) { nM = M / BM; nN = N / BM; nwg = nM * nN; G = G_; c = c_; fix = -1; base = 0; lim = nwg; }
    __host__ __device__ bool next(int i, Unit& u) const {
        const long L = (long)base + (long)i * G + c; if (L >= lim) return false;
        int wgid = (int)L; { const int q = nwg / NXCD, r = nwg % NXCD, xcd = wgid % NXCD, off = wgid / NXCD; wgid = (xcd < r ? xcd * (q + 1) : r * (q + 1) + (xcd - r) * q) + off; }
        const int nig = WGM * nN, gid = wgid / nig, fm = gid * WGM, gsz = (nM - fm) < WGM ? (nM - fm) : WGM;
        u.pm = fm + ((wgid % nig) % gsz); u.pn = (wgid % nig) / gsz; if (fix >= 0) { u.pm = fix; u.pn = fix; } return true;
    }
    __device__ __forceinline__ void a_ready(const Unit&) const {}
    __device__ __forceinline__ void done(const Unit&) const {}
};

typedef __bf16 bf16x2_n __attribute__((ext_vector_type(2)));
typedef float f32x2_n __attribute__((ext_vector_type(2)));
__device__ __forceinline__ unsigned cvt_pk_bf16(float lo, float hi) { const bf16x2_n r = __builtin_convertvector((f32x2_n){lo, hi}, bf16x2_n); return __builtin_bit_cast(unsigned, r); }
__device__ __forceinline__ float bf_lo(unsigned w) { return __builtin_bit_cast(float, w << 16); }
__device__ __forceinline__ float bf_hi(unsigned w) { return __builtin_bit_cast(float, w & 0xffff0000u); }
__device__ __forceinline__ float fsigmoid(float x) { return __builtin_amdgcn_rcpf(1.0f + __builtin_amdgcn_exp2f(-1.4426950408889634f * x)); }
__device__ __forceinline__ u32x4 pack8(const f32x4& a, const f32x4& b) { u32x4 w; w.x = cvt_pk_bf16(a[0], a[1]); w.y = cvt_pk_bf16(a[2], a[3]); w.z = cvt_pk_bf16(b[0], b[1]); w.w = cvt_pk_bf16(b[2], b[3]); return w; }
__device__ __forceinline__ void unpack8(const u32x4& w, f32x4& a, f32x4& b) { a = (f32x4){bf_lo(w.x), bf_hi(w.x), bf_lo(w.y), bf_hi(w.y)}; b = (f32x4){bf_lo(w.z), bf_hi(w.z), bf_lo(w.w), bf_hi(w.w)}; }

struct EpiSwiGLU {
    static constexpr bool PERM = true, AFTER_DRAIN = false;
    bf16_t* H; int ldh; const unsigned long long* ss;
    __device__ __forceinline__ void operator()(const f32x4 (&acc)[2][2][4][2], const Unit& u, int wr, int wc, int fr, int fq) const {
        const int row0 = u.pm * BM + wr * 64 + fr, col0 = u.pn * HALF + wc * 32 + 8 * fq;
#pragma unroll
        for (int ai = 0; ai < 2; ++ai)
#pragma unroll
            for (int m = 0; m < 4; ++m) { bf16_t* rowp = H + (size_t)(row0 + ai * HALF + m * 16) * ldh + col0;
                const float rs = ss ? 1.0f / sqrtf((float)ss[row0 + ai * HALF + m * 16] * (1.0f / (16777216.0f * 2048.0f)) + 1e-6f) : 1.0f;
                f32x4 o[2];
#pragma unroll
                for (int n = 0; n < 2; ++n) { const f32x4 g = acc[ai][0][m][n] * rs, up = acc[ai][1][m][n] * rs;
#pragma unroll
                    for (int j = 0; j < 4; ++j) o[n][j] = g[j] * fsigmoid(g[j]) * up[j]; }
                *(u32x4*)rowp = pack8(o[0], o[1]); }
    }
};
struct EpiResid {
    static constexpr bool PERM = false, AFTER_DRAIN = false;
    const float* in_lo; const float* in_hi; int split; float* out; int ldc; float scale;
    __device__ __forceinline__ void operator()(const f32x4 (&acc)[2][2][4][2], const Unit& u, int wr, int wc, int fr, int fq) const {
        const int row0 = u.pm * BM + wr * 64 + fr, col0 = u.pn * BM + wc * 32 + 4 * fq;
        const float* inb = (u.pm * BM < split) ? in_lo : in_hi - (size_t)split * ldc;
#pragma unroll
        for (int ai = 0; ai < 2; ++ai) { f32x4 bs[4][2][2];
#pragma unroll
            for (int m = 0; m < 4; ++m) { const size_t off = (size_t)(row0 + ai * HALF + m * 16) * ldc + col0;
#pragma unroll
                for (int bj = 0; bj < 2; ++bj)
#pragma unroll
                    for (int n = 0; n < 2; ++n) bs[m][bj][n] = *(const f32x4*)(inb + off + bj * HALF + n * 16); }
#pragma unroll
            for (int m = 0; m < 4; ++m) { const size_t off = (size_t)(row0 + ai * HALF + m * 16) * ldc + col0;
#pragma unroll
                for (int bj = 0; bj < 2; ++bj)
#pragma unroll
                    for (int n = 0; n < 2; ++n) *(f32x4*)(out + off + bj * HALF + n * 16) = bs[m][bj][n] + acc[ai][bj][m][n] * scale; }
            asm volatile("" ::: "memory"); }
    }
};
template <int MODE> struct EpiBf {
    static constexpr bool PERM = true, AFTER_DRAIN = false;
    bf16_t* O0; int ld0; bf16_t* O1; int ld1; int nsplit;
    const bf16_t* T; int ldt;
    const bf16_t* G; int ldg; int goff; const float* bias; const unsigned long long* ss;
    __device__ __forceinline__ void operator()(const f32x4 (&acc)[2][2][4][2], const Unit& u, int wr, int wc, int fr, int fq) const {
        const int row0 = u.pm * BM + wr * 64 + fr;
        bf16_t* base = O0; int ld = ld0; int colt = u.pn * BM;
        if (MODE == 0) { if (u.pn >= nsplit) { base = O1; ld = ld1; colt = (u.pn - nsplit) * BM; } }
        const int col0 = colt + wc * 32 + 8 * fq;
#pragma unroll
        for (int ai = 0; ai < 2; ++ai)
#pragma unroll
            for (int m = 0; m < 4; ++m) { const int row = row0 + ai * HALF + m * 16;
                const float rs = (MODE <= 1 && ss) ? 1.0f / sqrtf((float)ss[row] * (1.0f / (16777216.0f * 2048.0f)) + 1e-6f) : 1.0f;
#pragma unroll
                for (int bj = 0; bj < 2; ++bj) { f32x4 v0 = acc[ai][bj][m][0], v1 = acc[ai][bj][m][1]; const int col = col0 + bj * HALF;
                    if (MODE <= 1) { v0 = v0 * rs; v1 = v1 * rs; }
                    if (MODE == 1) {
#pragma unroll
                        for (int j = 0; j < 4; ++j) { v0[j] = fsigmoid(v0[j]); v1[j] = fsigmoid(v1[j]); } }
                    if (MODE == 2) { f32x4 t0, t1; unpack8(*(const u32x4*)(T + (size_t)row * ldt + col), t0, t1); v0 = v0 * t0; v1 = v1 * t1; }
                    if (MODE == 3) { f32x4 t0, t1; unpack8(*(const u32x4*)(T + (size_t)row * ldt + col), t0, t1); const f32x4 b0 = *(const f32x4*)(bias + col), b1 = *(const f32x4*)(bias + col + 4);
#pragma unroll
                        for (int j = 0; j < 4; ++j) { v0[j] = fsigmoid(v0[j] + b0[j]) * t0[j]; v1[j] = fsigmoid(v1[j] + b1[j]) * t1[j]; } }
                    if (MODE == 4) { f32x4 g0, g1; unpack8(*(const u32x4*)(G + (size_t)row * ldg + col), g0, g1); v0 = v0 * g0; v1 = v1 * g1; }
                    if (MODE == 5) { f32x4 g0, g1, t0, t1; unpack8(*(const u32x4*)(G + (size_t)row * ldg + goff + col), g0, g1); unpack8(*(const u32x4*)(T + (size_t)row * ldt + col), t0, t1); v0 = t0 + v0 * g0; v1 = t1 + v1 * g1; }
                    *(u32x4*)(base + (size_t)row * ld + col) = pack8(v0, v1); } }
    }
};


template <int SRC, int DST> struct EpiRes2 {
    static constexpr bool PERM = true, AFTER_DRAIN = false;
    const float* in_lo; const float* in_hi; int split; const bf16_t* xg_in; const float* gin; bf16_t* xg_out; const float* gout; float* xf_out; int ldc; float scale; unsigned long long* ss;
    __device__ __forceinline__ void operator()(const f32x4 (&acc)[2][2][4][2], const Unit& u, int wr, int wc, int fr, int fq) const {
        const int row0 = u.pm * BM + wr * 64 + fr, col0 = u.pn * BM + wc * 32 + 8 * fq;
        const float* inb = (u.pm * BM < split) ? in_lo : in_hi - (size_t)split * ldc;
        f32x4 gi[2][2], go[2][2];
#pragma unroll
        for (int bj = 0; bj < 2; ++bj)
#pragma unroll
            for (int n = 0; n < 2; ++n) { const int c = col0 + bj * HALF + 4 * n;
                if (SRC == 1) { const f32x4 g = *(const f32x4*)(gin + c); gi[bj][n] = (f32x4){1.0f / g[0], 1.0f / g[1], 1.0f / g[2], 1.0f / g[3]}; }
                if (DST == 0) go[bj][n] = *(const f32x4*)(gout + c); }
#pragma unroll
        for (int ai = 0; ai < 2; ++ai)
#pragma unroll
            for (int m = 0; m < 4; ++m) { const int row = row0 + ai * HALF + m * 16; const size_t off = (size_t)row * ldc + col0; f32x4 x[2][2]; float s = 0.f;
#pragma unroll
                for (int bj = 0; bj < 2; ++bj) {
                    if (SRC == 0) { x[bj][0] = *(const f32x4*)(inb + off + bj * HALF); x[bj][1] = *(const f32x4*)(inb + off + bj * HALF + 4); }
                    else { f32x4 t0, t1; unpack8(*(const u32x4*)(xg_in + off + bj * HALF), t0, t1); x[bj][0] = t0 * gi[bj][0]; x[bj][1] = t1 * gi[bj][1]; } }
#pragma unroll
                for (int bj = 0; bj < 2; ++bj)
#pragma unroll
                    for (int n = 0; n < 2; ++n) { x[bj][n] = x[bj][n] + acc[ai][bj][m][n] * scale; const f32x4 q = x[bj][n] * x[bj][n]; s += (q[0] + q[1]) + (q[2] + q[3]); }
#pragma unroll
                for (int bj = 0; bj < 2; ++bj) {
                    if (DST == 0) *(u32x4*)(xg_out + off + bj * HALF) = pack8(x[bj][0] * go[bj][0], x[bj][1] * go[bj][1]);
                    else { *(f32x4*)(xf_out + off + bj * HALF) = x[bj][0]; *(f32x4*)(xf_out + off + bj * HALF + 4) = x[bj][1]; } }
                s += __shfl_xor(s, 16); s += __shfl_xor(s, 32);
                if (fq == 0) __hip_atomic_fetch_add(ss + row, (unsigned long long)(s * 16777216.0f + 0.5f), __ATOMIC_RELAXED, __HIP_MEMORY_SCOPE_AGENT); }
    }
};
template <class Epi, class Sched, bool ALIGN_EPI = false, bool SP2 = false>
__device__ __forceinline__ void gemm_phase(PG8_LAS unsigned char* lds, const Gemm g, const Sched& S, const Epi& E) {
    int tid_l = threadIdx.x; asm volatile("" : "+v"(tid_l));
    const int tid = tid_l, wid = __builtin_amdgcn_readfirstlane(tid >> 6), lane = tid & 63, wr = wid >> 2, wc = wid & 3, fr = lane & 15, fq = lane >> 4;
    const int K = g.K, nt = K / BK, lda = g.lda ? g.lda : K;
    unsigned voffA[2], voffB[2];
#pragma unroll
    for (int i = 0; i < 2; ++i) { int R, C; stage_rc(tid * 16 + i * 8192, R, C); const int Rb = Epi::PERM ? ((R & ~31) + perm32(R & 31)) : R;
        voffA[i] = (unsigned)(R * lda + C) * 2u; voffB[i] = (unsigned)(Rb * K + C) * 2u; }
    const size_t kstep = (size_t)(BK * 2);
    const size_t hstep = (size_t)HALF * K * 2;
    const size_t tstep = 2 * hstep;
    const size_t hstepA = (size_t)HALF * lda * 2, tstepA = 2 * hstepA;
    const unsigned ldsw = (unsigned)wid * 1024u;
    const int aoff = lds_byte(wr * 64 + fr, fq * 8), boff = lds_byte(wc * 32 + fr, fq * 8);
#define PG8_SA(b, h) (((b) * 2 + (h)) * HTB)
#define PG8_SB(b, h) ((4 + (b) * 2 + (h)) * HTB)
#define PG8_STAGE(bufoff, gbase, voff) do { _Pragma("unroll") for (int _i = 0; _i < 2; ++_i) \
        __builtin_amdgcn_global_load_lds((const unsigned*)((const char*)(gbase) + (voff)[_i]), (PG8_LAS unsigned*)(lds + (bufoff) + ldsw + _i * 8192), 16, 0, 0); } while (0)
#define PG8_LDA(dst, b, h) do { _Pragma("unroll") for (int m = 0; m < 4; ++m) _Pragma("unroll") for (int k = 0; k < 2; ++k) dst[m][k] = *(const PG8_LAS bf16x8*)(lds + PG8_SA(b, h) + aoff + m * 2048 + k * 1024); } while (0)
#define PG8_LDB(dst, b, h) do { _Pragma("unroll") for (int n = 0; n < 2; ++n) _Pragma("unroll") for (int k = 0; k < 2; ++k) dst[n][k] = *(const PG8_LAS bf16x8*)(lds + PG8_SB(b, h) + boff + n * 2048 + k * 1024); } while (0)
#define PG8_MMA(ai, bj, At, Bt) do { __builtin_amdgcn_s_setprio(1); _Pragma("unroll") for (int m = 0; m < 4; ++m) _Pragma("unroll") for (int n = 0; n < 2; ++n) _Pragma("unroll") for (int k = 0; k < 2; ++k) \
        acc[ai][bj][m][n] = __builtin_amdgcn_mfma_f32_16x16x32_bf16(Bt[n][k], At[m][k], acc[ai][bj][m][n], 0, 0, 0); __builtin_amdgcn_s_setprio(0); } while (0)
#define PG8_WAIT_V(n) asm volatile("s_waitcnt vmcnt(" #n ")" ::: "memory")
#define PG8_WAIT_L(n) asm volatile("s_waitcnt lgkmcnt(" #n ")" ::: "memory")
#define PG8_BAR __builtin_amdgcn_s_barrier()
#define PG8_SCHED __builtin_amdgcn_sched_barrier(0)
    Unit cur, nxt; int ui = 0;
    if (!S.next(0, cur)) return;
    f32x4 acc[2][2][4][2];
#pragma unroll
    for (int a = 0; a < 2; ++a)
#pragma unroll
        for (int b = 0; b < 2; ++b)
#pragma unroll
            for (int m = 0; m < 4; ++m)
#pragma unroll
                for (int n = 0; n < 2; ++n) acc[a][b][m][n] = (f32x4){0.f, 0.f, 0.f, 0.f};
    bf16x8 At[4][2], B0[2][2], B1[2][2];
    const char* cA = (const char*)g.A + (size_t)cur.pm * tstepA; const char* cB = (const char*)g.Bt + (size_t)cur.pn * tstep;
    S.a_ready(cur);
    if constexpr (SP2) {
        PG8_STAGE(PG8_SB(0, 0), cB, voffB); PG8_STAGE(PG8_SB(0, 1), cB + hstep, voffB); PG8_STAGE(PG8_SA(0, 0), cA, voffA); PG8_STAGE(PG8_SA(0, 1), cA + hstepA, voffA);
        if (wr == 1) PG8_BAR;
        PG8_WAIT_V(2); PG8_BAR;
        PG8_STAGE(PG8_SB(1, 0), cB + kstep, voffB); PG8_STAGE(PG8_SA(1, 0), cA + kstep, voffA); PG8_STAGE(PG8_SB(1, 1), cB + hstep + kstep, voffB);
        PG8_WAIT_V(6); PG8_BAR;
    } else {
        PG8_STAGE(PG8_SB(0, 0), cB, voffB); PG8_STAGE(PG8_SA(0, 0), cA, voffA); PG8_STAGE(PG8_SB(0, 1), cB + hstep, voffB); PG8_STAGE(PG8_SA(0, 1), cA + hstepA, voffA);
        if (wr == 1) PG8_BAR;
        PG8_WAIT_V(4); PG8_BAR;
        PG8_STAGE(PG8_SB(1, 0), cB + kstep, voffB); PG8_STAGE(PG8_SA(1, 0), cA + kstep, voffA); PG8_STAGE(PG8_SB(1, 1), cB + hstep + kstep, voffB);
        PG8_WAIT_V(6); PG8_BAR;
    }
    for (;;) {
        const bool has_next = S.next(ui + 1, nxt);
        const char* nA = has_next ? (const char*)g.A + (size_t)nxt.pm * tstepA : cA; const char* nB = has_next ? (const char*)g.Bt + (size_t)nxt.pn * tstep : cB;
        for (int t = 0; t < nt; t += 2) {
            const bool last = (t == nt - 2);
            const char* a1 = cA + (size_t)(t + 1) * kstep;
            const char* a2 = last ? nA : cA + (size_t)(t + 2) * kstep; const char* b2 = last ? nB : cB + (size_t)(t + 2) * kstep;
            const char* a3 = a2 + kstep; const char* b3 = b2 + kstep;
            if (last && has_next) S.a_ready(nxt);
            if constexpr (SP2) {
            PG8_LDB(B0, 0, 0); PG8_LDB(B1, 0, 1); PG8_SCHED; PG8_LDA(At, 0, 0); PG8_STAGE(PG8_SA(1, 1), a1 + hstepA, voffA);
            PG8_WAIT_V(8); PG8_WAIT_L(0); PG8_BAR; PG8_MMA(0, 0, At, B0); PG8_MMA(0, 1, At, B1); PG8_BAR; PG8_SCHED;
            PG8_LDA(At, 0, 1); PG8_STAGE(PG8_SB(0, 0), b2, voffB); PG8_STAGE(PG8_SB(0, 1), b2 + hstep, voffB); PG8_STAGE(PG8_SA(0, 0), a2, voffA);
            PG8_WAIT_V(8); PG8_WAIT_L(0); PG8_BAR; PG8_MMA(1, 0, At, B0); PG8_MMA(1, 1, At, B1); PG8_BAR; PG8_SCHED;
            PG8_LDB(B0, 1, 0); PG8_LDB(B1, 1, 1); PG8_SCHED; PG8_LDA(At, 1, 0); PG8_STAGE(PG8_SA(0, 1), a2 + hstepA, voffA);
            PG8_WAIT_V(8); PG8_WAIT_L(0); PG8_BAR; PG8_MMA(0, 0, At, B0); PG8_MMA(0, 1, At, B1); PG8_BAR; PG8_SCHED;
            PG8_LDA(At, 1, 1); PG8_STAGE(PG8_SB(1, 0), b3, voffB); PG8_STAGE(PG8_SB(1, 1), b3 + hstep, voffB); PG8_STAGE(PG8_SA(1, 0), a3, voffA);
            PG8_WAIT_V(8); PG8_WAIT_L(0); PG8_BAR; PG8_MMA(1, 0, At, B0); PG8_MMA(1, 1, At, B1); PG8_BAR; PG8_SCHED;
            } else {
            PG8_LDB(B0, 0, 0); PG8_SCHED; PG8_LDA(At, 0, 0); PG8_STAGE(PG8_SA(1, 1), a1 + hstepA, voffA);
            PG8_WAIT_L(8); PG8_BAR; PG8_WAIT_L(0); PG8_MMA(0, 0, At, B0); PG8_BAR; PG8_SCHED;
            PG8_LDB(B1, 0, 1); PG8_STAGE(PG8_SB(0, 0), b2, voffB);
            PG8_BAR; PG8_WAIT_L(0); PG8_MMA(0, 1, At, B1); PG8_BAR;
            PG8_LDA(At, 0, 1); PG8_STAGE(PG8_SA(0, 0), a2, voffA);
            PG8_BAR; PG8_WAIT_L(0); PG8_MMA(1, 0, At, B0); PG8_BAR; PG8_SCHED;
            PG8_STAGE(PG8_SB(0, 1), b2 + hstep, voffB);
            PG8_WAIT_V(6); PG8_BAR; PG8_MMA(1, 1, At, B1); PG8_BAR;
            PG8_LDB(B0, 1, 0); PG8_SCHED; PG8_LDA(At, 1, 0); PG8_STAGE(PG8_SA(0, 1), a2 + hstepA, voffA);
            PG8_WAIT_L(8); PG8_BAR; PG8_WAIT_L(0); PG8_MMA(0, 0, At, B0); PG8_BAR; PG8_SCHED;
            PG8_LDB(B1, 1, 1); PG8_STAGE(PG8_SB(1, 0), b3, voffB);
            PG8_BAR; PG8_WAIT_L(0); PG8_MMA(0, 1, At, B1); PG8_BAR;
            PG8_LDA(At, 1, 1); PG8_STAGE(PG8_SA(1, 0), a3, voffA);
            PG8_BAR; PG8_WAIT_L(0); PG8_MMA(1, 0, At, B0); PG8_BAR; PG8_SCHED;
            PG8_STAGE(PG8_SB(1, 1), b3 + hstep, voffB);
            PG8_WAIT_V(6); PG8_BAR; PG8_MMA(1, 1, At, B1); PG8_BAR;
            }
        }
        if constexpr (ALIGN_EPI) { if (wr == 0) PG8_BAR; }
        if constexpr (!Epi::AFTER_DRAIN) { E(acc, cur, wr, wc, fr, fq); S.done(cur); }
        if (!has_next) break;
#pragma unroll
        for (int a = 0; a < 2; ++a)
#pragma unroll
            for (int b = 0; b < 2; ++b)
#pragma unroll
                for (int m = 0; m < 4; ++m)
#pragma unroll
                    for (int n = 0; n < 2; ++n) acc[a][b][m][n] = (f32x4){0.f, 0.f, 0.f, 0.f};
        cur = nxt; cA = nA; cB = nB; ++ui;
        if constexpr (ALIGN_EPI) { if (wr == 1) PG8_BAR; }
    }
    PG8_WAIT_V(0);
    if constexpr (!ALIGN_EPI) { if (wr == 0) PG8_BAR; }
    PG8_BAR;
    if constexpr (Epi::AFTER_DRAIN) { E.fused(acc, cur, wr, wc, fr, fq, lds, wid, lane); S.done(cur); }
#undef PG8_SA
#undef PG8_SB
#undef PG8_STAGE
#undef PG8_LDA
#undef PG8_LDB
#undef PG8_MMA
#undef PG8_WAIT_V
#undef PG8_WAIT_L
#undef PG8_BAR
#undef PG8_SCHED
}
}

constexpr int NWAVES = 8;
constexpr int NSEQ = 6, SEQL = 4096, M = NSEQ * SEQL, MP = 2 * SEQL;
constexpr int D = 2048, FF = 5504, NGU = 2 * FF;
constexpr int NH = 16, HD = 64, RW = 1024;
constexpr int RKW = 3072, SMW = 1024, NGATE = 4096, INC = 8064, NA = 3968;
constexpr int SM_WLOW = 0, SM_ALOW = 128, SM_GLOW = 256, SM_U = 384;
constexpr int MU_WLOW = 3072, MU_ALOW = 3200, MU_GLOW = 3328;
constexpr int S5G = 32, S5C = 16, S5P = 64, S5D = 512;
constexpr int DSW = 4096, DS_TW = 3072, DS_AL = 3200, DS_U = 3456, DS_INV = 3968;
constexpr float RMS_EPS = 1e-6f, GN_EPS = 64e-5f;

constexpr size_t MiB = 1u << 20;
constexpr size_t WS_CTL = 0, CTL_ZERO_BYTES = 1 * MiB;
constexpr size_t WS_WINA = 1 * MiB, WS_WING = 17 * MiB, WS_WPR = 33 * MiB, WS_WPS = 37 * MiB, WS_WOUT = 39 * MiB, WS_G2T = 47 * MiB, WS_WGLU = 47 * MiB + 512 * 1024;
constexpr size_t WS_BON = 48 * MiB, WS_SG = 51 * MiB, WS_XN = 63 * MiB;
constexpr size_t WS_WGU = 159 * MiB, WS_WDN = 202 * MiB, WS_H = 224 * MiB;
constexpr size_t WS_RKV = 159 * MiB, WS_SMALL = 303 * MiB, WS_YF = 351 * MiB, WS_YB = 399 * MiB, WS_S5F = 447 * MiB, WS_S5B = 471 * MiB, WS_END = 495 * MiB;
constexpr size_t WS_GATES = 159 * MiB;
static_assert(WS_WGU + (size_t)NGU * D * 2 <= WS_WDN && WS_WDN + (size_t)D * FF * 2 <= WS_H && WS_H + (size_t)M * FF * 2 <= WS_END, "ffn map");
static_assert(WS_RKV + (size_t)M * RKW * 2 <= WS_SMALL && WS_SMALL + (size_t)M * SMW * 2 <= WS_YF && WS_YF + (size_t)M * RW * 2 <= WS_YB && WS_YB + (size_t)M * RW * 2 <= WS_S5F && WS_S5F + (size_t)M * S5D * 2 <= WS_S5B && WS_S5B + (size_t)M * S5D * 2 <= WS_END, "mixer map");
static_assert(WS_GATES + (size_t)M * NGATE * 2 <= WS_YF && WS_XN + (size_t)M * D * 2 <= WS_WGU && WS_SG + (size_t)M * 256 * 2 <= WS_XN && WS_BON + (size_t)2 * M * NH * 4 <= WS_SG, "map");
constexpr int CW_BAR = 4096;

constexpr int RING_BYTES = 131072;
constexpr int LDSCTL_OFF = 146432, MISC_OFF = LDSCTL_OFF + 320;
constexpr int LDS_BYTES = 147456;

#define GAS __attribute__((address_space(1)))
#define LAS __attribute__((address_space(3)))
typedef unsigned short bf16;
typedef unsigned v4u __attribute__((ext_vector_type(4)));
typedef unsigned v2u __attribute__((ext_vector_type(2)));
typedef float f32x4 __attribute__((ext_vector_type(4)));
typedef float f32x2 __attribute__((ext_vector_type(2)));
typedef short bf16x8 __attribute__((ext_vector_type(8)));
typedef short bf16x4 __attribute__((ext_vector_type(4)));
typedef _Float16 h16x4 __attribute__((ext_vector_type(4)));
typedef _Float16 h16x8 __attribute__((ext_vector_type(8)));
typedef GAS unsigned gu32;
#define RLX_AGENT __ATOMIC_RELAXED, __HIP_MEMORY_SCOPE_AGENT
#define LDS_WAIT() asm volatile("s_waitcnt lgkmcnt(0)" ::: "memory")
#define VM_WAIT() asm volatile("s_waitcnt vmcnt(0)" ::: "memory")
using pg8::cvt_pk_bf16; using pg8::bf_lo; using pg8::bf_hi; using pg8::fsigmoid;

#define XB_TMO      128
#define XB_XCNT(j)  (256  + 64 * (j))
#define XB_XSUB(j)  (1280 + 64 * (j))
#define XB_XGEN(j)  (2304 + 64 * (j))
#define XB_TOP      3328
#define XB_TOPGEN   3392
#define XCD_BAR_WORDS 3456
#define XB_SPIN_CAP (1u << 18)

__device__ __forceinline__ unsigned xb_ld(unsigned* p)              { return __hip_atomic_load(p, __ATOMIC_RELAXED, __HIP_MEMORY_SCOPE_AGENT); }
__device__ __forceinline__ unsigned xb_add(unsigned* p, unsigned v) { return __hip_atomic_fetch_add(p, v, __ATOMIC_RELAXED, __HIP_MEMORY_SCOPE_AGENT); }
__device__ __forceinline__ unsigned xb_xcc_id() { return (unsigned)__builtin_amdgcn_s_getreg((3 << 11) | 20) & 0xFu; }
#define XB_SPIN(cond, bar) do { unsigned _sp = 0; while (cond) { __builtin_amdgcn_s_sleep(1); \
    if ((++_sp & 255u) == 0u) { if (xb_ld(&(bar)[XB_TMO])) break; if (_sp > XB_SPIN_CAP) { atomicAdd(&(bar)[XB_TMO], 1u); break; } } } } while (0)

struct XcdBarrier {
    unsigned* bar; unsigned x;
    volatile LAS unsigned* st;
};
__device__ __forceinline__ XcdBarrier xcd_barrier_post(unsigned* bar, volatile LAS unsigned* st) {
    XcdBarrier b; b.bar = bar; b.x = xb_xcc_id(); b.st = st;
    if (threadIdx.x == 0) (void)xb_add(&bar[XB_XCNT(b.x)], 1u);
    return b;
}
__device__ __forceinline__ void xcd_barrier_complete(unsigned* bar, unsigned x, unsigned& nloc, unsigned& nx) {
    const unsigned G = gridDim.x * gridDim.y * gridDim.z;
    unsigned sum, cnt, mine, sp = 0u;
    for (;;) {
        sum = 0u; cnt = 0u; mine = 0u;
#pragma unroll
        for (unsigned j = 0; j < 16; ++j) { const unsigned c = xb_ld(&bar[XB_XCNT(j)]); sum += c; cnt += (c > 0u) ? 1u : 0u; mine = (j == x) ? c : mine; }
        if (sum == G) break;
        __builtin_amdgcn_s_sleep(1);
        if ((++sp & 255u) == 0u) { if (xb_ld(&bar[XB_TMO])) break; if (sp > XB_SPIN_CAP) { atomicAdd(&bar[XB_TMO], 1u); break; } }
    }
    nloc = mine > 0u ? mine : 1u; nx = cnt > 0u ? cnt : 1u;
}
__device__ __forceinline__ void xcd_barrier(const XcdBarrier& b) {
    asm volatile("s_waitcnt vmcnt(0)" ::: "memory");
    __syncthreads();
    if (threadIdx.x == 0) {
        unsigned* bar = b.bar;
        __builtin_amdgcn_s_waitcnt(0);
        unsigned nloc = b.st[0], nx = b.st[1];
        if (nloc == 0u) { xcd_barrier_complete(bar, b.x, nloc, nx); b.st[0] = nloc; b.st[1] = nx; }
        const unsigned old = xb_add(&bar[XB_XSUB(b.x)], 1u);
        const unsigned gen = old / nloc;
        if (old + 1u == (gen + 1u) * nloc) {
            __builtin_amdgcn_fence(__ATOMIC_RELEASE, "agent");
            asm volatile("s_waitcnt vmcnt(0)" ::: "memory");
            const unsigned og = xb_add(&bar[XB_TOP], 1u);
            const unsigned tg = og / nx;
            if (og + 1u == (tg + 1u) * nx) xb_add(&bar[XB_TOPGEN], 1u);
            else XB_SPIN(xb_ld(&bar[XB_TOPGEN]) == tg, bar);
            __builtin_amdgcn_fence(__ATOMIC_ACQUIRE, "agent");
            xb_add(&bar[XB_XGEN(b.x)], 1u);
            asm volatile("s_waitcnt vmcnt(0)" ::: "memory");
        } else {
            XB_SPIN(xb_ld(&bar[XB_XGEN(b.x)]) == gen, bar);
            __builtin_amdgcn_fence(__ATOMIC_ACQUIRE, "agent");
            asm volatile("s_waitcnt vmcnt(0)" ::: "memory");
        }
    }
    __syncthreads();
}

__device__ __forceinline__ float wave_sum(float v) {
#pragma unroll
    for (int o = 1; o < 64; o <<= 1) v += __shfl_xor(v, o);
    return v;
}
__device__ __forceinline__ float dpp_f(float v, const int ctrl_sel) {
    const int x = __builtin_bit_cast(int, v); int r;
    if (ctrl_sel == 0) r = __builtin_amdgcn_update_dpp(x, x, 0xB1, 0xF, 0xF, false);
    else if (ctrl_sel == 1) r = __builtin_amdgcn_update_dpp(x, x, 0x4E, 0xF, 0xF, false);
    else r = __builtin_amdgcn_update_dpp(x, x, 0x141, 0xF, 0xF, false);
    return __builtin_bit_cast(float, r);
}
__device__ __forceinline__ float red4(float v) { v += dpp_f(v, 0); v += dpp_f(v, 1); return v; }
__device__ __forceinline__ float red8(float v) { v += dpp_f(v, 0); v += dpp_f(v, 1); v += dpp_f(v, 2); return v; }
__device__ __forceinline__ float red16(float v) { v = red8(v); v += __shfl_xor(v, 8); return v; }
__device__ __forceinline__ float ftanh(float x) { const float e = __builtin_amdgcn_exp2f(2.8853900817779268f * x); return 1.0f - 2.0f * __builtin_amdgcn_rcpf(1.0f + e); }
__device__ __forceinline__ unsigned f2bf(float f) { unsigned u = __builtin_bit_cast(unsigned, f); return (u + 0x7fffu + ((u >> 16) & 1u)) >> 16; }

__device__ __forceinline__ void transpose_item(const float* W, int ldW, int ncols, bf16* WT, int ldT, int rowmode, LAS float* scr, int item, int lane) {
    const int nblk = ncols / 32, kb = item / nblk, nb = item % nblk, k0 = 64 * kb, n0 = 32 * nb;
    const int r0 = rowmode == 0 ? n0 : ((n0 >> 7) * 256 + (n0 & 127) + (rowmode == 2 ? 128 : 0));
#pragma unroll 8
    for (int i = 0; i < 32; ++i) { const int kk = 2 * i + (lane >> 5); scr[kk * 33 + (lane & 31)] = W[(size_t)(k0 + kk) * ldW + n0 + (lane & 31)]; }
    LDS_WAIT(); asm volatile("" ::: "memory");
    const int c = lane & 7;
#pragma unroll
    for (int j = 0; j < 4; ++j) { const int n = (lane >> 3) + 8 * j; const LAS float* s = scr + (8 * c) * 33 + n;
        v4u o; o.x = cvt_pk_bf16(s[0 * 33], s[1 * 33]); o.y = cvt_pk_bf16(s[2 * 33], s[3 * 33]); o.z = cvt_pk_bf16(s[4 * 33], s[5 * 33]); o.w = cvt_pk_bf16(s[6 * 33], s[7 * 33]);
        *(v4u*)(WT + (size_t)(r0 + n) * ldT + k0 + 8 * c) = o; }
    LDS_WAIT(); asm volatile("" ::: "memory");
}
__device__ __forceinline__ void rms_row_bf16(const float* xrow, const float* g, bf16* orow, int lane) {
    const f32x4* xr = (const f32x4*)xrow + lane; const f32x4* gr = (const f32x4*)g + lane;
    f32x4 v[8]; float s = 0.f;
#pragma unroll
    for (int j = 0; j < 8; ++j) { v[j] = xr[64 * j]; s += (v[j].x * v[j].x + v[j].y * v[j].y) + (v[j].z * v[j].z + v[j].w * v[j].w); }
    const float rstd = 1.0f / sqrtf(wave_sum(s) * (1.f / D) + RMS_EPS);
    v2u* o8 = (v2u*)orow + lane;
#pragma unroll
    for (int j = 0; j < 8; ++j) { const f32x4 gg = gr[64 * j]; v2u w; w.x = cvt_pk_bf16(v[j].x * rstd * gg.x, v[j].y * rstd * gg.y); w.y = cvt_pk_bf16(v[j].z * rstd * gg.z, v[j].w * rstd * gg.w); o8[64 * j] = w; }
}
__device__ __forceinline__ void rms_row_f32(float* xrow, const float* g, int lane) {
    f32x4* xr = (f32x4*)xrow + lane; const f32x4* gr = (const f32x4*)g + lane;
    f32x4 v[8]; float s = 0.f;
#pragma unroll
    for (int j = 0; j < 8; ++j) { v[j] = xr[64 * j]; s += (v[j].x * v[j].x + v[j].y * v[j].y) + (v[j].z * v[j].z + v[j].w * v[j].w); }
    const float rstd = 1.0f / sqrtf(wave_sum(s) * (1.f / D) + RMS_EPS);
#pragma unroll
    for (int j = 0; j < 8; ++j) { const f32x4 gg = gr[64 * j]; xr[64 * j] = (f32x4){v[j].x * rstd * gg.x, v[j].y * rstd * gg.y, v[j].z * rstd * gg.z, v[j].w * rstd * gg.w}; }
}
template <bool F32OUT> __device__ __forceinline__ void rms_rows(const float* lo, const float* hi, int split, const float* g, bf16* ob, float* of, int gw, int NGW, int lane, unsigned long long* ssout = nullptr) {
    f32x4 gg[8]; { const f32x4* gr = (const f32x4*)g + lane;
#pragma unroll
      for (int j = 0; j < 8; ++j) gg[j] = gr[64 * j]; }
    f32x4 nv[8];
    { const int m = gw; const f32x4* xr = (const f32x4*)(m < split ? lo + (size_t)m * D : hi + (size_t)(m - split) * D) + lane;
#pragma unroll
      for (int j = 0; j < 8; ++j) nv[j] = xr[64 * j]; }
    for (int m = gw; m < M; m += NGW) {
        f32x4 v[8]; float s = 0.f;
#pragma unroll
        for (int j = 0; j < 8; ++j) { v[j] = nv[j]; s += (v[j].x * v[j].x + v[j].y * v[j].y) + (v[j].z * v[j].z + v[j].w * v[j].w); }
        { const int mn = m + NGW < M ? m + NGW : m; const f32x4* xr = (const f32x4*)(mn < split ? lo + (size_t)mn * D : hi + (size_t)(mn - split) * D) + lane;
#pragma unroll
          for (int j = 0; j < 8; ++j) nv[j] = xr[64 * j]; }
        const float ssum = wave_sum(s); const float rstd = ssout ? 1.0f : 1.0f / sqrtf(ssum * (1.f / D) + RMS_EPS);
        if (ssout && lane == 0) ssout[m] = (unsigned long long)(ssum * 16777216.0f + 0.5f);
        if (F32OUT) { f32x4* o = (f32x4*)(of + (size_t)m * D) + lane;
#pragma unroll
            for (int j = 0; j < 8; ++j) o[64 * j] = (f32x4){v[j].x * rstd * gg[j].x, v[j].y * rstd * gg[j].y, v[j].z * rstd * gg[j].z, v[j].w * rstd * gg[j].w}; }
        else { v2u* o8 = (v2u*)(ob + (size_t)m * D) + lane;
#pragma unroll
            for (int j = 0; j < 8; ++j) { v2u w; w.x = cvt_pk_bf16(v[j].x * rstd * gg[j].x, v[j].y * rstd * gg[j].y); w.y = cvt_pk_bf16(v[j].z * rstd * gg[j].z, v[j].w * rstd * gg[j].w); o8[64 * j] = w; } }
    }
}
__device__ __forceinline__ void scale_rows(const bf16* xg, const unsigned long long* ss, float* out, int gw, int NGW, int lane) {
    v4u nv[4]; float ns;
    { const v4u* xr = (const v4u*)(xg + (size_t)gw * D) + lane; ns = (float)ss[gw];
#pragma unroll
      for (int j = 0; j < 4; ++j) nv[j] = xr[64 * j]; }
    for (int m = gw; m < M; m += NGW) { v4u v[4]; const float rstd = 1.0f / sqrtf(ns * (1.f / (16777216.0f * D)) + RMS_EPS);
#pragma unroll
        for (int j = 0; j < 4; ++j) v[j] = nv[j];
        { const int mn = m + NGW < M ? m + NGW : m; const v4u* xr = (const v4u*)(xg + (size_t)mn * D) + lane; ns = (float)ss[mn];
#pragma unroll
          for (int j = 0; j < 4; ++j) nv[j] = xr[64 * j]; }
        f32x4* o = (f32x4*)(out + (size_t)m * D) + 2 * lane;
#pragma unroll
        for (int j = 0; j < 4; ++j) { o[128 * j] = (f32x4){bf_lo(v[j].x) * rstd, bf_hi(v[j].x) * rstd, bf_lo(v[j].y) * rstd, bf_hi(v[j].y) * rstd};
            o[128 * j + 1] = (f32x4){bf_lo(v[j].z) * rstd, bf_hi(v[j].z) * rstd, bf_lo(v[j].w) * rstd, bf_hi(v[j].w) * rstd}; } }
}
__device__ __forceinline__ void ld8bf(const bf16* p, bool ok, float (&o)[8]) {
    v4u w = (v4u){0u, 0u, 0u, 0u}; if (ok) w = *(const v4u*)p;
    o[0] = bf_lo(w.x); o[1] = bf_hi(w.x); o[2] = bf_lo(w.y); o[3] = bf_hi(w.y); o[4] = bf_lo(w.z); o[5] = bf_hi(w.z); o[6] = bf_lo(w.w); o[7] = bf_hi(w.w);
}
__device__ __forceinline__ void shift8(const bf16* base, size_t ld, size_t row, int t, const float* mu, float (&o)[8]) {
    float c[8], p[8], n[8];
    ld8bf(base + row * ld, true, c); ld8bf(base + (row - 1) * ld, t > 0, p); ld8bf(base + (row + 1) * ld, t < SEQL - 1, n);
    const f32x4 m0 = *(const f32x4*)mu, m1 = *(const f32x4*)(mu + 4);
#pragma unroll
    for (int j = 0; j < 8; ++j) { const float mm = j < 4 ? m0[j] : m1[j - 4]; o[j] = c[j] + (0.5f * (p[j] + n[j]) - c[j]) * mm; }
}

constexpr int RC = 32;
constexpr int RW_R = 0, RW_KD = 8192, RW_V = 16384, RW_KK = 24576, RW_W = 32768, RW_B = 40960, RW_Y = 49152, RW_TW = 57344, RW_AL = 61952, RW_INV = 66560;
struct RwkvP { const bf16* RKV; const bf16* SMALL; const float *mu, *w0, *w2, *a0, *a2, *k_k, *k_a, *r_k; _Float16* Y; float* BON; };
__device__ __forceinline__ void rwkv_chain(LAS unsigned char* lds, const RwkvP& P, int seq, int h, int d, int tid, int lane, int wave) {
    LAS float* sR = (LAS float*)(lds + RW_R); LAS float* sKD = (LAS float*)(lds + RW_KD); LAS float* sV = (LAS float*)(lds + RW_V); LAS float* sKK = (LAS float*)(lds + RW_KK);
    LAS float* sW = (LAS float*)(lds + RW_W); LAS float* sB = (LAS float*)(lds + RW_B); LAS float* sY = (LAS float*)(lds + RW_Y); LAS float* sINV = (LAS float*)(lds + RW_INV);
    LAS bf16* sTW = (LAS bf16*)(lds + RW_TW); LAS bf16* sAL = (LAS bf16*)(lds + RW_AL);
    const int mi = wave >> 2, ni = wave & 3, fr = lane & 15, fq = lane >> 4;
    const int cc = h * HD + ni * 16 + fr;
    bf16x8 Bw[2], Ba[2];
#pragma unroll
    for (int ks = 0; ks < 2; ++ks) { unsigned w[4], a[4];
#pragma unroll
        for (int j = 0; j < 4; ++j) { const int k0 = ks * 32 + fq * 8 + 2 * j; const size_t i0 = (size_t)(d * 64 + k0) * RW + cc, i1 = i0 + RW;
            w[j] = cvt_pk_bf16(P.w2[i0], P.w2[i1]); a[j] = cvt_pk_bf16(P.a2[i0], P.a2[i1]); }
        Bw[ks] = __builtin_bit_cast(bf16x8, (v4u){w[0], w[1], w[2], w[3]}); Ba[ks] = __builtin_bit_cast(bf16x8, (v4u){a[0], a[1], a[2], a[3]}); }
    const float w0c = P.w0[d * RW + cc], a0c = P.a0[d * RW + cc], kkc = P.k_k[cc], kac = P.k_a[cc];
    const int ke = lane & 7, srow = wave * 8 + (lane >> 3);
    float S[8];
#pragma unroll
    for (int j = 0; j < 8; ++j) S[j] = 0.f;
    const int st_t = tid >> 4, st_s = tid & 15;
    float kk4[4], rk4[4];
#pragma unroll
    for (int j = 0; j < 4; ++j) { kk4[j] = P.k_k[h * HD + st_s * 4 + j]; rk4[j] = P.r_k[h * HD + st_s * 4 + j]; }

    for (int ci = 0; ci < SEQL / RC; ++ci) {
        const int t0 = (d ? (SEQL / RC - 1 - ci) : ci) * RC;
        for (int p = tid; p < RC * 40; p += NWAVES * 64) {
            const int t = p / 40, rem = p - t * 40, seg = rem >> 3, c8 = (rem & 7) * 8; const int tt = t0 + t; const size_t row = (size_t)seq * SEQL + tt;
            float o[8];
            if (seg < 3) { const int col = seg * RW + h * HD + c8; shift8(P.RKV + col, RKW, row, tt, P.mu + col, o);
                LAS float* dst = (seg == 0 ? sR : (seg == 1 ? sKD : sV)) + t * 64 + c8;
                *(LAS f32x4*)dst = (f32x4){o[0], o[1], o[2], o[3]}; *(LAS f32x4*)(dst + 4) = (f32x4){o[4], o[5], o[6], o[7]}; }
            else { const int scol = (seg == 3 ? SM_WLOW : SM_ALOW) + d * 64 + c8, mcol = (seg == 3 ? MU_WLOW : MU_ALOW) + d * 64 + c8;
                shift8(P.SMALL + scol, SMW, row, tt, P.mu + mcol, o);
                if (seg == 3) {
#pragma unroll
                    for (int j = 0; j < 8; ++j) o[j] = ftanh(o[j]); }
                v4u w; w.x = cvt_pk_bf16(o[0], o[1]); w.y = cvt_pk_bf16(o[2], o[3]); w.z = cvt_pk_bf16(o[4], o[5]); w.w = cvt_pk_bf16(o[6], o[7]);
                *(LAS v4u*)((seg == 3 ? sTW : sAL) + t * 72 + c8) = w; }
        }
        __syncthreads();
        { float s = 0.f;
#pragma unroll
          for (int j = 0; j < 4; ++j) { const float q = sKD[st_t * 64 + st_s * 4 + j] * kk4[j]; s += q * q; }
          s = red16(s); if (st_s == 0) sINV[st_t] = 1.0f / sqrtf(s + 1e-12f); }
        f32x4 accw = (f32x4){0.f, 0.f, 0.f, 0.f}, acca = accw;
#pragma unroll
        for (int ks = 0; ks < 2; ++ks) { const bf16x8 aw = *(const LAS bf16x8*)(sTW + (mi * 16 + fr) * 72 + ks * 32 + fq * 8), aa = *(const LAS bf16x8*)(sAL + (mi * 16 + fr) * 72 + ks * 32 + fq * 8);
            accw = __builtin_amdgcn_mfma_f32_16x16x32_bf16(aw, Bw[ks], accw, 0, 0, 0); acca = __builtin_amdgcn_mfma_f32_16x16x32_bf16(aa, Ba[ks], acca, 0, 0, 0); }
        __syncthreads();
#pragma unroll
        for (int i = 0; i < 4; ++i) { const int t = mi * 16 + fq * 4 + i, c = ni * 16 + fr;
            const float wv = __builtin_amdgcn_exp2f(-0.875035265f * fsigmoid(accw[i] + w0c));
            const float av = fsigmoid(acca[i] + a0c);
            const float kr = sKD[t * 64 + c], kkv = kr * kkc * sINV[t];
            sW[t * 64 + c] = wv; sKK[t * 64 + c] = kkv; sB[t * 64 + c] = kkv * av; sKD[t * 64 + c] = kr * (1.0f + (av - 1.0f) * kac); }
        __syncthreads();
        { float s = 0.f;
#pragma unroll
          for (int j = 0; j < 4; ++j) s += sR[st_t * 64 + st_s * 4 + j] * sKD[st_t * 64 + st_s * 4 + j] * rk4[j];
          s = red16(s); if (st_s == 0) P.BON[((size_t)d * M + (size_t)seq * SEQL + t0 + st_t) * NH + h] = s; }
#pragma unroll 2
        for (int s = 0; s < RC; ++s) { const int t = d ? RC - 1 - s : s; const int o = t * 64 + ke * 8;
            const f32x4 k0 = *(const LAS f32x4*)(sKK + o), k1 = *(const LAS f32x4*)(sKK + o + 4), w0 = *(const LAS f32x4*)(sW + o), w1 = *(const LAS f32x4*)(sW + o + 4);
            const f32x4 b0 = *(const LAS f32x4*)(sB + o), b1 = *(const LAS f32x4*)(sB + o + 4), d0 = *(const LAS f32x4*)(sKD + o), d1 = *(const LAS f32x4*)(sKD + o + 4);
            const f32x4 r0 = *(const LAS f32x4*)(sR + o), r1 = *(const LAS f32x4*)(sR + o + 4); const float vv = sV[t * 64 + srow];
            float sa0 = S[0] * k0[0], sa1 = S[4] * k1[0];
#pragma unroll
            for (int j = 1; j < 4; ++j) { sa0 += S[j] * k0[j]; sa1 += S[4 + j] * k1[j]; }
            const float sa = -red8(sa0 + sa1);
            float y0 = 0.f, y1 = 0.f;
#pragma unroll
            for (int j = 0; j < 4; ++j) { S[j] = S[j] * w0[j] + (sa * b0[j] + vv * d0[j]); S[4 + j] = S[4 + j] * w1[j] + (sa * b1[j] + vv * d1[j]); y0 += S[j] * r0[j]; y1 += S[4 + j] * r1[j]; }
            const float y = red8(y0 + y1);
            if (ke == 0) sY[t * 64 + srow] = y; }
        __syncthreads();
        { const f32x4 yv = *(const LAS f32x4*)(sY + st_t * 64 + st_s * 4); h16x4 o; o[0] = (_Float16)yv[0]; o[1] = (_Float16)yv[1]; o[2] = (_Float16)yv[2]; o[3] = (_Float16)yv[3];
          *(h16x4*)(P.Y + ((size_t)seq * SEQL + t0 + st_t) * RW + h * HD + st_s * 4) = o; }
    }
}

constexpr int RW_AT = 66688, RW_RT = 71296, RW_BT = 75904, RW_KT = 80512, RW_BPT = 85120, RW_KPT = 89216, RW_VT = 93312, RW_LKA = 97408, RW_LRB = 98432, RW_LRK = 99456, RW_NTI = 100480, RW_LBA = 101504, RW_LAM = 103552;
__device__ __forceinline__ float quad_bcast(float v, const int n) { const int x = __builtin_bit_cast(int, v); int r;
    if (n == 0) r = __builtin_amdgcn_update_dpp(x, x, 0x00, 0xF, 0xF, false); else if (n == 1) r = __builtin_amdgcn_update_dpp(x, x, 0x55, 0xF, 0xF, false);
    else if (n == 2) r = __builtin_amdgcn_update_dpp(x, x, 0xAA, 0xF, 0xF, false); else r = __builtin_amdgcn_update_dpp(x, x, 0xFF, 0xF, 0xF, false);
    return __builtin_bit_cast(float, r); }
__device__ __forceinline__ bf16x4 pk4(float a, float b, float c, float d) { return __builtin_bit_cast(bf16x4, (v2u){cvt_pk_bf16(a, b), cvt_pk_bf16(c, d)}); }
__device__ __forceinline__ bf16x8 cat8(bf16x4 lo, bf16x4 hi) { return __builtin_shufflevector(lo, hi, 0, 1, 2, 3, 4, 5, 6, 7); }
__device__ __forceinline__ void rwkv_chain2(LAS unsigned char* lds, const RwkvP& P, int seq, int h, int d, int tid, int lane, int wave) {
    LAS float* sR = (LAS float*)(lds + RW_R); LAS float* sKD = (LAS float*)(lds + RW_KD); LAS float* sV = (LAS float*)(lds + RW_V); LAS float* sKK = (LAS float*)(lds + RW_KK);
    LAS float* sW = (LAS float*)(lds + RW_W); LAS float* sB = (LAS float*)(lds + RW_B); LAS float* sY = (LAS float*)(lds + RW_Y); LAS float* sINV = (LAS float*)(lds + RW_INV);
    LAS bf16* sTW = (LAS bf16*)(lds + RW_TW); LAS bf16* sAL = (LAS bf16*)(lds + RW_AL);
    LAS bf16* AT = (LAS bf16*)(lds + RW_AT); LAS bf16* RT = (LAS bf16*)(lds + RW_RT); LAS bf16* BT = (LAS bf16*)(lds + RW_BT); LAS bf16* KT = (LAS bf16*)(lds + RW_KT);
    LAS bf16* BPT = (LAS bf16*)(lds + RW_BPT); LAS bf16* KPT = (LAS bf16*)(lds + RW_KPT); LAS bf16* VT = (LAS bf16*)(lds + RW_VT);
    LAS bf16* LKA = (LAS bf16*)(lds + RW_LKA); LAS bf16* LRB = (LAS bf16*)(lds + RW_LRB); LAS bf16* LRK = (LAS bf16*)(lds + RW_LRK); LAS bf16* NTI = (LAS bf16*)(lds + RW_NTI);
    LAS float* LBA = (LAS float*)(lds + RW_LBA); LAS float* LAM = (LAS float*)(lds + RW_LAM);
    const int mi = wave >> 2, ni = wave & 3, fr = lane & 15, fq = lane >> 4;
    const int cc = h * HD + ni * 16 + fr;
    bf16x8 Bw[2], Ba[2];
#pragma unroll
    for (int ks = 0; ks < 2; ++ks) { unsigned w[4], a[4];
#pragma unroll
        for (int j = 0; j < 4; ++j) { const int k0 = ks * 32 + fq * 8 + 2 * j; const size_t i0 = (size_t)(d * 64 + k0) * RW + cc, i1 = i0 + RW;
            w[j] = cvt_pk_bf16(P.w2[i0], P.w2[i1]); a[j] = cvt_pk_bf16(P.a2[i0], P.a2[i1]); }
        Bw[ks] = __builtin_bit_cast(bf16x8, (v4u){w[0], w[1], w[2], w[3]}); Ba[ks] = __builtin_bit_cast(bf16x8, (v4u){a[0], a[1], a[2], a[3]}); }
    const float w0c = P.w0[d * RW + cc], a0c = P.a0[d * RW + cc], kkc = P.k_k[cc], kac = P.k_a[cc];
    const int st_t = tid >> 4, st_s = tid & 15;
    float kk4[4], rk4[4];
#pragma unroll
    for (int j = 0; j < 4; ++j) { kk4[j] = P.k_k[h * HD + st_s * 4 + j]; rk4[j] = P.r_k[h * HD + st_s * 4 + j]; }
    f32x4 S[4]; bf16x8 Sb[2];
#pragma unroll
    for (int kt = 0; kt < 4; ++kt) S[kt] = (f32x4){0.f, 0.f, 0.f, 0.f};
    Sb[0] = (bf16x8){0, 0, 0, 0, 0, 0, 0, 0}; Sb[1] = Sb[0];

    for (int ci = 0; ci < SEQL / RC; ++ci) {
        const int t0 = (d ? (SEQL / RC - 1 - ci) : ci) * RC;
        for (int p = tid; p < RC * 40; p += NWAVES * 64) {
            const int t = p / 40, rem = p - t * 40, seg = rem >> 3, c8 = (rem & 7) * 8; const int tt = t0 + (d ? RC - 1 - t : t); const size_t row = (size_t)seq * SEQL + tt;
            float o[8];
            if (seg < 3) { const int col = seg * RW + h * HD + c8; shift8(P.RKV + col, RKW, row, tt, P.mu + col, o);
                LAS float* dst = (seg == 0 ? sR : (seg == 1 ? sKD : sV)) + t * 64 + c8;
                *(LAS f32x4*)dst = (f32x4){o[0], o[1], o[2], o[3]}; *(LAS f32x4*)(dst + 4) = (f32x4){o[4], o[5], o[6], o[7]}; }
            else { const int scol = (seg == 3 ? SM_WLOW : SM_ALOW) + d * 64 + c8, mcol = (seg == 3 ? MU_WLOW : MU_ALOW) + d * 64 + c8;
                shift8(P.SMALL + scol, SMW, row, tt, P.mu + mcol, o);
                if (seg == 3) {
#pragma unroll
                    for (int j = 0; j < 8; ++j) o[j] = ftanh(o[j]); }
                v4u w; w.x = cvt_pk_bf16(o[0], o[1]); w.y = cvt_pk_bf16(o[2], o[3]); w.z = cvt_pk_bf16(o[4], o[5]); w.w = cvt_pk_bf16(o[6], o[7]);
                *(LAS v4u*)((seg == 3 ? sTW : sAL) + t * 72 + c8) = w; }
        }
        __syncthreads();
        { float s = 0.f;
#pragma unroll
          for (int j = 0; j < 4; ++j) { const float q = sKD[st_t * 64 + st_s * 4 + j] * kk4[j]; s += q * q; }
          s = red16(s); if (st_s == 0) sINV[st_t] = 1.0f / sqrtf(s + 1e-12f); }
        f32x4 accw = (f32x4){0.f, 0.f, 0.f, 0.f}, acca = accw;
#pragma unroll
        for (int ks = 0; ks < 2; ++ks) { const bf16x8 aw = *(const LAS bf16x8*)(sTW + (mi * 16 + fr) * 72 + ks * 32 + fq * 8), aa = *(const LAS bf16x8*)(sAL + (mi * 16 + fr) * 72 + ks * 32 + fq * 8);
            accw = __builtin_amdgcn_mfma_f32_16x16x32_bf16(aw, Bw[ks], accw, 0, 0, 0); acca = __builtin_amdgcn_mfma_f32_16x16x32_bf16(aa, Ba[ks], acca, 0, 0, 0); }
        __syncthreads();
#pragma unroll
        for (int i = 0; i < 4; ++i) { const int t = mi * 16 + fq * 4 + i, c = ni * 16 + fr;
            const float lw = -0.875035265f * fsigmoid(accw[i] + w0c);
            const float av = fsigmoid(acca[i] + a0c);
            const float kr = sKD[t * 64 + c], kkv = kr * kkc * sINV[t];
            sW[t * 64 + c] = lw; sKK[t * 64 + c] = kkv; sB[t * 64 + c] = kkv * av; sKD[t * 64 + c] = kr * (1.0f + (av - 1.0f) * kac); }
        __syncthreads();
        { float s = 0.f;
#pragma unroll
          for (int j = 0; j < 4; ++j) s += sR[st_t * 64 + st_s * 4 + j] * sKD[st_t * 64 + st_s * 4 + j] * rk4[j];
          s = red16(s); if (st_s == 0) P.BON[((size_t)d * M + (size_t)seq * SEQL + t0 + (d ? RC - 1 - st_t : st_t)) * NH + h] = s; }
        { const int c = tid >> 8, k = (tid >> 2) & 63, qq = tid & 3, sb = 16 * c + 4 * qq;
          float lw[4], cum[4];
#pragma unroll
          for (int i = 0; i < 4; ++i) lw[i] = sW[(sb + i) * 64 + k];
          cum[0] = lw[0]; cum[1] = cum[0] + lw[1]; cum[2] = cum[1] + lw[2]; cum[3] = cum[2] + lw[3];
          const float q0 = quad_bcast(cum[3], 0), q1 = quad_bcast(cum[3], 1), q2 = quad_bcast(cum[3], 2), q3 = quad_bcast(cum[3], 3);
          const float off = (qq > 0 ? q0 : 0.f) + (qq > 1 ? q1 : 0.f) + (qq > 2 ? q2 : 0.f), c15 = (q0 + q1) + (q2 + q3);
          float bp[4], kp[4], vv[4];
#pragma unroll
          for (int i = 0; i < 4; ++i) { const int s = sb + i, sl = 4 * qq + i; const float cs = off + cum[i];
              const float lam = __builtin_amdgcn_exp2f(cs), ilam = __builtin_amdgcn_exp2f(-cs), lprev = __builtin_amdgcn_exp2f(cs - lw[i]), rat = __builtin_amdgcn_exp2f(c15 - cs);
              const float kkv = sKK[s * 64 + k], bv = sB[s * 64 + k], kd = sKD[s * 64 + k], rv = sR[s * 64 + k];
              AT[(c * 16 + sl) * 72 + k] = (bf16)f2bf(kkv * lprev); RT[(c * 16 + sl) * 72 + k] = (bf16)f2bf(rv * lam); BT[(c * 16 + sl) * 72 + k] = (bf16)f2bf(bv * ilam); KT[(c * 16 + sl) * 72 + k] = (bf16)f2bf(kd * ilam);
              bp[i] = bv * rat; kp[i] = kd * rat; vv[i] = sV[s * 64 + k]; }
          *(LAS bf16x4*)(BPT + (c * 64 + k) * 16 + 4 * qq) = pk4(bp[0], bp[1], bp[2], bp[3]); *(LAS bf16x4*)(KPT + (c * 64 + k) * 16 + 4 * qq) = pk4(kp[0], kp[1], kp[2], kp[3]);
          *(LAS bf16x4*)(VT + (c * 64 + k) * 16 + 4 * qq) = pk4(vv[0], vv[1], vv[2], vv[3]);
          if (qq == 0) LAM[c * 64 + k] = __builtin_amdgcn_exp2f(c15); }
        __syncthreads();
        { const int c = wave >> 2, mat = wave & 3; const LAS bf16* Ax = (mat < 2 ? AT : RT) + c * 16 * 72; const LAS bf16* Bx = ((mat & 1) == 0 ? BT : KT) + c * 16 * 72;
          f32x4 acc = (f32x4){0.f, 0.f, 0.f, 0.f};
#pragma unroll
          for (int ks = 0; ks < 2; ++ks) { const bf16x8 a = *(const LAS bf16x8*)(Ax + fr * 72 + ks * 32 + fq * 8), b = *(const LAS bf16x8*)(Bx + fr * 72 + ks * 32 + fq * 8);
              acc = __builtin_amdgcn_mfma_f32_16x16x32_bf16(a, b, acc, 0, 0, 0); }
#pragma unroll
          for (int i = 0; i < 4; ++i) { const int s = 4 * fq + i, j = fr; const bool keep = mat < 2 ? (j < s) : (j <= s); const float v = keep ? acc[i] : 0.f;
              if (mat == 0) LBA[c * 256 + s * 16 + j] = v; else (mat == 1 ? LKA : (mat == 2 ? LRB : LRK))[c * 256 + s * 16 + j] = (bf16)f2bf(v); } }
        __syncthreads();
        if (wave == 0 && lane < 32) { const int c = lane >> 4, col = lane & 15; float T[16];
#pragma unroll
            for (int s = 0; s < 16; ++s) { float t = (s == col) ? 1.0f : 0.f;
                const LAS float* Lr = LBA + c * 256 + s * 16;
#pragma unroll
                for (int j = 0; j < s; ++j) t -= Lr[j] * T[j];
                T[s] = t; NTI[c * 256 + s * 16 + col] = (bf16)f2bf(-t); } }
        __syncthreads();
        if (wave < 4) {
#pragma unroll
            for (int c = 0; c < 2; ++c) {
                const bf16x4 vt = *(const LAS bf16x4*)(VT + (c * 64 + 16 * wave + fr) * 16 + 4 * fq);
                f32x4 w1 = __builtin_amdgcn_mfma_f32_16x16x16bf16_1k(*(const LAS bf16x4*)(LKA + c * 256 + fr * 16 + 4 * fq), vt, (f32x4){0.f, 0.f, 0.f, 0.f}, 0, 0, 0);
                f32x4 y = __builtin_amdgcn_mfma_f32_16x16x16bf16_1k(*(const LAS bf16x4*)(LRK + c * 256 + fr * 16 + 4 * fq), vt, (f32x4){0.f, 0.f, 0.f, 0.f}, 0, 0, 0);
#pragma unroll
                for (int ks = 0; ks < 2; ++ks) { const LAS bf16* ar = AT + (c * 16 + fr) * 72 + 32 * ks + 4 * fq; const LAS bf16* rr = RT + (c * 16 + fr) * 72 + 32 * ks + 4 * fq;
                    w1 = __builtin_amdgcn_mfma_f32_16x16x32_bf16(cat8(*(const LAS bf16x4*)ar, *(const LAS bf16x4*)(ar + 16)), Sb[ks], w1, 0, 0, 0);
                    y = __builtin_amdgcn_mfma_f32_16x16x32_bf16(cat8(*(const LAS bf16x4*)rr, *(const LAS bf16x4*)(rr + 16)), Sb[ks], y, 0, 0, 0); }
                const f32x4 sa = __builtin_amdgcn_mfma_f32_16x16x16bf16_1k(*(const LAS bf16x4*)(NTI + c * 256 + fr * 16 + 4 * fq), pk4(w1[0], w1[1], w1[2], w1[3]), (f32x4){0.f, 0.f, 0.f, 0.f}, 0, 0, 0);
                const bf16x4 sab = pk4(sa[0], sa[1], sa[2], sa[3]);
                y = __builtin_amdgcn_mfma_f32_16x16x16bf16_1k(*(const LAS bf16x4*)(LRB + c * 256 + fr * 16 + 4 * fq), sab, y, 0, 0, 0);
#pragma unroll
                for (int i = 0; i < 4; ++i) sY[(16 * c + 4 * fq + i) * 64 + 16 * wave + fr] = y[i];
#pragma unroll
                for (int kt = 0; kt < 4; ++kt) { const f32x4 lm = *(const LAS f32x4*)(LAM + c * 64 + 16 * kt + 4 * fq); f32x4 sn = S[kt] * lm;
                    sn = __builtin_amdgcn_mfma_f32_16x16x16bf16_1k(*(const LAS bf16x4*)(BPT + (c * 64 + 16 * kt + fr) * 16 + 4 * fq), sab, sn, 0, 0, 0);
                    sn = __builtin_amdgcn_mfma_f32_16x16x16bf16_1k(*(const LAS bf16x4*)(KPT + (c * 64 + 16 * kt + fr) * 16 + 4 * fq), vt, sn, 0, 0, 0);
                    S[kt] = sn; }
#pragma unroll
                for (int ks = 0; ks < 2; ++ks) Sb[ks] = cat8(pk4(S[2 * ks][0], S[2 * ks][1], S[2 * ks][2], S[2 * ks][3]), pk4(S[2 * ks + 1][0], S[2 * ks + 1][1], S[2 * ks + 1][2], S[2 * ks + 1][3]));
            }
        }
        __syncthreads();
        { const f32x4 yv = *(const LAS f32x4*)(sY + st_t * 64 + st_s * 4); h16x4 o; o[0] = (_Float16)yv[0]; o[1] = (_Float16)yv[1]; o[2] = (_Float16)yv[2]; o[3] = (_Float16)yv[3];
          *(h16x4*)(P.Y + ((size_t)seq * SEQL + t0 + (d ? RC - 1 - st_t : st_t)) * RW + h * HD + st_s * 4) = o; }
    }
}

constexpr int C3_MU = 115840, C3_KK = 117120, C3_TSCR = 117376, C3_RAW = 118912;
static_assert(C3_RAW + 32 * 656 <= LDSCTL_OFF && 32 * 656 <= 24576, "rwkv LDS map");
constexpr int C3_R = 0, C3_KR = 8192, C3_V = 16384, C3_TW = 24576, C3_AL = 29184, C3_INV = 33792, C3_BONP = 33920  , C3_Y = 34944, C3_LBA = 43136, C3_LX = 45184, C3_TB = 53376, C3_TBSZ = 31232;
constexpr int T_AT = 0, T_RT = 4608, T_BT = 9216, T_KT = 13824, T_BPT = 18432, T_KPT = 22528, T_VT = 26624, T_LAM = 30720, X_LKA = 0, X_LRB = 1024, X_LRK = 2048, X_NTI = 3072;
__device__ __forceinline__ bf16 bf1(float x) { return __builtin_bit_cast(bf16, (__bf16)x); }
__device__ __forceinline__ float bf2f_(bf16 b) { return __builtin_bit_cast(float, (unsigned)b << 16); }
__device__ __forceinline__ void rwkv_chain3(LAS unsigned char* lds, const RwkvP& P, int seq, int h, int d, int tid, int lane, int wave, const int probe) {
    LAS float* sR = (LAS float*)(lds + C3_R); LAS float* sKr = (LAS float*)(lds + C3_KR); LAS float* sV = (LAS float*)(lds + C3_V);
    LAS bf16* sTW = (LAS bf16*)(lds + C3_TW); LAS bf16* sAL = (LAS bf16*)(lds + C3_AL); LAS float* sINV = (LAS float*)(lds + C3_INV); LAS float* sBONP = (LAS float*)(lds + C3_BONP);
    LAS float* sY = (LAS float*)(lds + C3_Y); LAS float* LBA = (LAS float*)(lds + C3_LBA);
    constexpr int NR = SEQL / RC;
    const int mi = wave >> 2, ni = wave & 3, fr = lane & 15, fq = lane >> 4;
    const int cc = h * HD + ni * 16 + fr;
    bf16x8 Bw[2], Ba[2];
#pragma unroll
    for (int ks = 0; ks < 2; ++ks) { unsigned w[4], a[4];
#pragma unroll
        for (int j = 0; j < 4; ++j) { const int k0 = ks * 32 + fq * 8 + 2 * j; const size_t i0 = (size_t)(d * 64 + k0) * RW + cc, i1 = i0 + RW;
            w[j] = cvt_pk_bf16(P.w2[i0], P.w2[i1]); a[j] = cvt_pk_bf16(P.a2[i0], P.a2[i1]); }
        Bw[ks] = __builtin_bit_cast(bf16x8, (v4u){w[0], w[1], w[2], w[3]}); Ba[ks] = __builtin_bit_cast(bf16x8, (v4u){a[0], a[1], a[2], a[3]}); }
    const float w0c = P.w0[d * RW + cc], a0c = P.a0[d * RW + cc], kkc = P.k_k[cc], kac = P.k_a[cc], rkc = P.r_k[cc];
    const int st_t = tid >> 4, st_s = tid & 15;
    LAS float* sMU = (LAS float*)(lds + C3_MU); LAS float* sKK = (LAS float*)(lds + C3_KK);
    if (tid < 320) { const int sg = tid >> 6, c = tid & 63; sMU[tid] = P.mu[sg < 3 ? sg * RW + h * HD + c : (sg == 3 ? MU_WLOW : MU_ALOW) + d * 64 + c]; } else if (tid < 384) sKK[tid - 320] = P.k_k[h * HD + tid - 320];
    LAS bf16* sRAW0 = (LAS bf16*)(lds + C3_RAW); LAS bf16* sRAW1 = (LAS bf16*)(lds + C3_R);
    LAS float* sINVB = (LAS float*)(lds + C3_TW);
    int prr[3], pcol[3], psrc[3];
#pragma unroll
    for (int it = 0; it < 3; ++it) { const int p = tid + it * NWAVES * 64; const int rr = p / 40, rem = p - rr * 40, sg = rem >> 3, c8 = (rem & 7) * 8; prr[it] = rr; pcol[it] = sg * 64 + c8;
        psrc[it] = sg < 3 ? sg * RW + h * HD + c8 : (sg == 3 ? DS_TW : DS_AL) + d * 64 + c8; }
    v4u gc[3]; float ginv = 0.f;
#define C3_ISSUE(q) do { const int _t0 = (d ? (NR - 1 - (q)) : (q)) * RC; _Pragma("unroll") for (int it = 0; it < 3; ++it) { const int tt = _t0 + (d ? RC - 1 - prr[it] : prr[it]); \
        gc[it] = ((tid + it * NWAVES * 64) < RC * 40) ? *(const v4u*)(P.RKV + ((size_t)seq * SEQL + tt) * DSW + psrc[it]) : (v4u){0u, 0u, 0u, 0u}; } \
        if (tid < RC) ginv = ((const float*)(P.RKV + ((size_t)seq * SEQL + _t0 + (d ? RC - 1 - tid : tid)) * DSW + DS_INV))[h]; } while (0)
#define C3_RAWWR(q) do { LAS bf16* sRAW = ((q) & 1) ? sRAW1 : sRAW0; _Pragma("unroll") for (int it = 0; it < 3; ++it) if ((tid + it * NWAVES * 64) < RC * 40) *(LAS v4u*)(sRAW + prr[it] * 328 + pcol[it]) = gc[it]; \
        if (tid < RC) sINVB[((q) & 1) * 32 + tid] = ginv; } while (0)
    f32x4 S[4]; bf16x8 Sb[2];
#pragma unroll
    for (int kt = 0; kt < 4; ++kt) S[kt] = (f32x4){0.f, 0.f, 0.f, 0.f};
    Sb[0] = (bf16x8){0, 0, 0, 0, 0, 0, 0, 0}; Sb[1] = Sb[0];
    const int vw = wave & 3;
    C3_ISSUE(0); C3_RAWWR(0); C3_ISSUE(1);
    __syncthreads();
    for (int i = 0; i <= NR + 1; ++i) {
        if (i + 1 < NR) C3_RAWWR(i + 1);
        if (i + 2 < NR) C3_ISSUE(i + 2);
        if (i >= 2 && probe == 0) { const int q = i - 2, t0 = (d ? (NR - 1 - q) : q) * RC;
            const f32x4 yv = *(const LAS f32x4*)(sY + st_t * 64 + st_s * 4); h16x4 o; o[0] = (_Float16)yv[0]; o[1] = (_Float16)yv[1]; o[2] = (_Float16)yv[2]; o[3] = (_Float16)yv[3];
            *(h16x4*)(P.Y + ((size_t)seq * SEQL + t0 + (d ? RC - 1 - st_t : st_t)) * RW + h * HD + st_s * 4) = o; }
        if (i >= 1 && i <= NR && tid < RC && probe == 0) { const int q = i - 1, t0 = (d ? (NR - 1 - q) : q) * RC; const f32x4 b = *(const LAS f32x4*)(sBONP + ((i - 1) & 1) * 128 + tid * 4);
            P.BON[((size_t)d * M + (size_t)seq * SEQL + t0 + (d ? RC - 1 - tid : tid)) * NH + h] = (b[0] + b[1]) + (b[2] + b[3]); }
        if (i < NR && probe != 3) { LAS unsigned char* tb = lds + C3_TB + (i & 1) * C3_TBSZ;
            LAS bf16* AT = (LAS bf16*)(tb + T_AT); LAS bf16* RT = (LAS bf16*)(tb + T_RT); LAS bf16* BT = (LAS bf16*)(tb + T_BT); LAS bf16* KT = (LAS bf16*)(tb + T_KT);
            LAS bf16* BPT = (LAS bf16*)(tb + T_BPT); LAS bf16* KPT = (LAS bf16*)(tb + T_KPT); LAS bf16* VT = (LAS bf16*)(tb + T_VT); LAS float* LAM = (LAS float*)(tb + T_LAM);
            f32x4 accw = (f32x4){0.f, 0.f, 0.f, 0.f}, acca = accw;
            const LAS bf16* rawb = (i & 1) ? sRAW1 : sRAW0; const LAS float* invb = sINVB + (i & 1) * 32;
#pragma unroll
            for (int ks = 0; ks < 2; ++ks) { const bf16x8 aw = *(const LAS bf16x8*)(rawb + (mi * 16 + fr) * 328 + 192 + ks * 32 + fq * 8), aa = *(const LAS bf16x8*)(rawb + (mi * 16 + fr) * 328 + 256 + ks * 32 + fq * 8);
                accw = __builtin_amdgcn_mfma_f32_16x16x32_bf16(aw, Bw[ks], accw, 0, 0, 0); acca = __builtin_amdgcn_mfma_f32_16x16x32_bf16(aa, Ba[ks], acca, 0, 0, 0); }
            const int c = mi, k = ni * 16 + fr;
            float lw[4], kkv[4], bv[4], kd[4], rv[4], vv[4], cum[4]; float bon[4];
#pragma unroll
            for (int j = 0; j < 4; ++j) { const int s = 16 * c + 4 * fq + j;
                lw[j] = -0.875035265f * fsigmoid(accw[j] + w0c); const float av = fsigmoid(acca[j] + a0c);
                const float kr = bf2f_(rawb[s * 328 + 64 + k]); kkv[j] = kr * kkc * invb[s]; bv[j] = kkv[j] * av; kd[j] = kr * (1.0f + (av - 1.0f) * kac); rv[j] = bf2f_(rawb[s * 328 + k]); vv[j] = bf2f_(rawb[s * 328 + 128 + k]);
                bon[j] = rv[j] * kd[j] * rkc; }
            cum[0] = lw[0]; cum[1] = cum[0] + lw[1]; cum[2] = cum[1] + lw[2]; cum[3] = cum[2] + lw[3];
            const float q0 = __shfl(cum[3], fr), q1 = __shfl(cum[3], fr + 16), q2 = __shfl(cum[3], fr + 32), q3 = __shfl(cum[3], fr + 48);
            const float off = (fq > 0 ? q0 : 0.f) + (fq > 1 ? q1 : 0.f) + (fq > 2 ? q2 : 0.f), c15 = (q0 + q1) + (q2 + q3);
            float bp[4], kp[4];
#pragma unroll
            for (int j = 0; j < 4; ++j) { const int sl = 4 * fq + j; const float cs = off + cum[j];
                const float lam = __builtin_amdgcn_exp2f(cs), ilam = __builtin_amdgcn_exp2f(-cs), lprev = __builtin_amdgcn_exp2f(cs - lw[j]), rat = __builtin_amdgcn_exp2f(c15 - cs);
                AT[(c * 16 + sl) * 72 + k] = bf1(kkv[j] * lprev); RT[(c * 16 + sl) * 72 + k] = bf1(rv[j] * lam); BT[(c * 16 + sl) * 72 + k] = bf1(bv[j] * ilam); KT[(c * 16 + sl) * 72 + k] = bf1(kd[j] * ilam);
                bp[j] = bv[j] * rat; kp[j] = kd[j] * rat; }
            *(LAS bf16x4*)(BPT + (c * 64 + k) * 16 + 4 * fq) = pk4(bp[0], bp[1], bp[2], bp[3]); *(LAS bf16x4*)(KPT + (c * 64 + k) * 16 + 4 * fq) = pk4(kp[0], kp[1], kp[2], kp[3]);
            *(LAS bf16x4*)(VT + (c * 64 + k) * 16 + 4 * fq) = pk4(vv[0], vv[1], vv[2], vv[3]);
            if (fq == 0) LAM[c * 64 + k] = __builtin_amdgcn_exp2f(c15);
#pragma unroll
            for (int j = 0; j < 4; ++j) { const float s = red16(bon[j]); if (fr == 0) sBONP[(i & 1) * 128 + (16 * c + 4 * fq + j) * 4 + ni] = s; }
        }
        __syncthreads();
#pragma unroll
        for (int half = 0; half < 2; ++half) {
            if (wave < 4) {
                if (i < NR && probe != 2) { LAS unsigned char* tb = lds + C3_TB + (i & 1) * C3_TBSZ; LAS unsigned char* lx = lds + C3_LX + (i & 1) * 4096; (void)tb;
                    if (half == 0)
                    { const int mat = wave; const LAS bf16* Ax0 = (const LAS bf16*)(tb + (mat < 2 ? T_AT : T_RT)); const LAS bf16* Bx0 = (const LAS bf16*)(tb + ((mat & 1) == 0 ? T_BT : T_KT));
#pragma unroll
                        for (int c = 0; c < 2; ++c) { const LAS bf16* Ax = Ax0 + c * 16 * 72; const LAS bf16* Bx = Bx0 + c * 16 * 72; f32x4 acc = (f32x4){0.f, 0.f, 0.f, 0.f};
#pragma unroll
                            for (int ks = 0; ks < 2; ++ks) { const bf16x8 a = *(const LAS bf16x8*)(Ax + fr * 72 + ks * 32 + fq * 8), b = *(const LAS bf16x8*)(Bx + fr * 72 + ks * 32 + fq * 8);
                                acc = __builtin_amdgcn_mfma_f32_16x16x32_bf16(a, b, acc, 0, 0, 0); }
#pragma unroll
                            for (int j = 0; j < 4; ++j) { const int s = 4 * fq + j, jj = fr; const bool keep = mat < 2 ? (jj < s) : (jj <= s); const float v = keep ? acc[j] : 0.f;
                                if (mat == 0) LBA[c * 256 + s * 16 + jj] = v; else ((LAS bf16*)(lx + (mat == 1 ? X_LKA : (mat == 2 ? X_LRB : X_LRK))))[c * 256 + s * 16 + jj] = bf1(v); } } }
                    else
                    if (wave < 2) { const int c = wave; LAS bf16* NTI = (LAS bf16*)(lx + X_NTI) + c * 256; const LAS float* L = LBA + c * 256;
                        LAS float* TS = (LAS float*)(lds + C3_TSCR) + c * 192;
                        if (lane < 16) { const int blk = lane >> 3, col = lane & 7; float T[8];
#pragma unroll
                            for (int s = 0; s < 8; ++s) { float t = (s == col) ? 1.0f : 0.f; const LAS float* Lr = L + (8 * blk + s) * 16 + 8 * blk;
#pragma unroll
                                for (int j = 0; j < s; ++j) t -= Lr[j] * T[j];
                                T[s] = t; TS[blk * 64 + s * 8 + col] = t; NTI[(8 * blk + s) * 16 + 8 * blk + col] = bf1(-t); if (blk == 0) NTI[s * 16 + 8 + col] = (bf16)0; } }
                        LDS_WAIT(); __builtin_amdgcn_wave_barrier();
                        { const int r = lane >> 3, cq = lane & 7; float x = 0.f;
#pragma unroll
                          for (int j = 0; j < 8; ++j) x += L[(8 + r) * 16 + j] * TS[j * 8 + cq];
                          TS[128 + r * 8 + cq] = x; }
                        LDS_WAIT(); __builtin_amdgcn_wave_barrier();
                        { const int r = lane >> 3, cq = lane & 7; float y = 0.f;
#pragma unroll
                          for (int j = 0; j < 8; ++j) y += TS[64 + r * 8 + j] * TS[128 + j * 8 + cq];
                          NTI[(8 + r) * 16 + cq] = bf1(y); } }
                }
            } else {
            if (i >= 1 && i <= NR && probe != 1) { const int c = half; LAS unsigned char* tb = lds + C3_TB + ((i - 1) & 1) * C3_TBSZ; LAS unsigned char* lx = lds + C3_LX + ((i - 1) & 1) * 4096;
                const LAS bf16* AT = (const LAS bf16*)(tb + T_AT); const LAS bf16* RT = (const LAS bf16*)(tb + T_RT); const LAS bf16* BPT = (const LAS bf16*)(tb + T_BPT); const LAS bf16* KPT = (const LAS bf16*)(tb + T_KPT);
                const LAS bf16* VT = (const LAS bf16*)(tb + T_VT); const LAS float* LAM = (const LAS float*)(tb + T_LAM);
                const LAS bf16* LKA = (const LAS bf16*)(lx + X_LKA); const LAS bf16* LRB = (const LAS bf16*)(lx + X_LRB); const LAS bf16* LRK = (const LAS bf16*)(lx + X_LRK); const LAS bf16* NTI = (const LAS bf16*)(lx + X_NTI);
                const bf16x4 vt = *(const LAS bf16x4*)(VT + (c * 64 + 16 * vw + fr) * 16 + 4 * fq);
                f32x4 w1 = __builtin_amdgcn_mfma_f32_16x16x16bf16_1k(*(const LAS bf16x4*)(LKA + c * 256 + fr * 16 + 4 * fq), vt, (f32x4){0.f, 0.f, 0.f, 0.f}, 0, 0, 0);
                f32x4 y = __builtin_amdgcn_mfma_f32_16x16x16bf16_1k(*(const LAS bf16x4*)(LRK + c * 256 + fr * 16 + 4 * fq), vt, (f32x4){0.f, 0.f, 0.f, 0.f}, 0, 0, 0);
#pragma unroll
                for (int ks = 0; ks < 2; ++ks) { const LAS bf16* ar = AT + (c * 16 + fr) * 72 + 32 * ks + 4 * fq; const LAS bf16* rr = RT + (c * 16 + fr) * 72 + 32 * ks + 4 * fq;
                    w1 = __builtin_amdgcn_mfma_f32_16x16x32_bf16(cat8(*(const LAS bf16x4*)ar, *(const LAS bf16x4*)(ar + 16)), Sb[ks], w1, 0, 0, 0);
                    y = __builtin_amdgcn_mfma_f32_16x16x32_bf16(cat8(*(const LAS bf16x4*)rr, *(const LAS bf16x4*)(rr + 16)), Sb[ks], y, 0, 0, 0); }
                const f32x4 sa = __builtin_amdgcn_mfma_f32_16x16x16bf16_1k(*(const LAS bf16x4*)(NTI + c * 256 + fr * 16 + 4 * fq), pk4(w1[0], w1[1], w1[2], w1[3]), (f32x4){0.f, 0.f, 0.f, 0.f}, 0, 0, 0);
                const bf16x4 sab = pk4(sa[0], sa[1], sa[2], sa[3]);
                y = __builtin_amdgcn_mfma_f32_16x16x16bf16_1k(*(const LAS bf16x4*)(LRB + c * 256 + fr * 16 + 4 * fq), sab, y, 0, 0, 0);
#pragma unroll
                for (int j = 0; j < 4; ++j) sY[(16 * c + 4 * fq + j) * 64 + 16 * vw + fr] = y[j];
#pragma unroll
                for (int kt = 0; kt < 4; ++kt) { const f32x4 lm = *(const LAS f32x4*)(LAM + c * 64 + 16 * kt + 4 * fq); f32x4 sn = S[kt] * lm;
                    sn = __builtin_amdgcn_mfma_f32_16x16x16bf16_1k(*(const LAS bf16x4*)(BPT + (c * 64 + 16 * kt + fr) * 16 + 4 * fq), sab, sn, 0, 0, 0);
                    sn = __builtin_amdgcn_mfma_f32_16x16x16bf16_1k(*(const LAS bf16x4*)(KPT + (c * 64 + 16 * kt + fr) * 16 + 4 * fq), vt, sn, 0, 0, 0);
                    S[kt] = sn; }
#pragma unroll
                for (int ks = 0; ks < 2; ++ks) Sb[ks] = cat8(pk4(S[2 * ks][0], S[2 * ks][1], S[2 * ks][2], S[2 * ks][3]), pk4(S[2 * ks + 1][0], S[2 * ks + 1][1], S[2 * ks + 1][2], S[2 * ks + 1][3]));
            }
            }
            __syncthreads();
        }
    }
#undef C3_ISSUE
#undef C3_RAWWR
}

constexpr int S5_WL = 14592;
struct S5Pm { const bf16* SMALL; const float *a_re, *a_im, *log_step, *b_re, *b_im, *c_re, *c_im; _Float16* Yp; };
__device__ __forceinline__ void s5_wave(LAS unsigned char* wl, const S5Pm& P, int seq, int g, int d, int lane) {
    LAS float* BU = (LAS float*)wl; LAS bf16* ST = (LAS bf16*)(wl + 10240);
    const int fr = lane & 15, fq = lane >> 4; const int dg = d * S5G + g;
    const float dt = expf(P.log_step[dg]);
    float lr, li;
    { const float are = P.a_re[dg * S5P + lane], aim = P.a_im[dg * S5P + lane]; const float mag = expf(are * dt); lr = mag * cosf(aim * dt); li = mag * sinf(aim * dt); }
    bf16x4 Bre[4], Bim[4];
#pragma unroll
    for (int jj = 0; jj < 4; ++jj) { const int p = 16 * jj + fr; const float are = P.a_re[dg * S5P + p], aim = P.a_im[dg * S5P + p]; const float mag = expf(are * dt);
        const float pr = mag * cosf(aim * dt), pi = mag * sinf(aim * dt); const float nr = pr - 1.0f, nim = pi, den = 1.0f / (are * are + aim * aim);
        const float cr = (nr * are + nim * aim) * den, ci = (nim * are - nr * aim) * den;
        float vr[4], vi[4];
#pragma unroll
        for (int j = 0; j < 4; ++j) { const size_t bi = ((size_t)dg * S5P + p) * S5C + 4 * fq + j; const float br = P.b_re[bi], bim = P.b_im[bi]; vr[j] = cr * br - ci * bim; vi[j] = cr * bim + ci * br; }
        Bre[jj] = __builtin_bit_cast(bf16x4, (v2u){cvt_pk_bf16(vr[0], vr[1]), cvt_pk_bf16(vr[2], vr[3])}); Bim[jj] = __builtin_bit_cast(bf16x4, (v2u){cvt_pk_bf16(vi[0], vi[1]), cvt_pk_bf16(vi[2], vi[3])}); }
    bf16x8 Cf[4];
#pragma unroll
    for (int ks = 0; ks < 4; ++ks) { const int k0 = (ks & 1) * 32 + fq * 8; const float* src = (ks < 2 ? P.c_re : P.c_im) + ((size_t)g * S5C + fr) * S5P + k0; const float sg = ks < 2 ? 1.0f : -1.0f;
        const f32x4 c0 = *(const f32x4*)src, c1 = *(const f32x4*)(src + 4);
        Cf[ks] = __builtin_bit_cast(bf16x8, (v4u){cvt_pk_bf16(sg * c0[0], sg * c0[1]), cvt_pk_bf16(sg * c0[2], sg * c0[3]), cvt_pk_bf16(sg * c1[0], sg * c1[1]), cvt_pk_bf16(sg * c1[2], sg * c1[3])}); }
    float xr = 0.f, xi = 0.f;
    const bf16* ub = P.SMALL + DS_U + g * S5C + 4 * fq;
    constexpr int NCH = SEQL / 16;
    v2u un1 = *(const v2u*)(ub + ((size_t)seq * SEQL + (size_t)(d ? NCH - 1 : 0) * 16 + fr) * DSW), un2 = *(const v2u*)(ub + ((size_t)seq * SEQL + (size_t)(d ? NCH - 2 : 1) * 16 + fr) * DSW);
    for (int ci = 0; ci < NCH; ++ci) {
        const int ch = d ? (NCH - 1 - ci) : ci; const size_t tok0 = (size_t)seq * SEQL + (size_t)ch * 16;
        const bf16x4 ua = __builtin_bit_cast(bf16x4, un1); un1 = un2;
        { const int cn = ci + 2 < NCH ? ci + 2 : ci; const int chn = d ? (NCH - 1 - cn) : cn; un2 = *(const v2u*)(ub + ((size_t)seq * SEQL + (size_t)chn * 16 + fr) * DSW); }
        const f32x4 z = (f32x4){0.f, 0.f, 0.f, 0.f};
#pragma unroll
        for (int jt = 0; jt < 8; ++jt) { const f32x4 acc = __builtin_amdgcn_mfma_f32_16x16x16bf16_1k(ua, jt < 4 ? Bre[jt] : Bim[jt - 4], z, 0, 0, 0);
            *(LAS f32x4*)(BU + (jt * 16 + fr) * 20 + 4 * fq) = acc; }
        LDS_WAIT(); __builtin_amdgcn_wave_barrier();
        float bre[16], bim[16];
#pragma unroll
        for (int j = 0; j < 4; ++j) { const f32x4 a = *(const LAS f32x4*)(BU + lane * 20 + 4 * j), b = *(const LAS f32x4*)(BU + (64 + lane) * 20 + 4 * j);
#pragma unroll
            for (int e = 0; e < 4; ++e) { bre[4 * j + e] = a[e]; bim[4 * j + e] = b[e]; } }
#pragma unroll
        for (int s = 0; s < 16; ++s) { const int t = d ? 15 - s : s; const float br = bre[t], bi = bim[t];
            const float nxr = lr * xr - li * xi + br, nxi = lr * xi + li * xr + bi; xr = nxr; xi = nxi;
            const unsigned pk = cvt_pk_bf16(xr, xi); ST[t * 136 + lane] = (bf16)(pk & 0xffffu); ST[t * 136 + 64 + lane] = (bf16)(pk >> 16); }
        LDS_WAIT(); __builtin_amdgcn_wave_barrier();
        f32x4 y = z;
#pragma unroll
        for (int ks = 0; ks < 4; ++ks) { const bf16x8 a = *(const LAS bf16x8*)(ST + fr * 136 + ks * 32 + fq * 8); y = __builtin_amdgcn_mfma_f32_16x16x32_bf16(a, Cf[ks], y, 0, 0, 0); }
        { LAS _Float16* YT = (LAS _Float16*)BU;
#pragma unroll
          for (int i = 0; i < 4; ++i) YT[(4 * fq + i) * 16 + fr] = (_Float16)y[i];
          LDS_WAIT(); __builtin_amdgcn_wave_barrier();
          if (lane < 32) { const v4u o = *(const LAS v4u*)(YT + lane * 8); *(v4u*)(P.Yp + (tok0 + (lane >> 1)) * S5D + g * S5C + (lane & 1) * 8) = o; } }
        LDS_WAIT(); __builtin_amdgcn_wave_barrier();
    }
}


#ifndef RWKV_REF
#define RWKV_REF 0
#endif
#ifndef RWKV_SEQ
#define RWKV_SEQ 0
#endif
#ifndef S5_REF
#define S5_REF 0
#endif
__device__ __forceinline__ float bf2f(bf16 b) { return __builtin_bit_cast(float, (unsigned)b << 16); }
__device__ __forceinline__ float shift1(const bf16* base, size_t ld, size_t row, int t, float mu) {
    const float c = bf2f(base[row * ld]), p = t > 0 ? bf2f(base[(row - 1) * ld]) : 0.f, n = t < SEQL - 1 ? bf2f(base[(row + 1) * ld]) : 0.f;
    return c + (0.5f * (p + n) - c) * mu;
}
__device__ __forceinline__ void rwkv_ref_wave(LAS float* sl, const RwkvP& P, int seq, int h, int d, int lane) {
    LAS float* vtw = sl; LAS float* val = sl + 64; LAS float* vkk = sl + 128; LAS float* vw = sl + 192; LAS float* vb = sl + 256; LAS float* vkd = sl + 320; LAS float* vr = sl + 384;
    const int c = h * HD + lane;
    LAS float* Sm = sl + 512 + lane * 65;
    for (int k = 0; k < 64; ++k) Sm[k] = 0.f;
    const float mur = P.mu[c], muk = P.mu[RW + c], muv = P.mu[2 * RW + c], muw = P.mu[MU_WLOW + d * 64 + lane], mua = P.mu[MU_ALOW + d * 64 + lane];
    const float w0c = P.w0[d * RW + c], a0c = P.a0[d * RW + c], kkc = P.k_k[c], kac = P.k_a[c], rkc = P.r_k[c];
    for (int s = 0; s < SEQL; ++s) { const int t = d ? SEQL - 1 - s : s; const size_t row = (size_t)seq * SEQL + t;
        const float r = shift1(P.RKV + c, RKW, row, t, mur), k = shift1(P.RKV + RW + c, RKW, row, t, muk), v = shift1(P.RKV + 2 * RW + c, RKW, row, t, muv);
        const float wl = tanhf(shift1(P.SMALL + SM_WLOW + d * 64 + lane, SMW, row, t, muw)), al = shift1(P.SMALL + SM_ALOW + d * 64 + lane, SMW, row, t, mua);
        vtw[lane] = wl; val[lane] = al; LDS_WAIT(); __builtin_amdgcn_wave_barrier();
        float wp = w0c, ap = a0c;
#pragma unroll 4
        for (int q = 0; q < 64; ++q) { wp += vtw[q] * P.w2[(size_t)(d * 64 + q) * RW + c]; ap += val[q] * P.a2[(size_t)(d * 64 + q) * RW + c]; }
        const float sp = log1pf(expf(-wp));
        const float w = expf(-expf(-sp - 0.5f)), a = 1.0f / (1.0f + expf(-ap));
        float kk = k * kkc; const float nn = wave_sum(kk * kk); kk = kk / sqrtf(nn + 1e-12f);
        const float kd = k * (1.0f + (a - 1.0f) * kac), b = kk * a;
        const float bon = wave_sum(r * kd * rkc); if (lane == 0) P.BON[((size_t)d * M + row) * NH + h] = bon;
        LDS_WAIT(); __builtin_amdgcn_wave_barrier();
        vkk[lane] = kk; vw[lane] = w; vb[lane] = b; vkd[lane] = kd; vr[lane] = r; LDS_WAIT(); __builtin_amdgcn_wave_barrier();
        float sa = 0.f;
#pragma unroll 8
        for (int q = 0; q < 64; ++q) sa -= Sm[q] * vkk[q];
        float y = 0.f;
#pragma unroll 8
        for (int q = 0; q < 64; ++q) { const float sn = Sm[q] * vw[q] + sa * vb[q] + v * vkd[q]; Sm[q] = sn; y += sn * vr[q]; }
        P.Y[row * RW + c] = (_Float16)y;
        LDS_WAIT(); __builtin_amdgcn_wave_barrier();
    }
}
__device__ __forceinline__ void s5_ref_wave(const S5Pm& P, int seq, int g, int d, int lane) {
    const int dg = d * S5G + g; const float dt = expf(P.log_step[dg]);
    const float are = P.a_re[dg * S5P + lane], aim = P.a_im[dg * S5P + lane]; const float mag = expf(are * dt); const float lr = mag * cosf(aim * dt), li = mag * sinf(aim * dt);
    const float nr = lr - 1.0f, nim = li, den = 1.0f / (are * are + aim * aim); const float cr = (nr * are + nim * aim) * den, ci = (nim * are - nr * aim) * den;
    float bbr[16], bbi[16], cre[16], cim[16];
#pragma unroll
    for (int c = 0; c < 16; ++c) { const float br = P.b_re[((size_t)dg * S5P + lane) * S5C + c], bim = P.b_im[((size_t)dg * S5P + lane) * S5C + c]; bbr[c] = cr * br - ci * bim; bbi[c] = cr * bim + ci * br;
        cre[c] = P.c_re[((size_t)g * S5C + c) * S5P + lane]; cim[c] = P.c_im[((size_t)g * S5C + c) * S5P + lane]; }
    float xr = 0.f, xi = 0.f;
    for (int s = 0; s < SEQL; ++s) { const int t = d ? SEQL - 1 - s : s; const size_t row = (size_t)seq * SEQL + t;
        float br = 0.f, bi = 0.f;
#pragma unroll
        for (int c = 0; c < 16; ++c) { const float u = bf2f(P.SMALL[row * SMW + SM_U + g * S5C + c]); br += u * bbr[c]; bi += u * bbi[c]; }
        const float nxr = lr * xr - li * xi + br, nxi = lr * xi + li * xr + bi; xr = nxr; xi = nxi;
#pragma unroll
        for (int c = 0; c < 16; ++c) { const float y = wave_sum(xr * cre[c] - xi * cim[c]); if (lane == c) P.Yp[row * S5D + g * S5C + c] = (_Float16)y; }
    }
}

struct Args { const float* in[37]; float* out; unsigned char* ws; int ph_lo, ph_hi, li, pad; };
enum { I_XP = 0, I_XS, I_NF1, I_F1G, I_F1U, I_F1D, I_NMIX, I_WIN, I_MU, I_W0, I_W2, I_A0, I_A2, I_G2, I_KK, I_KA, I_RK, I_LNW, I_LNB, I_SARE, I_SAIM, I_SLOG, I_SBRE, I_SBIM, I_SCRE, I_SCIM, I_SD, I_SWGLU, I_SBGLU, I_PR, I_PS, I_WO, I_NF2, I_F2G, I_F2U, I_F2D, I_NFIN };
constexpr int N_PHASES = 15;
constexpr int GATES_EARLY = 256;

#define KAS __attribute__((address_space(4)))
__device__ __forceinline__ const KAS unsigned char* kargs() { const KAS unsigned char* p = (const KAS unsigned char*)__builtin_amdgcn_kernarg_segment_ptr(); asm volatile("" : "+s"(p)); return p; }
#define ARGIN(k) (*(const float* const KAS*)(kp + 8 * (k)))
#define PHASE_BEGIN() int tid = threadIdx.x; asm volatile("" : "+v"(tid)); const int lane = tid & 63; (void)lane; const KAS unsigned char* kp = kargs(); (void)kp; \
    unsigned char* ws = *(unsigned char* const KAS*)(kp + 8 * 38); (void)ws; float* X = *(float* const KAS*)(kp + 8 * 37); (void)X;
#define SS0 ((unsigned long long*)(ws + WS_CTL + 65536 + 3 * 196608))
#define SS1 ((unsigned long long*)(ws + WS_CTL + 65536))
#define SS2 ((unsigned long long*)(ws + WS_CTL + 65536 + 196608))
#define SS3 ((unsigned long long*)(ws + WS_CTL + 65536 + 2 * 196608))
#define XN ((bf16*)(ws + WS_XN))
#define HB ((bf16*)(ws + WS_H))
#define WGU ((bf16*)(ws + WS_WGU))
#define WDN ((bf16*)(ws + WS_WDN))
#define WINA ((bf16*)(ws + WS_WINA))
#define WING ((bf16*)(ws + WS_WING))
#define WPR ((bf16*)(ws + WS_WPR))
#define WPS ((bf16*)(ws + WS_WPS))
#define WOUT ((bf16*)(ws + WS_WOUT))
#define G2T ((bf16*)(ws + WS_G2T))
#define WGLU ((bf16*)(ws + WS_WGLU))
#define BON ((float*)(ws + WS_BON))
#define SG ((bf16*)(ws + WS_SG))
#define RKV ((bf16*)(ws + WS_RKV))
#define SMALL ((bf16*)(ws + WS_SMALL))
#define GATES ((bf16*)(ws + WS_GATES))
#define DS ((bf16*)X)
#define YF ((_Float16*)(ws + WS_YF))
#define YB ((_Float16*)(ws + WS_YB))
#define S5F ((_Float16*)(ws + WS_S5F))
#define S5B ((_Float16*)(ws + WS_S5B))
#define TB ((bf16*)(ws + WS_YF))
#define YR ((bf16*)(ws + WS_YB))
#define YS0 ((bf16*)(ws + WS_S5F))
#define YS ((bf16*)(ws + WS_S5B))
#define MRG ((bf16*)(ws + WS_XN))
__global__ void __launch_bounds__(NWAVES * 64, 2) hyb_fwd(Args args_unused) {
    extern __shared__ __attribute__((aligned(16))) unsigned char lds_raw[];
    LAS unsigned char* lds = (LAS unsigned char*)lds_raw;
    volatile LAS unsigned* MISC = (volatile LAS unsigned*)(lds + MISC_OFF);
    const int wave = __builtin_amdgcn_readfirstlane((int)threadIdx.x >> 6);
    const int G = gridDim.x, bx = blockIdx.x;
    const int gw = bx * NWAVES + wave, NGW = G * NWAVES;
    for (int u = threadIdx.x; u < (LDS_BYTES - LDSCTL_OFF) / 4; u += NWAVES * 64) ((LAS unsigned*)(lds + LDSCTL_OFF))[u] = 0u;
    __syncthreads();
    int lo, hi, li; unsigned* ctl;
    { const KAS unsigned char* kp = kargs(); ctl = (unsigned*)(*(unsigned char* const KAS*)(kp + 8 * 38) + WS_CTL); lo = *(const int KAS*)(kp + 8 * 39); hi = *(const int KAS*)(kp + 8 * 39 + 4); li = *(const int KAS*)(kp + 8 * 40); }
    XcdBarrier bar; bar.bar = ctl + CW_BAR + li * XCD_BAR_WORDS; bar.x = 0; bar.st = nullptr;
    if (!MK_SPLIT) bar = xcd_barrier_post(ctl + CW_BAR + li * XCD_BAR_WORDS, MISC + 8);
#ifdef L2_PROBE
#define FIX_PROBE(ph) do { if (li == 1 && lo == (ph)) S.fix = bx & 7; } while (0)
#else
#define FIX_PROBE(ph) do { } while (0)
#endif
#define IN(k) (lo <= (k) && (k) < hi)
#define SEAM(k) do { if (IN(k) && IN((k) + 1)) xcd_barrier(bar); } while (0)
    LAS float* scr = (LAS float*)(lds + wave * 16384);

    if (IN(0)) { PHASE_BEGIN();
        constexpr int I0 = (D / 64) * (FF / 32), I2 = (FF / 64) * (D / 32), I3 = (D / 64) * (NA / 32), I4 = (D / 64) * (NGATE / 32), I5 = (RW / 64) * (D / 32), I6 = (S5D / 64) * (D / 32), I7 = (D / 64) * (D / 32), I8 = (128 / 64) * (RW / 32), I9 = (S5D / 64) * (S5D / 32);
        constexpr int NIT = 2 * I0 + I2; (void)I3; (void)I4; (void)I5; (void)I6; (void)I7; (void)I8; (void)I9;
        for (int it = gw; it < NIT; it += NGW) { int r = it;
            if (r < I0) { transpose_item(ARGIN(I_F1G), FF, FF, WGU, D, 1, scr, r, lane); continue; } r -= I0;
            if (r < I0) { transpose_item(ARGIN(I_F1U), FF, FF, WGU, D, 2, scr, r, lane); continue; } r -= I0;
            transpose_item(ARGIN(I_F1D), D, D, WDN, FF, 0, scr, r, lane);
        }
        rms_rows<false>(ARGIN(I_XP), ARGIN(I_XS), MP, ARGIN(I_NF1), XN, nullptr, gw, NGW, lane, SS0);
    }
    SEAM(0);
    if (IN(1)) { PHASE_BEGIN(); pg8::Gemm g{XN, WGU, M, NGU, D, 0}; pg8::StaticOrder S; S.init(M, NGU, G, bx); FIX_PROBE(1); pg8::EpiSwiGLU E{HB, FF, SS0};
        pg8::gemm_phase<pg8::EpiSwiGLU, pg8::StaticOrder, true, true>(lds, g, S, E);
        { const int nfull = (M / 256) * (NGU / 256) / G;
          if (nfull * G + bx >= (M / 256) * (NGU / 256)) { const int ntail = (M / 256) * (NGU / 256) - nfull * G, gw2 = (bx - ntail) * NWAVES + wave, NGW2 = (G - ntail) * NWAVES;
            constexpr int I3 = (D / 64) * (NA / 32), I4 = (D / 64) * (NGATE / 32), I5 = (RW / 64) * (D / 32), I6 = (S5D / 64) * (D / 32), I7 = (D / 64) * (D / 32), I8 = (128 / 64) * (RW / 32), I9 = (S5D / 64) * (S5D / 32);
            constexpr int NIT2 = I3 + I4 + I5 + I6 + I7 + I8 + I9;
            for (int it = gw2; it < NIT2; it += NGW2) { int r = it;
                if (r < I3) { transpose_item(ARGIN(I_WIN), INC, NA, WINA, D, 0, scr, r, lane); continue; } r -= I3;
                if (r < I4) { transpose_item(ARGIN(I_WIN) + NA, INC, NGATE, WING, D, 0, scr, r, lane); continue; } r -= I4;
                if (r < I5) { transpose_item(ARGIN(I_PR), D, D, WPR, RW, 0, scr, r, lane); continue; } r -= I5;
                if (r < I6) { transpose_item(ARGIN(I_PS), D, D, WPS, S5D, 0, scr, r, lane); continue; } r -= I6;
                if (r < I7) { transpose_item(ARGIN(I_WO), D, D, WOUT, D, 0, scr, r, lane); continue; } r -= I7;
                if (r < I8) { transpose_item(ARGIN(I_G2), RW, RW, G2T, 256, 0, scr, r, lane); continue; } r -= I8;
                transpose_item(ARGIN(I_SWGLU), S5D, S5D, WGLU, S5D, 0, scr, r, lane); }
            const v4u z = (v4u){0u, 0u, 0u, 0u};
            for (int i = gw2 * 64 + lane; i < (4096 - NA) * D / 8; i += NGW2 * 64) *(v4u*)(WINA + (size_t)NA * D + (size_t)i * 8) = z;
            for (int i = gw2 * 64 + lane; i < RW * 16; i += NGW2 * 64) *(v4u*)(G2T + (size_t)(i >> 4) * 256 + 128 + (i & 15) * 8) = z; } }
    }
    SEAM(1);
    if (IN(2)) { PHASE_BEGIN(); pg8::Gemm g{HB, WDN, M, D, FF, 0}; pg8::StaticOrder S; S.init(M, D, G, bx);
        pg8::EpiRes2<1, 0> E{nullptr, nullptr, 0, XN, ARGIN(I_NF1), XN, ARGIN(I_NMIX), nullptr, D, 0.5f, SS1};
        pg8::gemm_phase<pg8::EpiRes2<1, 0>, pg8::StaticOrder, true, true>(lds, g, S, E); }
    SEAM(2);
    if (IN(4)) { PHASE_BEGIN(); pg8::Gemm g{XN, WINA, M, 4096, D, 0}; pg8::StaticOrder S; S.init(M, 4096, G, bx); pg8::EpiBf<0> E{RKV, RKW, SMALL, SMW, RKW / 256, nullptr, 0, nullptr, 0, 0, nullptr, SS1};
        pg8::gemm_phase<pg8::EpiBf<0>, pg8::StaticOrder, true, true>(lds, g, S, E);
        if (!MK_SPLIT) xcd_barrier(bar);
        { const float* mu = ARGIN(I_MU); const float* kkp = ARGIN(I_KK);
          constexpr int RUN = 32, NRUN = M / RUN;
          for (int item = gw; item < 8 * NRUN; item += NGW) { const int cb = item & 7, run = item >> 3, tok0 = run * RUN, t0 = tok0 & (SEQL - 1);
            if (cb == 7) {
#pragma unroll 8
                for (int j = 0; j < RUN; ++j) *(v4u*)(DS + (size_t)(tok0 + j) * DSW + DS_U + 8 * lane) = *(const v4u*)(SMALL + (size_t)(tok0 + j) * SMW + SM_U + 8 * lane);
                continue; }
            const int sel = lane >> 4;
            const bool rd = cb < 6 || sel < 3;
            const bf16* src = cb < 6 ? RKV + cb * 512 + 8 * lane : SMALL + 8 * lane; const size_t ld = cb < 6 ? RKW : SMW;
            const int mcol = cb < 6 ? cb * 512 + 8 * lane : RKW + 8 * lane;
            f32x4 m0 = (f32x4){0.f, 0.f, 0.f, 0.f}, m1 = m0, k0 = m0, k1 = m0;
            if (rd) { m0 = *(const f32x4*)(mu + mcol); m1 = *(const f32x4*)(mu + mcol + 4); }
            if (cb == 2 || cb == 3) { k0 = *(const f32x4*)(kkp + mcol - RW); k1 = *(const f32x4*)(kkp + mcol - RW + 4); }
            float pv[8], cv[8], nv[8];
            ld8bf(src + (size_t)(tok0 - 1) * ld, rd && t0 > 0, pv); ld8bf(src + (size_t)tok0 * ld, rd, cv);
            v4u nx = (v4u){0u, 0u, 0u, 0u}; if (rd) nx = *(const v4u*)(src + (size_t)(tok0 + 1) * ld);
            for (int j = 0; j < RUN; ++j) { const int tok = tok0 + j;
                nv[0] = bf_lo(nx.x); nv[1] = bf_hi(nx.x); nv[2] = bf_lo(nx.y); nv[3] = bf_hi(nx.y); nv[4] = bf_lo(nx.z); nv[5] = bf_hi(nx.z); nv[6] = bf_lo(nx.w); nv[7] = bf_hi(nx.w);
                { const int tn = t0 + j + 2; nx = (v4u){0u, 0u, 0u, 0u}; if (rd && tn < SEQL) nx = *(const v4u*)(src + (size_t)(tok + 2) * ld); }
                float o[8];
#pragma unroll
                for (int e = 0; e < 8; ++e) { const float mm = e < 4 ? m0[e] : m1[e - 4]; o[e] = cv[e] + (0.5f * (pv[e] + nv[e]) - cv[e]) * mm; pv[e] = cv[e]; cv[e] = nv[e]; }
                bf16* drow = DS + (size_t)tok * DSW;
                if (cb < 6) { v4u w; w.x = cvt_pk_bf16(o[0], o[1]); w.y = cvt_pk_bf16(o[2], o[3]); w.z = cvt_pk_bf16(o[4], o[5]); w.w = cvt_pk_bf16(o[6], o[7]); *(v4u*)(drow + cb * 512 + 8 * lane) = w;
                    if (cb == 2 || cb == 3) { float s = 0.f;
#pragma unroll
                        for (int e = 0; e < 8; ++e) { const float q = o[e] * (e < 4 ? k0[e] : k1[e - 4]); s += q * q; }
                        s = red8(s); if ((lane & 7) == 0) ((float*)(drow + DS_INV))[(mcol - RW) >> 6] = 1.0f / sqrtf(s + 1e-12f); } }
                else { const int c8 = (lane & 15) * 8;
                    if (sel == 0) {
#pragma unroll
                        for (int e = 0; e < 8; ++e) o[e] = ftanh(o[e]); }
                    if (sel == 2) {
#pragma unroll
                        for (int e = 0; e < 8; ++e) o[e] = fsigmoid(o[e]); }
                    v4u w; w.x = cvt_pk_bf16(o[0], o[1]); w.y = cvt_pk_bf16(o[2], o[3]); w.z = cvt_pk_bf16(o[4], o[5]); w.w = cvt_pk_bf16(o[6], o[7]);
                    if (sel == 3) w = (v4u){0u, 0u, 0u, 0u};
                    if (sel >= 2) *(v4u*)(SG + (size_t)tok * 256 + (sel - 2) * 128 + c8) = w; else *(v4u*)(drow + DS_TW + sel * 128 + c8) = w; } } } }
    }
    SEAM(4);
    if (IN(5)) { PHASE_BEGIN();
        { const int job = bx;
#ifdef P5_SKIP
            if (!(li == 1 && ((P5_SKIP == 1) == (job < NSEQ * NH * 2))))
#endif
            if (job < NSEQ * NH * 2) { const int seq = job / (NH * 2), h = (job >> 1) & (NH - 1), d = job & 1;
                RwkvP P{DS, SMALL, ARGIN(I_MU), ARGIN(I_W0), ARGIN(I_W2), ARGIN(I_A0), ARGIN(I_A2), ARGIN(I_KK), ARGIN(I_KA), ARGIN(I_RK), d ? YB : YF, BON};
#if RWKV_REF
                if (wave == 0) rwkv_ref_wave((LAS float*)lds, P, seq, h, d, lane);
                __syncthreads();
#else
#if RWKV_SEQ
                rwkv_chain(lds, P, seq, h, d, tid, lane, wave); __syncthreads();
#else
#ifdef C3_PROBE
                if (li == 1) rwkv_chain3(lds, P, seq, h, d, tid, lane, wave, C3_PROBE); else
#endif
                rwkv_chain3(lds, P, seq, h, d, tid, lane, wave, 0);
                __syncthreads();
#endif
#endif
            }
            else if (wave < 6) { const int j = (job - NSEQ * NH * 2) * 6 + wave;        const int seq = j / (S5G * 2), g = (j >> 1) & (S5G - 1), d = j & 1;
                S5Pm P{DS, ARGIN(I_SARE), ARGIN(I_SAIM), ARGIN(I_SLOG), ARGIN(I_SBRE), ARGIN(I_SBIM), ARGIN(I_SCRE), ARGIN(I_SCIM), d ? S5B : S5F};
#if S5_REF
                s5_ref_wave(P, seq, g, d, lane);
#else
                s5_wave(lds + wave * S5_WL, P, seq, g, d, lane);
#endif
            }
        }
        if (bx >= NSEQ * NH * 2) {
            __syncthreads();
            pg8::Gemm g{XN, WING, M, NGATE, D, 0}; pg8::StaticOrder S; S.init(M, NGATE, G - NSEQ * NH * 2, bx - NSEQ * NH * 2); S.lim = GATES_EARLY;
            pg8::EpiBf<1> E{GATES, NGATE, nullptr, 0, 0, nullptr, 0, nullptr, 0, 0, nullptr, SS1};
            pg8::gemm_phase<pg8::EpiBf<1>, pg8::StaticOrder, true, true>(lds, g, S, E);
        }
    }
    SEAM(5);
    if (IN(6)) { PHASE_BEGIN();
        const int c0 = 16 * lane, h = lane >> 2;
        for (int tok = gw; tok < M; tok += NGW) { const int t = tok & (SEQL - 1);
            { const h16x8 f0 = *(const h16x8*)(YF + (size_t)tok * RW + c0), f1 = *(const h16x8*)(YF + (size_t)tok * RW + c0 + 8), b0 = *(const h16x8*)(YB + (size_t)tok * RW + c0), b1 = *(const h16x8*)(YB + (size_t)tok * RW + c0 + 8);
              float y[16]; float s = 0.f;
#pragma unroll
              for (int j = 0; j < 8; ++j) { y[j] = (float)f0[j] + (float)b0[j]; y[8 + j] = (float)f1[j] + (float)b1[j]; }
#pragma unroll
              for (int j = 0; j < 16; ++j) s += y[j];
              const float mean = red4(s) * (1.f / 64.f); float q = 0.f;
#pragma unroll
              for (int j = 0; j < 16; ++j) { y[j] -= mean; q += y[j] * y[j]; }
              const float rstd = 1.0f / sqrtf(red4(q) * (1.f / 64.f) + GN_EPS);
              const float bonus = BON[(size_t)tok * NH + h] + BON[((size_t)M + tok) * NH + h];
              float v0[8], v1[8]; ld8bf(DS + (size_t)tok * DSW + 2 * RW + c0, true, v0); ld8bf(DS + (size_t)tok * DSW + 2 * RW + c0 + 8, true, v1); (void)t;
              const float* lw = ARGIN(I_LNW) + c0; const float* lb = ARGIN(I_LNB) + c0; float o[16];
#pragma unroll
              for (int j = 0; j < 16; ++j) o[j] = y[j] * rstd * lw[j] + lb[j] + bonus * (j < 8 ? v0[j] : v1[j - 8]);
              v4u w0, w1; w0.x = cvt_pk_bf16(o[0], o[1]); w0.y = cvt_pk_bf16(o[2], o[3]); w0.z = cvt_pk_bf16(o[4], o[5]); w0.w = cvt_pk_bf16(o[6], o[7]);
              w1.x = cvt_pk_bf16(o[8], o[9]); w1.y = cvt_pk_bf16(o[10], o[11]); w1.z = cvt_pk_bf16(o[12], o[13]); w1.w = cvt_pk_bf16(o[14], o[15]);
              *(v4u*)(TB + (size_t)tok * RW + c0) = w0; *(v4u*)(TB + (size_t)tok * RW + c0 + 8) = w1; }
            { const int c = 8 * lane; const h16x8 pf = *(const h16x8*)(S5F + (size_t)tok * S5D + c), pb = *(const h16x8*)(S5B + (size_t)tok * S5D + c);
              float uu[8]; ld8bf(DS + (size_t)tok * DSW + DS_U + c, true, uu); const f32x4 d0 = *(const f32x4*)(ARGIN(I_SD) + c), d1 = *(const f32x4*)(ARGIN(I_SD) + c + 4); float o[8];
#pragma unroll
              for (int j = 0; j < 8; ++j) { const float yy = (float)pf[j] + (float)pb[j] + (j < 4 ? d0[j] : d1[j - 4]) * uu[j]; o[j] = 0.5f * yy * (1.0f + ftanh(0.7978845608028654f * (yy + 0.044715f * yy * yy * yy))); }
              v4u w; w.x = cvt_pk_bf16(o[0], o[1]); w.y = cvt_pk_bf16(o[2], o[3]); w.z = cvt_pk_bf16(o[4], o[5]); w.w = cvt_pk_bf16(o[6], o[7]);
              *(v4u*)(YS0 + (size_t)tok * S5D + c) = w; }
        }
    }
    SEAM(6);
    if (IN(7)) { PHASE_BEGIN();
        { pg8::Gemm g{XN, WING, M, NGATE, D, 0}; pg8::StaticOrder S; S.init(M, NGATE, G, bx); S.base = GATES_EARLY;
          pg8::EpiBf<1> E{GATES, NGATE, nullptr, 0, 0, nullptr, 0, nullptr, 0, 0, nullptr, SS1};
          pg8::gemm_phase<pg8::EpiBf<1>, pg8::StaticOrder, true, true>(lds, g, S, E); }
        __syncthreads();
        { pg8::Gemm g{SG, G2T, M, RW, 256, 0}; pg8::StaticOrder S; S.init(M, RW, G, bx); pg8::EpiBf<2> E{YR, RW, nullptr, 0, 0, TB, RW, nullptr, 0, 0, nullptr, nullptr};
          pg8::gemm_phase<pg8::EpiBf<2>, pg8::StaticOrder, true, true>(lds, g, S, E); }
        __syncthreads();
        { pg8::Gemm g{YS0, WGLU, M, S5D, S5D, 0}; pg8::StaticOrder S; S.init(M, S5D, G, bx); pg8::EpiBf<3> E{YS, S5D, nullptr, 0, 0, YS0, S5D, nullptr, 0, 0, ARGIN(I_SBGLU), nullptr};
          pg8::gemm_phase<pg8::EpiBf<3>, pg8::StaticOrder, true, true>(lds, g, S, E); }
    }
    SEAM(7);
    if (IN(9)) { PHASE_BEGIN();
        { pg8::Gemm g{YR, WPR, M, D, RW, 0}; pg8::StaticOrder S; S.init(M, D, G, bx); pg8::EpiBf<4> E{GATES, NGATE, nullptr, 0, 0, nullptr, 0, GATES, NGATE, 0, nullptr, nullptr};
          pg8::gemm_phase<pg8::EpiBf<4>, pg8::StaticOrder, true, true>(lds, g, S, E); }
        VM_WAIT(); __syncthreads();
        { pg8::Gemm g{YS, WPS, M, D, S5D, 0}; pg8::StaticOrder S; S.init(M, D, G, bx); pg8::EpiBf<5> E{GATES, NGATE, nullptr, 0, 0, GATES, NGATE, GATES, NGATE, D, nullptr, nullptr};
          pg8::gemm_phase<pg8::EpiBf<5>, pg8::StaticOrder, true, true>(lds, g, S, E); }
    }
    SEAM(9);
    if (IN(10)) { PHASE_BEGIN(); pg8::Gemm g{GATES, WOUT, M, D, D, NGATE}; pg8::StaticOrder S; S.init(M, D, G, bx);
        pg8::EpiRes2<1, 0> E{nullptr, nullptr, 0, XN, ARGIN(I_NMIX), XN, ARGIN(I_NF2), nullptr, D, 1.0f, SS2};
        pg8::gemm_phase<pg8::EpiRes2<1, 0>, pg8::StaticOrder, true, true>(lds, g, S, E); }
    SEAM(10);
    if (IN(11)) { PHASE_BEGIN();
        constexpr int I0 = (D / 64) * (FF / 32);
        for (int it = gw; it < 2 * I0; it += NGW) { if (it < I0) transpose_item(ARGIN(I_F2G), FF, FF, WGU, D, 1, scr, it, lane); else transpose_item(ARGIN(I_F2U), FF, FF, WGU, D, 2, scr, it - I0, lane); }
    }
    SEAM(11);
    if (IN(12)) { PHASE_BEGIN(); pg8::Gemm g{XN, WGU, M, NGU, D, 0}; pg8::StaticOrder S; S.init(M, NGU, G, bx); pg8::EpiSwiGLU E{HB, FF, SS2};
        pg8::gemm_phase<pg8::EpiSwiGLU, pg8::StaticOrder, true, true>(lds, g, S, E);
        { const int nfull = (M / 256) * (NGU / 256) / G;
          if (nfull * G + bx >= (M / 256) * (NGU / 256)) { const int ntail = (M / 256) * (NGU / 256) - nfull * G, gw2 = (bx - ntail) * NWAVES + wave, NGW2 = (G - ntail) * NWAVES;
            constexpr int I2 = (FF / 64) * (D / 32);
            for (int it = gw2; it < I2; it += NGW2) transpose_item(ARGIN(I_F2D), D, D, WDN, FF, 0, scr, it, lane); } }
    }
    SEAM(12);
    if (IN(13)) { PHASE_BEGIN(); pg8::Gemm g{HB, WDN, M, D, FF, 0}; pg8::StaticOrder S; S.init(M, D, G, bx);
        pg8::EpiRes2<1, 0> E{nullptr, nullptr, 0, XN, ARGIN(I_NF2), XN, ARGIN(I_NFIN), nullptr, D, 0.5f, SS3};
        pg8::gemm_phase<pg8::EpiRes2<1, 0>, pg8::StaticOrder, true, true>(lds, g, S, E); }
    SEAM(13);
    if (IN(14)) { PHASE_BEGIN(); scale_rows(XN, SS3, X, gw, NGW, lane); }
#undef IN
#undef SEAM
}


#ifndef MK_CHECK
#define MK_CHECK 0
#endif
#if MK_CHECK
constexpr int CK_R = 512, CK_C = 128, CW_ERR = 16;
constexpr size_t CK_EXP = 512 * 1024;
__device__ __forceinline__ int ck_row(int i) { return i < 8 ? (i == 0 ? 0 : i == 1 ? 255 : i == 2 ? 256 : i == 3 ? 8191 : i == 4 ? 8192 : i == 5 ? M - 1 : i == 6 ? 4095 : 4096) : (int)(((long)i * 9973 + 131) % M); }
__device__ __forceinline__ int ck_col(int j, int N) { return j == 0 ? 0 : j == 1 ? N - 1 : (int)(((long)j * 7919 + 17) % N); }
__device__ __forceinline__ float dotbb(const bf16* a, const bf16* b, int K) { float s = 0.f; for (int k = 0; k < K; ++k) s += bf2f(a[k]) * bf2f(b[k]); return s; }
__device__ __forceinline__ float rbf(float x) { return bf2f((bf16)f2bf(x)); }
#ifndef CK_WATCH
#define CK_WATCH 80
#endif
#ifndef CK_SEL
#define CK_SEL 0
#endif
__device__ int ck_m, ck_n;
__device__ __forceinline__ void ck_fail_at(unsigned* ctl, int stage, float got, float exp, float tolr, float tola, int m, int n) {
    if (!(fabsf(got - exp) <= tolr * fabsf(exp) + tola)) { atomicMin(&ctl[CW_ERR], (unsigned)stage);
        if (stage == CK_WATCH) { atomicAdd(&ctl[32], 1u); if (!(got >= 0.f && got <= 1.f)) atomicAdd(&ctl[41], 1u); atomicMin(&ctl[33], (unsigned)(m >> 8)); atomicMax(&ctl[34], (unsigned)(m >> 8)); atomicMin(&ctl[35], (unsigned)(n >> 8)); atomicMax(&ctl[36], (unsigned)(n >> 8));
            atomicMin(&ctl[37], (unsigned)(m & 255)); atomicMax(&ctl[38], (unsigned)(m & 255)); atomicMin(&ctl[39], (unsigned)(n & 255)); atomicMax(&ctl[40], (unsigned)(n & 255)); } } }
#define ck_fail(ctl, stage, got, exp, tolr, tola) ck_fail_at(ctl, stage, got, exp, tolr, tola, m, (int)(j))
__device__ __forceinline__ float sigm(float x) { return 1.0f / (1.0f + expf(-x)); }
__global__ void hyb_chk(Args a, int stage, int pre) {
    unsigned char* ws = a.ws; unsigned* ctl = (unsigned*)(ws + WS_CTL); float* EXP = (float*)(ws + CK_EXP); float* X = a.out;
    const int i = blockIdx.x, m = ck_row(i);
    const float* xin = m < MP ? a.in[I_XP] + (size_t)m * D : a.in[I_XS] + (size_t)(m - MP) * D;
    for (int j = threadIdx.x; j < CK_C; j += blockDim.x) {
        if (stage == 1 || stage == 12) {
            const float* g = stage == 1 ? a.in[I_NF1] : a.in[I_NF2]; const float* xr = stage == 1 ? xin : X + (size_t)m * D; const int n = ck_col(j, D);
            float ss = 0.f; for (int k = 0; k < D; ++k) ss += xr[k] * xr[k]; const float e = xr[n] / sqrtf(ss / D + RMS_EPS) * g[n];
            ck_fail(ctl, stage * 10 + 0, bf2f(XN[(size_t)m * D + n]), e, 0.01f, 0.01f);
            const float* wg = a.in[stage == 1 ? I_F1G : I_F2G]; const float* wu = a.in[stage == 1 ? I_F1U : I_F2U]; const float* wd = a.in[stage == 1 ? I_F1D : I_F2D];
            { const int k = m % D, c = ck_col(j, FF); ck_fail(ctl, stage * 10 + 1, bf2f(WGU[(size_t)((c >> 7) * 256 + (c & 127)) * D + k]), wg[(size_t)k * FF + c], 0.005f, 1e-6f);
              ck_fail(ctl, stage * 10 + 2, bf2f(WGU[(size_t)((c >> 7) * 256 + 128 + (c & 127)) * D + k]), wu[(size_t)k * FF + c], 0.005f, 1e-6f); }
            { const int k = m % FF, c = ck_col(j, D); ck_fail(ctl, stage * 10 + 3, bf2f(WDN[(size_t)c * FF + k]), wd[(size_t)k * D + c], 0.005f, 1e-6f); }
            if (stage == 1) { const int k = m % D; { const int c = ck_col(j, 4096); ck_fail(ctl, 14, bf2f(WINA[(size_t)c * D + k]), c < NA ? a.in[I_WIN][(size_t)k * INC + c] : 0.f, 0.005f, 1e-6f);
                ck_fail(ctl, 15, bf2f(WING[(size_t)c * D + k]), a.in[I_WIN][(size_t)k * INC + NA + c], 0.005f, 1e-6f); }
              { const int c = ck_col(j, D); ck_fail(ctl, 16, bf2f(WPR[(size_t)c * RW + (k % RW)]), a.in[I_PR][(size_t)(k % RW) * D + c], 0.005f, 1e-6f);
                ck_fail(ctl, 17, bf2f(WPS[(size_t)c * S5D + (k % S5D)]), a.in[I_PS][(size_t)(k % S5D) * D + c], 0.005f, 1e-6f);
                ck_fail(ctl, 18, bf2f(WOUT[(size_t)c * D + k]), a.in[I_WO][(size_t)k * D + c], 0.005f, 1e-6f); }
              { const int c = ck_col(j, RW), kk = k % 256; ck_fail(ctl, 19, bf2f(G2T[(size_t)c * 256 + kk]), kk < 128 ? a.in[I_G2][(size_t)kk * RW + c] : 0.f, 0.005f, 1e-6f); }
              { const int c = ck_col(j, S5D), kk = k % S5D; ck_fail(ctl, 19, bf2f(WGLU[(size_t)c * S5D + kk]), a.in[I_SWGLU][(size_t)kk * S5D + c], 0.005f, 1e-6f); } }
        }
        if (stage == 2 || stage == 13) { const int c = ck_col(j, FF); const bf16* xr = XN + (size_t)m * D;
            const float gg = dotbb(xr, WGU + (size_t)((c >> 7) * 256 + (c & 127)) * D, D), uu = dotbb(xr, WGU + (size_t)((c >> 7) * 256 + 128 + (c & 127)) * D, D);
            ck_fail(ctl, stage * 10, bf2f(HB[(size_t)m * FF + c]), gg * sigm(gg) * uu, 0.02f, 0.01f); }
        if (stage == 3) { const int n = ck_col(j, D); ck_fail(ctl, 30, X[(size_t)m * D + n], xin[n] + 0.5f * dotbb(HB + (size_t)m * FF, WDN + (size_t)n * FF, FF), 0.005f, 0.005f); }
        if (stage == 4) { const int n = ck_col(j, D); const float* xr = X + (size_t)m * D; float ss = 0.f; for (int k = 0; k < D; ++k) ss += xr[k] * xr[k];
            ck_fail(ctl, 40, bf2f(XN[(size_t)m * D + n]), xr[n] / sqrtf(ss / D + RMS_EPS) * a.in[I_NMIX][n], 0.01f, 0.01f); }
        if (stage == 5) { const int n = ck_col(j, 4096); const float e = dotbb(XN + (size_t)m * D, WINA + (size_t)n * D, D);
            const float got = n < RKW ? bf2f(RKV[(size_t)m * RKW + n]) : bf2f(SMALL[(size_t)m * SMW + n - RKW]); ck_fail(ctl, 50, got, e, 0.01f, 0.01f); }
        if (stage == 7) { const int n = ck_col(j, 128); const int t = m & (SEQL - 1);
            const float c = bf2f(SMALL[(size_t)m * SMW + SM_GLOW + n]), pv = t > 0 ? bf2f(SMALL[(size_t)(m - 1) * SMW + SM_GLOW + n]) : 0.f, nx = t < SEQL - 1 ? bf2f(SMALL[(size_t)(m + 1) * SMW + SM_GLOW + n]) : 0.f;
            ck_fail(ctl, 70, bf2f(SG[(size_t)m * 256 + n]), sigm(c + (0.5f * (pv + nx) - c) * a.in[I_MU][MU_GLOW + n]), 0.01f, 0.005f);
            ck_fail(ctl, 71, bf2f(SG[(size_t)m * 256 + 128 + n]), 0.f, 0.f, 0.f); }
        if (stage == 8) { const int n = ck_col(j, NGATE); const float e = sigm(dotbb(XN + (size_t)m * D, WING + (size_t)n * D, D));
            if (pre) EXP[i * CK_C + j] = e; else { ck_fail_at(ctl, 89, bf2f(GATES[(size_t)m * NGATE + n]), EXP[i * CK_C + j], 0.01f, 0.005f, m, n); ck_fail(ctl, 85, e, EXP[i * CK_C + j], 0.001f, 0.0001f);
                const int k = (m * 7 + j) % D; ck_fail(ctl, 86, bf2f(WING[(size_t)n * D + k]), a.in[I_WIN][(size_t)k * INC + NA + n], 0.005f, 1e-6f);
                const float* xr = X + (size_t)m * D; float ss = 0.f; for (int q = 0; q < D; ++q) ss += xr[q] * xr[q]; const int nn = ck_col(j, D);
                ck_fail(ctl, 87, bf2f(XN[(size_t)m * D + nn]), xr[nn] / sqrtf(ss / D + RMS_EPS) * a.in[I_NMIX][nn], 0.01f, 0.01f); } }
        if (stage == 9) { { const int n = ck_col(j, RW); ck_fail(ctl, 90, bf2f(YR[(size_t)m * RW + n]), dotbb(SG + (size_t)m * 256, G2T + (size_t)n * 256, 256) * bf2f(TB[(size_t)m * RW + n]), 0.02f, 0.01f); }
            { const int n = ck_col(j, S5D); const float y0 = bf2f(YS0[(size_t)m * S5D + n]); ck_fail(ctl, 91, bf2f(YS[(size_t)m * S5D + n]), sigm(dotbb(YS0 + (size_t)m * S5D, WGLU + (size_t)n * S5D, S5D) + a.in[I_SBGLU][n]) * y0, 0.02f, 0.01f); } }
        if (stage == 10) { const int n = ck_col(j, D); const float t1 = rbf(bf2f(GATES[(size_t)m * NGATE + n]) * dotbb(YR + (size_t)m * RW, WPR + (size_t)n * RW, RW));
            ck_fail(ctl, 100, bf2f(MRG[(size_t)m * D + n]), t1 + bf2f(GATES[(size_t)m * NGATE + D + n]) * dotbb(YS + (size_t)m * S5D, WPS + (size_t)n * S5D, S5D), 0.02f, 0.01f); }
        if (stage == 11 || stage == 14) { const int n = ck_col(j, D);
            if (pre) EXP[i * CK_C + j] = X[(size_t)m * D + n] + (stage == 11 ? dotbb(MRG + (size_t)m * D, WOUT + (size_t)n * D, D) : 0.5f * dotbb(HB + (size_t)m * FF, WDN + (size_t)n * FF, FF));
            else ck_fail(ctl, stage * 10, X[(size_t)m * D + n], EXP[i * CK_C + j], 0.005f, 0.005f); }
        if (stage == 15) { const int n = ck_col(j, D); const float* xr = X + (size_t)m * D;
            if (pre) { float ss = 0.f; for (int k = 0; k < D; ++k) ss += xr[k] * xr[k]; EXP[i * CK_C + j] = xr[n] / sqrtf(ss / D + RMS_EPS) * a.in[I_NFIN][n]; }
            else ck_fail(ctl, 150, xr[n], EXP[i * CK_C + j], 0.001f, 0.001f); }
    }
}
__global__ void hyb_chk_report(Args a) { unsigned* ctl = (unsigned*)(a.ws + WS_CTL); const unsigned e = ctl[CW_ERR]; if (e == 0xffffffffu) return;
    unsigned va, vb;
    if (CK_SEL == 0) { va = 0; vb = e; }
    else if (CK_SEL == 1) { va = ctl[33] + 1; vb = ctl[34] + 1; }
    else if (CK_SEL == 2) { va = ctl[35] + 1; vb = ctl[36] + 1; }
    else if (CK_SEL == 3) { va = (ctl[37] >> 2) + 1; vb = (ctl[38] >> 2) + 1; }
    else if (CK_SEL == 4) { va = (ctl[39] >> 2) + 1; vb = (ctl[40] >> 2) + 1; }
    else if (CK_SEL == 5) { const unsigned c = ctl[32]; va = 1; vb = c > 99 ? 99 : c; }
    else { const unsigned c = ctl[32], o = ctl[41]; va = 1 + (98u * o) / (c ? c : 1u); vb = 1 + c / 1000u; }
    const size_t i = (size_t)blockIdx.x * blockDim.x + threadIdx.x;
    if (va && i < 4000000) a.out[i] = (float)va * 10.0f;
    if (i == 0) a.out[(size_t)MP * D + 12345] = (float)vb * 1000.0f; }
__global__ void hyb_chk_init(Args a) { unsigned* ctl = (unsigned*)(a.ws + WS_CTL); if (threadIdx.x == 0) { ctl[CW_ERR] = 0xffffffffu; ctl[33] = 0xffffffffu; ctl[35] = 0xffffffffu; ctl[37] = 0xffffffffu; ctl[39] = 0xffffffffu; } }
#endif

extern "C" void kernel_launch(void* const* d_in, const int* in_sizes, int n_in, void* d_out, int out_size, void* d_ws, size_t ws_size, hipStream_t stream) {
    static int grid = 0;
    if (grid == 0) {
        if (n_in != 37 || in_sizes[0] != MP * D || out_size != M * D || ws_size < WS_END) { fprintf(stderr, "kernel_launch: unexpected problem (n_in %d, in0 %d, out %d, ws %zu, need %zu); nothing launched\n", n_in, n_in > 0 ? in_sizes[0] : -1, out_size, ws_size, (size_t)WS_END); grid = -1; return; }
        int dev = 0, cus = 0, per_cu = 0;
        if (hipGetDevice(&dev) != hipSuccess || hipDeviceGetAttribute(&cus, hipDeviceAttributeMultiprocessorCount, dev) != hipSuccess) { grid = -1; return; }
        if (hipFuncSetAttribute((const void*)hyb_fwd, hipFuncAttributeMaxDynamicSharedMemorySize, LDS_BYTES) != hipSuccess) { fprintf(stderr, "kernel_launch: hipFuncSetAttribute failed\n"); grid = -1; return; }
        if (hipOccupancyMaxActiveBlocksPerMultiprocessor(&per_cu, (const void*)hyb_fwd, NWAVES * 64, LDS_BYTES) != hipSuccess || per_cu < 1) fprintf(stderr, "kernel_launch: occupancy query reports %d\n", per_cu);
        (void)hipGetLastError();
        grid = cus;
        if (grid != 256) { fprintf(stderr, "kernel_launch: needs exactly 256 CUs (got %d); nothing launched\n", grid); grid = -1; return; }
        fprintf(stderr, "kernel_launch: grid %d, ws %zu\n", grid, ws_size);
    }
    if (grid < 0) return;
    if (hipMemsetAsync((char*)d_ws + WS_CTL, 0, CTL_ZERO_BYTES, stream) != hipSuccess) return;
    Args a{};
    for (int i = 0; i < 37; ++i) a.in[i] = (const float*)d_in[i];
    a.out = (float*)d_out; a.ws = (unsigned char*)d_ws;
#if MK_SPLIT
#if MK_CHECK
    hipLaunchKernelGGL(hyb_chk_init, dim3(1), dim3(64), 0, stream, a);
#endif
    for (int p = 0; p < N_PHASES; ++p) { a.ph_lo = p; a.ph_hi = p + 1;
#if MK_CHECK
        if (p == 7 || p == 10 || p == 13 || p == 14) hipLaunchKernelGGL(hyb_chk, dim3(CK_R), dim3(128), 0, stream, a, p + 1, 1);
#endif
        hipLaunchKernelGGL(hyb_fwd, dim3(grid), dim3(NWAVES * 64), LDS_BYTES, stream, a);
#if MK_CHECK
        if (p != 5) hipLaunchKernelGGL(hyb_chk, dim3(CK_R), dim3(128), 0, stream, a, p + 1, 0);
#endif
    }
#if MK_CHECK
    hipLaunchKernelGGL(hyb_chk_report, dim3(4000000 / 256), dim3(256), 0, stream, a);
#endif
#else
#ifdef DUP_PHASE
    a.ph_lo = 0; a.ph_hi = DUP_PHASE + 1; a.li = 0; hipLaunchKernelGGL(hyb_fwd, dim3(grid), dim3(NWAVES * 64), LDS_BYTES, stream, a);
    a.ph_lo = DUP_PHASE; a.ph_hi = N_PHASES; a.li = 1; hipLaunchKernelGGL(hyb_fwd, dim3(grid), dim3(NWAVES * 64), LDS_BYTES, stream, a);
#else
    a.ph_lo = 0; a.ph_hi = N_PHASES; hipLaunchKernelGGL(hyb_fwd, dim3(grid), dim3(NWAVES * 64), LDS_BYTES, stream, a);
#endif
#endif
}
```

```cpp
#include <hip/hip_runtime.h>
#include <cstdio>
#include <cstdint>
#ifndef MK_SPLIT
#define MK_SPLIT 0
#endif
#define RWKV_REF 0
#define S5_REF 0
#define MK_CHECK 0
namespace pg8 {
#define PG8_LAS __attribute__((address_space(3)))
typedef unsigned short bf16_t;
typedef short bf16x8 __attribute__((ext_vector_type(8)));
typedef float f32x4 __attribute__((ext_vector_type(4)));
typedef unsigned u32x4 __attribute__((ext_vector_type(4)));
constexpr int BM = 256, BK = 64, HALF = 128, HTB = HALF * BK * 2  , STAGE_BYTES = 8 * HTB, NXCD = 8, WGM = 8;

__host__ __device__ __forceinline__ int lds_byte(int r, int c) { const int st = (r >> 4) * 2 + (c >> 5), rr = r & 15, cc = c & 31, ob = rr * 64 + cc * 2; return st * 1024 + (ob ^ (((ob >> 9) & 1) << 5)); }
__host__ __device__ __forceinline__ void stage_rc(int b, int& R, int& C) { const int st = b / 1024, sb = b % 1024, swz = sb ^ (((sb >> 9) & 1) << 5); R = (st >> 1) * 16 + swz / 64; C = (st & 1) * 32 + (swz % 64) / 2; }
__host__ __device__ __forceinline__ int perm32(int rho) { const int n = rho >> 4, i = rho & 15; return 8 * (i >> 2) + 4 * n + (i & 3); }

struct Unit { int pm, pn; };
struct Gemm { const bf16_t* A; const bf16_t* Bt; int M, N, K; int lda; int atile; };

struct StaticOrder {
    int nM, nN, nwg, G, c, fix, base, lim, rev;
    __host__ __device__ void init(int M, int N, int G_, int c_) { nM = M / BM; nN = N / BM; nwg = nM * nN; G = G_; c = c_; fix = -1; base = 0; lim = nwg; rev = 0; }
    __host__ __device__ bool next(int i, Unit& u) const {
        const long L = (long)base + (long)i * G + c; if (L >= lim) return false;
        int wgid = (int)L; { const int q = nwg / NXCD, r = nwg % NXCD, xcd = wgid % NXCD, off = wgid / NXCD; wgid = (xcd < r ? xcd * (q + 1) : r * (q + 1) + (xcd - r) * q) + off; }
        const int nig = WGM * nN, gid = wgid / nig, fm = gid * WGM, gsz = (nM - fm) < WGM ? (nM - fm) : WGM;
        u.pm = fm + ((wgid % nig) % gsz); u.pn = (wgid % nig) / gsz; if (rev) u.pm = nM - 1 - u.pm;
        if (fix >= 0) { u.pm = fix; u.pn = fix; } return true;
    }
    __device__ __forceinline__ void a_ready(const Unit&) const {}
    __device__ __forceinline__ void done(const Unit&) const {}
};

typedef __bf16 bf16x2_n __attribute__((ext_vector_type(2)));
typedef float f32x2_n __attribute__((ext_vector_type(2)));
__device__ __forceinline__ unsigned cvt_pk_bf16(float lo, float hi) { const bf16x2_n r = __builtin_convertvector((f32x2_n){lo, hi}, bf16x2_n); return __builtin_bit_cast(unsigned, r); }
__device__ __forceinline__ float bf_lo(unsigned w) { return __builtin_bit_cast(float, w << 16); }
__device__ __forceinline__ float bf_hi(unsigned w) { return __builtin_bit_cast(float, w & 0xffff0000u); }
__device__ __forceinline__ float fsigmoid(float x) { return __builtin_amdgcn_rcpf(1.0f + __builtin_amdgcn_exp2f(-1.4426950408889634f * x)); }
__device__ __forceinline__ u32x4 pack8(const f32x4& a, const f32x4& b) { u32x4 w; w.x = cvt_pk_bf16(a[0], a[1]); w.y = cvt_pk_bf16(a[2], a[3]); w.z = cvt_pk_bf16(b[0], b[1]); w.w = cvt_pk_bf16(b[2], b[3]); return w; }
__device__ __forceinline__ void unpack8(const u32x4& w, f32x4& a, f32x4& b) { a = (f32x4){bf_lo(w.x), bf_hi(w.x), bf_lo(w.y), bf_hi(w.y)}; b = (f32x4){bf_lo(w.z), bf_hi(w.z), bf_lo(w.w), bf_hi(w.w)}; }

struct EpiSwiGLU {
    static constexpr bool PERM = true, AFTER_DRAIN = false;
    bf16_t* H; int ldh; const unsigned long long* ss; int nkt;
    __device__ __forceinline__ void operator()(const f32x4 (&acc)[2][2][4][2], const Unit& u, int wr, int wc, int fr, int fq) const {
        const int row0 = u.pm * BM + wr * 64 + fr, col0 = u.pn * HALF + wc * 32 + 8 * fq;
#pragma unroll
        for (int ai = 0; ai < 2; ++ai)
#pragma unroll
            for (int m = 0; m < 4; ++m) { bf16_t* rowp = nkt ? H + ((size_t)(u.pm * nkt + (col0 >> 6)) * BM + (wr * 64 + fr + ai * HALF + m * 16)) * BK + (col0 & 63) : H + (size_t)(row0 + ai * HALF + m * 16) * ldh + col0;
                const float rs = ss ? 1.0f / sqrtf((float)ss[row0 + ai * HALF + m * 16] * (1.0f / (16777216.0f * 2048.0f)) + 1e-6f) : 1.0f;
                f32x4 o[2];
#pragma unroll
                for (int n = 0; n < 2; ++n) { const f32x4 g = acc[ai][0][m][n] * rs, up = acc[ai][1][m][n] * rs;
#pragma unroll
                    for (int j = 0; j < 4; ++j) o[n][j] = g[j] * fsigmoid(g[j]) * up[j]; }
                *(u32x4*)rowp = pack8(o[0], o[1]); }
    }
};
struct EpiResid {
    static constexpr bool PERM = false, AFTER_DRAIN = false;
    const float* in_lo; const float* in_hi; int split; float* out; int ldc; float scale;
    __device__ __forceinline__ void operator()(const f32x4 (&acc)[2][2][4][2], const Unit& u, int wr, int wc, int fr, int fq) const {
        const int row0 = u.pm * BM + wr * 64 + fr, col0 = u.pn * BM + wc * 32 + 4 * fq;
        const float* inb = (u.pm * BM < split) ? in_lo : in_hi - (size_t)split * ldc;
#pragma unroll
        for (int ai = 0; ai < 2; ++ai) { f32x4 bs[4][2][2];
#pragma unroll
            for (int m = 0; m < 4; ++m) { const size_t off = (size_t)(row0 + ai * HALF + m * 16) * ldc + col0;
#pragma unroll
                for (int bj = 0; bj < 2; ++bj)
#pragma unroll
                    for (int n = 0; n < 2; ++n) bs[m][bj][n] = *(const f32x4*)(inb + off + bj * HALF + n * 16); }
#pragma unroll
            for (int m = 0; m < 4; ++m) { const size_t off = (size_t)(row0 + ai * HALF + m * 16) * ldc + col0;
#pragma unroll
                for (int bj = 0; bj < 2; ++bj)
#pragma unroll
                    for (int n = 0; n < 2; ++n) *(f32x4*)(out + off + bj * HALF + n * 16) = bs[m][bj][n] + acc[ai][bj][m][n] * scale; }
            asm volatile("" ::: "memory"); }
    }
};
template <int MODE> struct EpiBf {
    static constexpr bool PERM = true, AFTER_DRAIN = false;
    bf16_t* O0; int ld0; bf16_t* O1; int ld1; int nsplit;
    const bf16_t* T; int ldt;
    const bf16_t* G; int ldg; int goff; const float* bias; const unsigned long long* ss;
    __device__ __forceinline__ void operator()(const f32x4 (&acc)[2][2][4][2], const Unit& u, int wr, int wc, int fr, int fq) const {
        const int row0 = u.pm * BM + wr * 64 + fr;
        bf16_t* base = O0; int ld = ld0; int colt = u.pn * BM;
        if (MODE == 0) { if (u.pn >= nsplit) { base = O1; ld = ld1; colt = (u.pn - nsplit) * BM; } }
        const int col0 = colt + wc * 32 + 8 * fq;
#pragma unroll
        for (int ai = 0; ai < 2; ++ai)
#pragma unroll
            for (int m = 0; m < 4; ++m) { const int row = row0 + ai * HALF + m * 16;
                const float rs = (MODE <= 1 && ss) ? 1.0f / sqrtf((float)ss[row] * (1.0f / (16777216.0f * 2048.0f)) + 1e-6f) : 1.0f;
#pragma unroll
                for (int bj = 0; bj < 2; ++bj) { f32x4 v0 = acc[ai][bj][m][0], v1 = acc[ai][bj][m][1]; const int col = col0 + bj * HALF;
                    if (MODE <= 1) { v0 = v0 * rs; v1 = v1 * rs; }
                    if (MODE == 1) {
#pragma unroll
                        for (int j = 0; j < 4; ++j) { v0[j] = fsigmoid(v0[j]); v1[j] = fsigmoid(v1[j]); } }
                    if (MODE == 2) { f32x4 t0, t1; unpack8(*(const u32x4*)(T + (size_t)row * ldt + col), t0, t1); v0 = v0 * t0; v1 = v1 * t1; }
                    if (MODE == 3) { f32x4 t0, t1; unpack8(*(const u32x4*)(T + (size_t)row * ldt + col), t0, t1); const f32x4 b0 = *(const f32x4*)(bias + col), b1 = *(const f32x4*)(bias + col + 4);
#pragma unroll
                        for (int j = 0; j < 4; ++j) { v0[j] = fsigmoid(v0[j] + b0[j]) * t0[j]; v1[j] = fsigmoid(v1[j] + b1[j]) * t1[j]; } }
                    if (MODE == 4) { f32x4 g0, g1; unpack8(*(const u32x4*)(G + (size_t)row * ldg + col), g0, g1); v0 = v0 * g0; v1 = v1 * g1; }
                    if (MODE == 5) { f32x4 g0, g1, t0, t1; unpack8(*(const u32x4*)(G + (size_t)row * ldg + goff + col), g0, g1); unpack8(*(const u32x4*)(T + (size_t)row * ldt + col), t0, t1); v0 = t0 + v0 * g0; v1 = t1 + v1 * g1; }
                    *(u32x4*)(base + (size_t)row * ld + col) = pack8(v0, v1); } }
    }
};


template <int SRC, int DST> struct EpiRes2 {
    static constexpr bool PERM = true, AFTER_DRAIN = false;
    const float* in_lo; const float* in_hi; int split; const bf16_t* xg_in; const float* gin; bf16_t* xg_out; const float* gout; float* xf_out; int ldc; float scale; unsigned long long* ss;
    __device__ __forceinline__ void operator()(const f32x4 (&acc)[2][2][4][2], const Unit& u, int wr, int wc, int fr, int fq) const {
        const int row0 = u.pm * BM + wr * 64 + fr, col0 = u.pn * BM + wc * 32 + 8 * fq;
        const float* inb = (u.pm * BM < split) ? in_lo : in_hi - (size_t)split * ldc;
        f32x4 gi[2][2], go[2][2];
#pragma unroll
        for (int bj = 0; bj < 2; ++bj)
#pragma unroll
            for (int n = 0; n < 2; ++n) { const int c = col0 + bj * HALF + 4 * n;
                if (SRC == 1) { const f32x4 g = *(const f32x4*)(gin + c); gi[bj][n] = (f32x4){1.0f / g[0], 1.0f / g[1], 1.0f / g[2], 1.0f / g[3]}; }
                if (DST == 0) go[bj][n] = *(const f32x4*)(gout + c); }
#pragma unroll
        for (int ai = 0; ai < 2; ++ai)
#pragma unroll
            for (int m = 0; m < 4; ++m) { const int row = row0 + ai * HALF + m * 16; const size_t off = (size_t)row * ldc + col0; f32x4 x[2][2]; float s = 0.f;
#pragma unroll
                for (int bj = 0; bj < 2; ++bj) {
                    if (SRC == 0) { x[bj][0] = *(const f32x4*)(inb + off + bj * HALF); x[bj][1] = *(const f32x4*)(inb + off + bj * HALF + 4); }
                    else { f32x4 t0, t1; unpack8(*(const u32x4*)(xg_in + off + bj * HALF), t0, t1); x[bj][0] = t0 * gi[bj][0]; x[bj][1] = t1 * gi[bj][1]; } }
#pragma unroll
                for (int bj = 0; bj < 2; ++bj)
#pragma unroll
                    for (int n = 0; n < 2; ++n) { x[bj][n] = x[bj][n] + acc[ai][bj][m][n] * scale; const f32x4 q = x[bj][n] * x[bj][n]; s += (q[0] + q[1]) + (q[2] + q[3]); }
#pragma unroll
                for (int bj = 0; bj < 2; ++bj) {
                    if (DST == 0) *(u32x4*)(xg_out + off + bj * HALF) = pack8(x[bj][0] * go[bj][0], x[bj][1] * go[bj][1]);
                    else { *(f32x4*)(xf_out + off + bj * HALF) = x[bj][0]; *(f32x4*)(xf_out + off + bj * HALF + 4) = x[bj][1]; } }
                s += __shfl_xor(s, 16); s += __shfl_xor(s, 32);
                if (fq == 0) __hip_atomic_fetch_add(ss + row, (unsigned long long)(s * 16777216.0f + 0.5f), __ATOMIC_RELAXED, __HIP_MEMORY_SCOPE_AGENT); }
    }
};
template <class Epi, class Sched, bool ALIGN_EPI = false, bool SP2 = false>
__device__ __forceinline__ void gemm_phase(PG8_LAS unsigned char* lds, const Gemm g, const Sched& S, const Epi& E) {
    int tid_l = threadIdx.x; asm volatile("" : "+v"(tid_l));
    const int tid = tid_l, wid = __builtin_amdgcn_readfirstlane(tid >> 6), lane = tid & 63, wr = wid >> 2, wc = wid & 3, fr = lane & 15, fq = lane >> 4;
    const int K = g.K, nt = K / BK, lda = g.atile ? BK : (g.lda ? g.lda : K);
    unsigned voffA[2], voffB[2];
#pragma unroll
    for (int i = 0; i < 2; ++i) { int R, C; stage_rc(tid * 16 + i * 8192, R, C); const int Rb = Epi::PERM ? ((R & ~31) + perm32(R & 31)) : R;
        voffA[i] = (unsigned)(R * lda + C) * 2u; voffB[i] = (unsigned)(Rb * K + C) * 2u; }
    const size_t kstep = (size_t)(BK * 2);
    const size_t hstep = (size_t)HALF * K * 2;
    const size_t tstep = 2 * hstep;
    const size_t hstepA = (size_t)HALF * lda * 2, tstepA = g.atile ? (size_t)BM * K * 2 : 2 * hstepA;
    const size_t kstepA = g.atile ? (size_t)BM * BK * 2 : kstep;
    const unsigned ldsw = (unsigned)wid * 1024u;
    const int aoff = lds_byte(wr * 64 + fr, fq * 8), boff = lds_byte(wc * 32 + fr, fq * 8);
#define PG8_SA(b, h) (((b) * 2 + (h)) * HTB)
#define PG8_SB(b, h) ((4 + (b) * 2 + (h)) * HTB)
#define PG8_STAGE(bufoff, gbase, voff) do { _Pragma("unroll") for (int _i = 0; _i < 2; ++_i) \
        __builtin_amdgcn_global_load_lds((const unsigned*)((const char*)(gbase) + (voff)[_i]), (PG8_LAS unsigned*)(lds + (bufoff) + ldsw + _i * 8192), 16, 0, 0); } while (0)
#define PG8_LDA(dst, b, h) do { _Pragma("unroll") for (int m = 0; m < 4; ++m) _Pragma("unroll") for (int k = 0; k < 2; ++k) dst[m][k] = *(const PG8_LAS bf16x8*)(lds + PG8_SA(b, h) + aoff + m * 2048 + k * 1024); } while (0)
#define PG8_LDB(dst, b, h) do { _Pragma("unroll") for (int n = 0; n < 2; ++n) _Pragma("unroll") for (int k = 0; k < 2; ++k) dst[n][k] = *(const PG8_LAS bf16x8*)(lds + PG8_SB(b, h) + boff + n * 2048 + k * 1024); } while (0)
#define PG8_MMA(ai, bj, At, Bt) do { __builtin_amdgcn_s_setprio(1); _Pragma("unroll") for (int m = 0; m < 4; ++m) _Pragma("unroll") for (int n = 0; n < 2; ++n) _Pragma("unroll") for (int k = 0; k < 2; ++k) \
        acc[ai][bj][m][n] = __builtin_amdgcn_mfma_f32_16x16x32_bf16(Bt[n][k], At[m][k], acc[ai][bj][m][n], 0, 0, 0); __builtin_amdgcn_s_setprio(0); } while (0)
#define PG8_WAIT_V(n) asm volatile("s_waitcnt vmcnt(" #n ")" ::: "memory")
#define PG8_WAIT_L(n) asm volatile("s_waitcnt lgkmcnt(" #n ")" ::: "memory")
#define PG8_BAR __builtin_amdgcn_s_barrier()
#define PG8_SCHED __builtin_amdgcn_sched_barrier(0)
    Unit cur, nxt; int ui = 0;
    if (!S.next(0, cur)) return;
    f32x4 acc[2][2][4][2];
#pragma unroll
    for (int a = 0; a < 2; ++a)
#pragma unroll
        for (int b = 0; b < 2; ++b)
#pragma unroll
            for (int m = 0; m < 4; ++m)
#pragma unroll
                for (int n = 0; n < 2; ++n) acc[a][b][m][n] = (f32x4){0.f, 0.f, 0.f, 0.f};
    bf16x8 At[4][2], B0[2][2], B1[2][2];
    const char* cA = (const char*)g.A + (size_t)cur.pm * tstepA; const char* cB = (const char*)g.Bt + (size_t)cur.pn * tstep;
    S.a_ready(cur);
    if constexpr (SP2) {
        PG8_STAGE(PG8_SB(0, 0), cB, voffB); PG8_STAGE(PG8_SB(0, 1), cB + hstep, voffB); PG8_STAGE(PG8_SA(0, 0), cA, voffA); PG8_STAGE(PG8_SA(0, 1), cA + hstepA, voffA);
        if (wr == 1) PG8_BAR;
        PG8_WAIT_V(2); PG8_BAR;
        PG8_STAGE(PG8_SB(1, 0), cB + kstep, voffB); PG8_STAGE(PG8_SA(1, 0), cA + kstepA, voffA); PG8_STAGE(PG8_SB(1, 1), cB + hstep + kstep, voffB);
        PG8_WAIT_V(6); PG8_BAR;
    } else {
        PG8_STAGE(PG8_SB(0, 0), cB, voffB); PG8_STAGE(PG8_SA(0, 0), cA, voffA); PG8_STAGE(PG8_SB(0, 1), cB + hstep, voffB); PG8_STAGE(PG8_SA(0, 1), cA + hstepA, voffA);
        if (wr == 1) PG8_BAR;
        PG8_WAIT_V(4); PG8_BAR;
        PG8_STAGE(PG8_SB(1, 0), cB + kstep, voffB); PG8_STAGE(PG8_SA(1, 0), cA + kstepA, voffA); PG8_STAGE(PG8_SB(1, 1), cB + hstep + kstep, voffB);
        PG8_WAIT_V(6); PG8_BAR;
    }
    for (;;) {
        const bool has_next = S.next(ui + 1, nxt);
        const char* nA = has_next ? (const char*)g.A + (size_t)nxt.pm * tstepA : cA; const char* nB = has_next ? (const char*)g.Bt + (size_t)nxt.pn * tstep : cB;
        for (int t = 0; t < nt; t += 2) {
            const bool last = (t == nt - 2);
            const char* a1 = cA + (size_t)(t + 1) * kstepA;
            const char* a2 = last ? nA : cA + (size_t)(t + 2) * kstepA; const char* b2 = last ? nB : cB + (size_t)(t + 2) * kstep;
            const char* a3 = a2 + kstepA; const char* b3 = b2 + kstep;
            if (last && has_next) S.a_ready(nxt);
            if constexpr (SP2) {
            PG8_LDB(B0, 0, 0); PG8_LDB(B1, 0, 1); PG8_SCHED; PG8_LDA(At, 0, 0); PG8_STAGE(PG8_SA(1, 1), a1 + hstepA, voffA);
            PG8_WAIT_V(8); PG8_WAIT_L(0); PG8_BAR; PG8_MMA(0, 0, At, B0); PG8_MMA(0, 1, At, B1); PG8_BAR; PG8_SCHED;
            PG8_LDA(At, 0, 1); PG8_STAGE(PG8_SB(0, 0), b2, voffB); PG8_STAGE(PG8_SB(0, 1), b2 + hstep, voffB); PG8_STAGE(PG8_SA(0, 0), a2, voffA);
            PG8_WAIT_V(8); PG8_WAIT_L(0); PG8_BAR; PG8_MMA(1, 0, At, B0); PG8_MMA(1, 1, At, B1); PG8_BAR; PG8_SCHED;
            PG8_LDB(B0, 1, 0); PG8_LDB(B1, 1, 1); PG8_SCHED; PG8_LDA(At, 1, 0); PG8_STAGE(PG8_SA(0, 1), a2 + hstepA, voffA);
            PG8_WAIT_V(8); PG8_WAIT_L(0); PG8_BAR; PG8_MMA(0, 0, At, B0); PG8_MMA(0, 1, At, B1); PG8_BAR; PG8_SCHED;
            PG8_LDA(At, 1, 1); PG8_STAGE(PG8_SB(1, 0), b3, voffB); PG8_STAGE(PG8_SB(1, 1), b3 + hstep, voffB); PG8_STAGE(PG8_SA(1, 0), a3, voffA);
            PG8_WAIT_V(8); PG8_WAIT_L(0); PG8_BAR; PG8_MMA(1, 0, At, B0); PG8_MMA(1, 1, At, B1); PG8_BAR; PG8_SCHED;
            } else {
            PG8_LDB(B0, 0, 0); PG8_SCHED; PG8_LDA(At, 0, 0); PG8_STAGE(PG8_SA(1, 1), a1 + hstepA, voffA);
            PG8_WAIT_L(8); PG8_BAR; PG8_WAIT_L(0); PG8_MMA(0, 0, At, B0); PG8_BAR; PG8_SCHED;
            PG8_LDB(B1, 0, 1); PG8_STAGE(PG8_SB(0, 0), b2, voffB);
            PG8_BAR; PG8_WAIT_L(0); PG8_MMA(0, 1, At, B1); PG8_BAR;
            PG8_LDA(At, 0, 1); PG8_STAGE(PG8_SA(0, 0), a2, voffA);
            PG8_BAR; PG8_WAIT_L(0); PG8_MMA(1, 0, At, B0); PG8_BAR; PG8_SCHED;
            PG8_STAGE(PG8_SB(0, 1), b2 + hstep, voffB);
            PG8_WAIT_V(6); PG8_BAR; PG8_MMA(1, 1, At, B1); PG8_BAR;
            PG8_LDB(B0, 1, 0); PG8_SCHED; PG8_LDA(At, 1, 0); PG8_STAGE(PG8_SA(0, 1), a2 + hstepA, voffA);
            PG8_WAIT_L(8); PG8_BAR; PG8_WAIT_L(0); PG8_MMA(0, 0, At, B0); PG8_BAR; PG8_SCHED;
            PG8_LDB(B1, 1, 1); PG8_STAGE(PG8_SB(1, 0), b3, voffB);
            PG8_BAR; PG8_WAIT_L(0); PG8_MMA(0, 1, At, B1); PG8_BAR;
            PG8_LDA(At, 1, 1); PG8_STAGE(PG8_SA(1, 0), a3, voffA);
            PG8_BAR; PG8_WAIT_L(0); PG8_MMA(1, 0, At, B0); PG8_BAR; PG8_SCHED;
            PG8_STAGE(PG8_SB(1, 1), b3 + hstep, voffB);
            PG8_WAIT_V(6); PG8_BAR; PG8_MMA(1, 1, At, B1); PG8_BAR;
            }
        }
        if constexpr (ALIGN_EPI) { if (wr == 0) PG8_BAR; }
        if constexpr (!Epi::AFTER_DRAIN) { E(acc, cur, wr, wc, fr, fq); S.done(cur); }
        if (!has_next) break;
#pragma unroll
        for (int a = 0; a < 2; ++a)
#pragma unroll
            for (int b = 0; b < 2; ++b)
#pragma unroll
                for (int m = 0; m < 4; ++m)
#pragma unroll
                    for (int n = 0; n < 2; ++n) acc[a][b][m][n] = (f32x4){0.f, 0.f, 0.f, 0.f};
        cur = nxt; cA = nA; cB = nB; ++ui;
        if constexpr (ALIGN_EPI) { if (wr == 1) PG8_BAR; }
    }
    PG8_WAIT_V(0);
    if constexpr (!ALIGN_EPI) { if (wr == 0) PG8_BAR; }
    PG8_BAR;
    if constexpr (Epi::AFTER_DRAIN) { E.fused(acc, cur, wr, wc, fr, fq, lds, wid, lane); S.done(cur); }
#undef PG8_SA
#undef PG8_SB
#undef PG8_STAGE
#undef PG8_LDA
#undef PG8_LDB
#undef PG8_MMA
#undef PG8_WAIT_V
#undef PG8_WAIT_L
#undef PG8_BAR
#undef PG8_SCHED
}
}

constexpr int NWAVES = 8;
constexpr int NSEQ = 6, SEQL = 4096, M = NSEQ * SEQL, MP = 2 * SEQL;
constexpr int D = 2048, FF = 5504, NGU = 2 * FF;
constexpr int NH = 16, HD = 64, RW = 1024;
constexpr int RKW = 3072, SMW = 1024, NGATE = 4096, INC = 8064, NA = 3968;
constexpr int SM_WLOW = 0, SM_ALOW = 128, SM_GLOW = 256, SM_U = 384;
constexpr int MU_WLOW = 3072, MU_ALOW = 3200, MU_GLOW = 3328;
constexpr int S5G = 32, S5C = 16, S5P = 64, S5D = 512;
constexpr int DSW = 4096, DS_TW = 3072, DS_AL = 3200, DS_U = 3456, DS_INV = 3968;
constexpr float RMS_EPS = 1e-6f, GN_EPS = 64e-5f;

constexpr size_t MiB = 1u << 20;
constexpr size_t WS_CTL = 0, CTL_ZERO_BYTES = 1 * MiB;
constexpr size_t WS_WINA = 1 * MiB, WS_WING = 17 * MiB, WS_WPR = 33 * MiB, WS_WPS = 37 * MiB, WS_WOUT = 39 * MiB, WS_G2T = 47 * MiB, WS_WGLU = 47 * MiB + 512 * 1024;
constexpr size_t WS_BON = 48 * MiB, WS_SG = 51 * MiB, WS_XN = 63 * MiB;
constexpr size_t WS_WGU = 159 * MiB, WS_WDN = 202 * MiB, WS_H = 224 * MiB;
constexpr size_t WS_RKV = 159 * MiB, WS_SMALL = 303 * MiB, WS_YF = 351 * MiB, WS_YB = 399 * MiB, WS_S5F = 447 * MiB, WS_S5B = 471 * MiB, WS_END = 495 * MiB;
constexpr size_t WS_WGU2 = 495 * MiB, WS_END2 = 538 * MiB;
constexpr size_t WS_GATES = 159 * MiB;
static_assert(WS_WGU2 + (size_t)NGU * D * 2 <= WS_END2, "early FFN2 weights");
static_assert(WS_WGU + (size_t)NGU * D * 2 <= WS_WDN && WS_WDN + (size_t)D * FF * 2 <= WS_H && WS_H + (size_t)M * FF * 2 <= WS_END, "ffn map");
static_assert(WS_RKV + (size_t)M * RKW * 2 <= WS_SMALL && WS_SMALL + (size_t)M * SMW * 2 <= WS_YF && WS_YF + (size_t)M * RW * 2 <= WS_YB && WS_YB + (size_t)M * RW * 2 <= WS_S5F && WS_S5F + (size_t)M * S5D * 2 <= WS_S5B && WS_S5B + (size_t)M * S5D * 2 <= WS_END, "mixer map");
static_assert(WS_GATES + (size_t)M * NGATE * 2 <= WS_YF && WS_XN + (size_t)M * D * 2 <= WS_WGU && WS_SG + (size_t)M * 256 * 2 <= WS_XN && WS_BON + (size_t)2 * M * NH * 4 <= WS_SG, "map");
constexpr int CW_BAR = 4096;

constexpr int RING_BYTES = 131072;
constexpr int LDSCTL_OFF = 146432, MISC_OFF = LDSCTL_OFF + 320;
constexpr int LDS_BYTES = 147456;

#define GAS __attribute__((address_space(1)))
#define LAS __attribute__((address_space(3)))
typedef unsigned short bf16;
typedef unsigned v4u __attribute__((ext_vector_type(4)));
typedef unsigned v2u __attribute__((ext_vector_type(2)));
typedef float f32x4 __attribute__((ext_vector_type(4)));
typedef float f32x2 __attribute__((ext_vector_type(2)));
typedef short bf16x8 __attribute__((ext_vector_type(8)));
typedef short bf16x4 __attribute__((ext_vector_type(4)));
typedef _Float16 h16x4 __attribute__((ext_vector_type(4)));
typedef _Float16 h16x8 __attribute__((ext_vector_type(8)));
typedef GAS unsigned gu32;
#define RLX_AGENT __ATOMIC_RELAXED, __HIP_MEMORY_SCOPE_AGENT
#define LDS_WAIT() asm volatile("s_waitcnt lgkmcnt(0)" ::: "memory")
#define VM_WAIT() asm volatile("s_waitcnt vmcnt(0)" ::: "memory")
using pg8::cvt_pk_bf16; using pg8::bf_lo; using pg8::bf_hi; using pg8::fsigmoid;

#define XB_TMO      128
#define XB_XCNT(j)  (256  + 64 * (j))
#define XB_XSUB(j)  (1280 + 64 * (j))
#define XB_XGEN(j)  (2304 + 64 * (j))
#define XB_TOP      3328
#define XB_TOPGEN   3392
#define XCD_BAR_WORDS 3456
#define XB_SPIN_CAP (1u << 18)

__device__ __forceinline__ unsigned xb_ld(unsigned* p)              { return __hip_atomic_load(p, __ATOMIC_RELAXED, __HIP_MEMORY_SCOPE_AGENT); }
__device__ __forceinline__ unsigned xb_add(unsigned* p, unsigned v) { return __hip_atomic_fetch_add(p, v, __ATOMIC_RELAXED, __HIP_MEMORY_SCOPE_AGENT); }
__device__ __forceinline__ unsigned xb_xcc_id() { return (unsigned)__builtin_amdgcn_s_getreg((3 << 11) | 20) & 0xFu; }
#define XB_SPIN(cond, bar) do { unsigned _sp = 0; while (cond) { __builtin_amdgcn_s_sleep(1); \
    if ((++_sp & 255u) == 0u) { if (xb_ld(&(bar)[XB_TMO])) break; if (_sp > XB_SPIN_CAP) { atomicAdd(&(bar)[XB_TMO], 1u); break; } } } } while (0)

struct XcdBarrier {
    unsigned* bar; unsigned x;
    volatile LAS unsigned* st;
};
__device__ __forceinline__ XcdBarrier xcd_barrier_post(unsigned* bar, volatile LAS unsigned* st) {
    XcdBarrier b; b.bar = bar; b.x = xb_xcc_id(); b.st = st;
    if (threadIdx.x == 0) (void)xb_add(&bar[XB_XCNT(b.x)], 1u);
    return b;
}
__device__ __forceinline__ void xcd_barrier_complete(unsigned* bar, unsigned x, unsigned& nloc, unsigned& nx) {
    const unsigned G = gridDim.x * gridDim.y * gridDim.z;
    unsigned sum, cnt, mine, sp = 0u;
    for (;;) {
        sum = 0u; cnt = 0u; mine = 0u;
#pragma unroll
        for (unsigned j = 0; j < 16; ++j) { const unsigned c = xb_ld(&bar[XB_XCNT(j)]); sum += c; cnt += (c > 0u) ? 1u : 0u; mine = (j == x) ? c : mine; }
        if (sum == G) break;
        __builtin_amdgcn_s_sleep(1);
        if ((++sp & 255u) == 0u) { if (xb_ld(&bar[XB_TMO])) break; if (sp > XB_SPIN_CAP) { atomicAdd(&bar[XB_TMO], 1u); break; } }
    }
    nloc = mine > 0u ? mine : 1u; nx = cnt > 0u ? cnt : 1u;
}
__device__ __forceinline__ void xcd_barrier(const XcdBarrier& b) {
    asm volatile("s_waitcnt vmcnt(0)" ::: "memory");
    __syncthreads();
    if (threadIdx.x == 0) {
        unsigned* bar = b.bar;
        __builtin_amdgcn_s_waitcnt(0);
        unsigned nloc = b.st[0], nx = b.st[1];
        if (nloc == 0u) { xcd_barrier_complete(bar, b.x, nloc, nx); b.st[0] = nloc; b.st[1] = nx; }
        const unsigned old = xb_add(&bar[XB_XSUB(b.x)], 1u);
        const unsigned gen = old / nloc;
        if (old + 1u == (gen + 1u) * nloc) {
            __builtin_amdgcn_fence(__ATOMIC_RELEASE, "agent");
            asm volatile("s_waitcnt vmcnt(0)" ::: "memory");
            const unsigned og = xb_add(&bar[XB_TOP], 1u);
            const unsigned tg = og / nx;
            if (og + 1u == (tg + 1u) * nx) xb_add(&bar[XB_TOPGEN], 1u);
            else XB_SPIN(xb_ld(&bar[XB_TOPGEN]) == tg, bar);
            __builtin_amdgcn_fence(__ATOMIC_ACQUIRE, "agent");
            xb_add(&bar[XB_XGEN(b.x)], 1u);
            asm volatile("s_waitcnt vmcnt(0)" ::: "memory");
        } else {
            XB_SPIN(xb_ld(&bar[XB_XGEN(b.x)]) == gen, bar);
            __builtin_amdgcn_fence(__ATOMIC_ACQUIRE, "agent");
            asm volatile("s_waitcnt vmcnt(0)" ::: "memory");
        }
    }
    __syncthreads();
}

__device__ __forceinline__ float wave_sum(float v) {
#pragma unroll
    for (int o = 1; o < 64; o <<= 1) v += __shfl_xor(v, o);
    return v;
}
__device__ __forceinline__ float dpp_f(float v, const int ctrl_sel) {
    const int x = __builtin_bit_cast(int, v); int r;
    if (ctrl_sel == 0) r = __builtin_amdgcn_update_dpp(x, x, 0xB1, 0xF, 0xF, false);
    else if (ctrl_sel == 1) r = __builtin_amdgcn_update_dpp(x, x, 0x4E, 0xF, 0xF, false);
    else if (ctrl_sel == 2) r = __builtin_amdgcn_update_dpp(x, x, 0x141, 0xF, 0xF, false);
    else r = __builtin_amdgcn_update_dpp(x, x, 0x140, 0xF, 0xF, false);
    return __builtin_bit_cast(float, r);
}
__device__ __forceinline__ float red4(float v) { v += dpp_f(v, 0); v += dpp_f(v, 1); return v; }
__device__ __forceinline__ float red8(float v) { v += dpp_f(v, 0); v += dpp_f(v, 1); v += dpp_f(v, 2); return v; }
__device__ __forceinline__ float red16(float v) { v = red8(v); v += dpp_f(v, 3); return v; }
__device__ __forceinline__ float ftanh(float x) { const float e = __builtin_amdgcn_exp2f(2.8853900817779268f * x); return 1.0f - 2.0f * __builtin_amdgcn_rcpf(1.0f + e); }
__device__ __forceinline__ unsigned f2bf(float f) { unsigned u = __builtin_bit_cast(unsigned, f); return (u + 0x7fffu + ((u >> 16) & 1u)) >> 16; }

__device__ __forceinline__ void transpose_item(const float* W, int ldW, int ncols, bf16* WT, int ldT, int rowmode, LAS float* scr, int item, int lane) {
    const int nblk = ncols / 32, kb = item / nblk, nb = item % nblk, k0 = 64 * kb, n0 = 32 * nb;
    const int r0 = rowmode == 0 ? n0 : ((n0 >> 7) * 256 + (n0 & 127) + (rowmode == 2 ? 128 : 0));
#pragma unroll 8
    for (int i = 0; i < 32; ++i) { const int kk = 2 * i + (lane >> 5); scr[kk * 33 + (lane & 31)] = W[(size_t)(k0 + kk) * ldW + n0 + (lane & 31)]; }
    LDS_WAIT(); asm volatile("" ::: "memory");
    const int c = lane & 7;
#pragma unroll
    for (int j = 0; j < 4; ++j) { const int n = (lane >> 3) + 8 * j; const LAS float* s = scr + (8 * c) * 33 + n;
        v4u o; o.x = cvt_pk_bf16(s[0 * 33], s[1 * 33]); o.y = cvt_pk_bf16(s[2 * 33], s[3 * 33]); o.z = cvt_pk_bf16(s[4 * 33], s[5 * 33]); o.w = cvt_pk_bf16(s[6 * 33], s[7 * 33]);
        *(v4u*)(WT + (size_t)(r0 + n) * ldT + k0 + 8 * c) = o; }
    LDS_WAIT(); asm volatile("" ::: "memory");
}
__device__ __forceinline__ void rms_row_bf16(const float* xrow, const float* g, bf16* orow, int lane) {
    const f32x4* xr = (const f32x4*)xrow + lane; const f32x4* gr = (const f32x4*)g + lane;
    f32x4 v[8]; float s = 0.f;
#pragma unroll
    for (int j = 0; j < 8; ++j) { v[j] = xr[64 * j]; s += (v[j].x * v[j].x + v[j].y * v[j].y) + (v[j].z * v[j].z + v[j].w * v[j].w); }
    const float rstd = 1.0f / sqrtf(wave_sum(s) * (1.f / D) + RMS_EPS);
    v2u* o8 = (v2u*)orow + lane;
#pragma unroll
    for (int j = 0; j < 8; ++j) { const f32x4 gg = gr[64 * j]; v2u w; w.x = cvt_pk_bf16(v[j].x * rstd * gg.x, v[j].y * rstd * gg.y); w.y = cvt_pk_bf16(v[j].z * rstd * gg.z, v[j].w * rstd * gg.w); o8[64 * j] = w; }
}
__device__ __forceinline__ void rms_row_f32(float* xrow, const float* g, int lane) {
    f32x4* xr = (f32x4*)xrow + lane; const f32x4* gr = (const f32x4*)g + lane;
    f32x4 v[8]; float s = 0.f;
#pragma unroll
    for (int j = 0; j < 8; ++j) { v[j] = xr[64 * j]; s += (v[j].x * v[j].x + v[j].y * v[j].y) + (v[j].z * v[j].z + v[j].w * v[j].w); }
    const float rstd = 1.0f / sqrtf(wave_sum(s) * (1.f / D) + RMS_EPS);
#pragma unroll
    for (int j = 0; j < 8; ++j) { const f32x4 gg = gr[64 * j]; xr[64 * j] = (f32x4){v[j].x * rstd * gg.x, v[j].y * rstd * gg.y, v[j].z * rstd * gg.z, v[j].w * rstd * gg.w}; }
}
template <bool F32OUT> __device__ __forceinline__ void rms_rows(const float* lo, const float* hi, int split, const float* g, bf16* ob, float* of, int gw, int NGW, int lane) {
    f32x4 gg[8]; { const f32x4* gr = (const f32x4*)g + lane;
#pragma unroll
      for (int j = 0; j < 8; ++j) gg[j] = gr[64 * j]; }
    f32x4 nv[8];
    { const int m = gw; const f32x4* xr = (const f32x4*)(m < split ? lo + (size_t)m * D : hi + (size_t)(m - split) * D) + lane;
#pragma unroll
      for (int j = 0; j < 8; ++j) nv[j] = xr[64 * j]; }
    for (int m = gw; m < M; m += NGW) {
        f32x4 v[8]; float s = 0.f;
#pragma unroll
        for (int j = 0; j < 8; ++j) { v[j] = nv[j]; s += (v[j].x * v[j].x + v[j].y * v[j].y) + (v[j].z * v[j].z + v[j].w * v[j].w); }
        { const int mn = m + NGW < M ? m + NGW : m; const f32x4* xr = (const f32x4*)(mn < split ? lo + (size_t)mn * D : hi + (size_t)(mn - split) * D) + lane;
#pragma unroll
          for (int j = 0; j < 8; ++j) nv[j] = xr[64 * j]; }
        const float rstd = 1.0f / sqrtf(wave_sum(s) * (1.f / D) + RMS_EPS);
        if (F32OUT) { f32x4* o = (f32x4*)(of + (size_t)m * D) + lane;
#pragma unroll
            for (int j = 0; j < 8; ++j) o[64 * j] = (f32x4){v[j].x * rstd * gg[j].x, v[j].y * rstd * gg[j].y, v[j].z * rstd * gg[j].z, v[j].w * rstd * gg[j].w}; }
        else { v2u* o8 = (v2u*)(ob + (size_t)m * D) + lane;
#pragma unroll
            for (int j = 0; j < 8; ++j) { v2u w; w.x = cvt_pk_bf16(v[j].x * rstd * gg[j].x, v[j].y * rstd * gg[j].y); w.y = cvt_pk_bf16(v[j].z * rstd * gg[j].z, v[j].w * rstd * gg[j].w); o8[64 * j] = w; } }
    }
}
__device__ __forceinline__ void scale_rows(const bf16* xg, const unsigned long long* ss, float* out, int gw, int NGW, int lane) {
    v4u nv[4]; float ns;
    { const v4u* xr = (const v4u*)(xg + (size_t)gw * D) + lane; ns = (float)ss[gw];
#pragma unroll
      for (int j = 0; j < 4; ++j) nv[j] = xr[64 * j]; }
    for (int m = gw; m < M; m += NGW) { v4u v[4]; const float rstd = 1.0f / sqrtf(ns * (1.f / (16777216.0f * D)) + RMS_EPS);
#pragma unroll
        for (int j = 0; j < 4; ++j) v[j] = nv[j];
        { const int mn = m + NGW < M ? m + NGW : m; const v4u* xr = (const v4u*)(xg + (size_t)mn * D) + lane; ns = (float)ss[mn];
#pragma unroll
          for (int j = 0; j < 4; ++j) nv[j] = xr[64 * j]; }
        f32x4* o = (f32x4*)(out + (size_t)m * D) + 2 * lane;
#pragma unroll
        for (int j = 0; j < 4; ++j) { o[128 * j] = (f32x4){bf_lo(v[j].x) * rstd, bf_hi(v[j].x) * rstd, bf_lo(v[j].y) * rstd, bf_hi(v[j].y) * rstd};
            o[128 * j + 1] = (f32x4){bf_lo(v[j].z) * rstd, bf_hi(v[j].z) * rstd, bf_lo(v[j].w) * rstd, bf_hi(v[j].w) * rstd}; } }
}
__device__ __forceinline__ void ld8bf(const bf16* p, bool ok, float (&o)[8]) {
    v4u w = (v4u){0u, 0u, 0u, 0u}; if (ok) w = *(const v4u*)p;
    o[0] = bf_lo(w.x); o[1] = bf_hi(w.x); o[2] = bf_lo(w.y); o[3] = bf_hi(w.y); o[4] = bf_lo(w.z); o[5] = bf_hi(w.z); o[6] = bf_lo(w.w); o[7] = bf_hi(w.w);
}
__device__ __forceinline__ void shift8(const bf16* base, size_t ld, size_t row, int t, const float* mu, float (&o)[8]) {
    float c[8], p[8], n[8];
    ld8bf(base + row * ld, true, c); ld8bf(base + (row - 1) * ld, t > 0, p); ld8bf(base + (row + 1) * ld, t < SEQL - 1, n);
    const f32x4 m0 = *(const f32x4*)mu, m1 = *(const f32x4*)(mu + 4);
#pragma unroll
    for (int j = 0; j < 8; ++j) { const float mm = j < 4 ? m0[j] : m1[j - 4]; o[j] = c[j] + (0.5f * (p[j] + n[j]) - c[j]) * mm; }
}

constexpr int RC = 32;
constexpr int RW_R = 0, RW_KD = 8192, RW_V = 16384, RW_KK = 24576, RW_W = 32768, RW_B = 40960, RW_Y = 49152, RW_TW = 57344, RW_AL = 61952, RW_INV = 66560;
struct RwkvP { const bf16* RKV; const bf16* SMALL; const float *mu, *w0, *w2, *a0, *a2, *k_k, *k_a, *r_k; _Float16* Y; float* BON;
#ifdef TPROBE
    float* tp;
#endif
};
__device__ __forceinline__ void rwkv_chain(LAS unsigned char* lds, const RwkvP& P, int seq, int h, int d, int tid, int lane, int wave) {
    LAS float* sR = (LAS float*)(lds + RW_R); LAS float* sKD = (LAS float*)(lds + RW_KD); LAS float* sV = (LAS float*)(lds + RW_V); LAS float* sKK = (LAS float*)(lds + RW_KK);
    LAS float* sW = (LAS float*)(lds + RW_W); LAS float* sB = (LAS float*)(lds + RW_B); LAS float* sY = (LAS float*)(lds + RW_Y); LAS float* sINV = (LAS float*)(lds + RW_INV);
    LAS bf16* sTW = (LAS bf16*)(lds + RW_TW); LAS bf16* sAL = (LAS bf16*)(lds + RW_AL);
    const int mi = wave >> 2, ni = wave & 3, fr = lane & 15, fq = lane >> 4;
    const int cc = h * HD + ni * 16 + fr;
    bf16x8 Bw[2], Ba[2];
#pragma unroll
    for (int ks = 0; ks < 2; ++ks) { unsigned w[4], a[4];
#pragma unroll
        for (int j = 0; j < 4; ++j) { const int k0 = ks * 32 + fq * 8 + 2 * j; const size_t i0 = (size_t)(d * 64 + k0) * RW + cc, i1 = i0 + RW;
            w[j] = cvt_pk_bf16(P.w2[i0], P.w2[i1]); a[j] = cvt_pk_bf16(P.a2[i0], P.a2[i1]); }
        Bw[ks] = __builtin_bit_cast(bf16x8, (v4u){w[0], w[1], w[2], w[3]}); Ba[ks] = __builtin_bit_cast(bf16x8, (v4u){a[0], a[1], a[2], a[3]}); }
    const float w0c = P.w0[d * RW + cc], a0c = P.a0[d * RW + cc], kkc = P.k_k[cc], kac = P.k_a[cc];
    const int ke = lane & 7, srow = wave * 8 + (lane >> 3);
    float S[8];
#pragma unroll
    for (int j = 0; j < 8; ++j) S[j] = 0.f;
    const int st_t = tid >> 4, st_s = tid & 15;
    float kk4[4], rk4[4];
#pragma unroll
    for (int j = 0; j < 4; ++j) { kk4[j] = P.k_k[h * HD + st_s * 4 + j]; rk4[j] = P.r_k[h * HD + st_s * 4 + j]; }

    for (int ci = 0; ci < SEQL / RC; ++ci) {
        const int t0 = (d ? (SEQL / RC - 1 - ci) : ci) * RC;
        for (int p = tid; p < RC * 40; p += NWAVES * 64) {
            const int t = p / 40, rem = p - t * 40, seg = rem >> 3, c8 = (rem & 7) * 8; const int tt = t0 + t; const size_t row = (size_t)seq * SEQL + tt;
            float o[8];
            if (seg < 3) { const int col = seg * RW + h * HD + c8; shift8(P.RKV + col, RKW, row, tt, P.mu + col, o);
                LAS float* dst = (seg == 0 ? sR : (seg == 1 ? sKD : sV)) + t * 64 + c8;
                *(LAS f32x4*)dst = (f32x4){o[0], o[1], o[2], o[3]}; *(LAS f32x4*)(dst + 4) = (f32x4){o[4], o[5], o[6], o[7]}; }
            else { const int scol = (seg == 3 ? SM_WLOW : SM_ALOW) + d * 64 + c8, mcol = (seg == 3 ? MU_WLOW : MU_ALOW) + d * 64 + c8;
                shift8(P.SMALL + scol, SMW, row, tt, P.mu + mcol, o);
                if (seg == 3) {
#pragma unroll
                    for (int j = 0; j < 8; ++j) o[j] = ftanh(o[j]); }
                v4u w; w.x = cvt_pk_bf16(o[0], o[1]); w.y = cvt_pk_bf16(o[2], o[3]); w.z = cvt_pk_bf16(o[4], o[5]); w.w = cvt_pk_bf16(o[6], o[7]);
                *(LAS v4u*)((seg == 3 ? sTW : sAL) + t * 72 + c8) = w; }
        }
        __syncthreads();
        { float s = 0.f;
#pragma unroll
          for (int j = 0; j < 4; ++j) { const float q = sKD[st_t * 64 + st_s * 4 + j] * kk4[j]; s += q * q; }
          s = red16(s); if (st_s == 0) sINV[st_t] = 1.0f / sqrtf(s + 1e-12f); }
        f32x4 accw = (f32x4){0.f, 0.f, 0.f, 0.f}, acca = accw;
#pragma unroll
        for (int ks = 0; ks < 2; ++ks) { const bf16x8 aw = *(const LAS bf16x8*)(sTW + (mi * 16 + fr) * 72 + ks * 32 + fq * 8), aa = *(const LAS bf16x8*)(sAL + (mi * 16 + fr) * 72 + ks * 32 + fq * 8);
            accw = __builtin_amdgcn_mfma_f32_16x16x32_bf16(aw, Bw[ks], accw, 0, 0, 0); acca = __builtin_amdgcn_mfma_f32_16x16x32_bf16(aa, Ba[ks], acca, 0, 0, 0); }
        __syncthreads();
#pragma unroll
        for (int i = 0; i < 4; ++i) { const int t = mi * 16 + fq * 4 + i, c = ni * 16 + fr;
            const float wv = __builtin_amdgcn_exp2f(-0.875035265f * fsigmoid(accw[i] + w0c));
            const float av = fsigmoid(acca[i] + a0c);
            const float kr = sKD[t * 64 + c], kkv = kr * kkc * sINV[t];
            sW[t * 64 + c] = wv; sKK[t * 64 + c] = kkv; sB[t * 64 + c] = kkv * av; sKD[t * 64 + c] = kr * (1.0f + (av - 1.0f) * kac); }
        __syncthreads();
        { float s = 0.f;
#pragma unroll
          for (int j = 0; j < 4; ++j) s += sR[st_t * 64 + st_s * 4 + j] * sKD[st_t * 64 + st_s * 4 + j] * rk4[j];
          s = red16(s); if (st_s == 0) P.BON[((size_t)d * M + (size_t)seq * SEQL + t0 + st_t) * NH + h] = s; }
#pragma unroll 2
        for (int s = 0; s < RC; ++s) { const int t = d ? RC - 1 - s : s; const int o = t * 64 + ke * 8;
            const f32x4 k0 = *(const LAS f32x4*)(sKK + o), k1 = *(const LAS f32x4*)(sKK + o + 4), w0 = *(const LAS f32x4*)(sW + o), w1 = *(const LAS f32x4*)(sW + o + 4);
            const f32x4 b0 = *(const LAS f32x4*)(sB + o), b1 = *(const LAS f32x4*)(sB + o + 4), d0 = *(const LAS f32x4*)(sKD + o), d1 = *(const LAS f32x4*)(sKD + o + 4);
            const f32x4 r0 = *(const LAS f32x4*)(sR + o), r1 = *(const LAS f32x4*)(sR + o + 4); const float vv = sV[t * 64 + srow];
            float sa0 = S[0] * k0[0], sa1 = S[4] * k1[0];
#pragma unroll
            for (int j = 1; j < 4; ++j) { sa0 += S[j] * k0[j]; sa1 += S[4 + j] * k1[j]; }
            const float sa = -red8(sa0 + sa1);
            float y0 = 0.f, y1 = 0.f;
#pragma unroll
            for (int j = 0; j < 4; ++j) { S[j] = S[j] * w0[j] + (sa * b0[j] + vv * d0[j]); S[4 + j] = S[4 + j] * w1[j] + (sa * b1[j] + vv * d1[j]); y0 += S[j] * r0[j]; y1 += S[4 + j] * r1[j]; }
            const float y = red8(y0 + y1);
            if (ke == 0) sY[t * 64 + srow] = y; }
        __syncthreads();
        { const f32x4 yv = *(const LAS f32x4*)(sY + st_t * 64 + st_s * 4); h16x4 o; o[0] = (_Float16)yv[0]; o[1] = (_Float16)yv[1]; o[2] = (_Float16)yv[2]; o[3] = (_Float16)yv[3];
          *(h16x4*)(P.Y + ((size_t)seq * SEQL + t0 + st_t) * RW + h * HD + st_s * 4) = o; }
    }
}

constexpr int RW_AT = 66688, RW_RT = 71296, RW_BT = 75904, RW_KT = 80512, RW_BPT = 85120, RW_KPT = 89216, RW_VT = 93312, RW_LKA = 97408, RW_LRB = 98432, RW_LRK = 99456, RW_NTI = 100480, RW_LBA = 101504, RW_LAM = 103552;
__device__ __forceinline__ float quad_bcast(float v, const int n) { const int x = __builtin_bit_cast(int, v); int r;
    if (n == 0) r = __builtin_amdgcn_update_dpp(x, x, 0x00, 0xF, 0xF, false); else if (n == 1) r = __builtin_amdgcn_update_dpp(x, x, 0x55, 0xF, 0xF, false);
    else if (n == 2) r = __builtin_amdgcn_update_dpp(x, x, 0xAA, 0xF, 0xF, false); else r = __builtin_amdgcn_update_dpp(x, x, 0xFF, 0xF, 0xF, false);
    return __builtin_bit_cast(float, r); }
__device__ __forceinline__ bf16x4 pk4(float a, float b, float c, float d) { return __builtin_bit_cast(bf16x4, (v2u){cvt_pk_bf16(a, b), cvt_pk_bf16(c, d)}); }
__device__ __forceinline__ bf16x8 cat8(bf16x4 lo, bf16x4 hi) { return __builtin_shufflevector(lo, hi, 0, 1, 2, 3, 4, 5, 6, 7); }
__device__ __forceinline__ void rwkv_chain2(LAS unsigned char* lds, const RwkvP& P, int seq, int h, int d, int tid, int lane, int wave) {
    LAS float* sR = (LAS float*)(lds + RW_R); LAS float* sKD = (LAS float*)(lds + RW_KD); LAS float* sV = (LAS float*)(lds + RW_V); LAS float* sKK = (LAS float*)(lds + RW_KK);
    LAS float* sW = (LAS float*)(lds + RW_W); LAS float* sB = (LAS float*)(lds + RW_B); LAS float* sY = (LAS float*)(lds + RW_Y); LAS float* sINV = (LAS float*)(lds + RW_INV);
    LAS bf16* sTW = (LAS bf16*)(lds + RW_TW); LAS bf16* sAL = (LAS bf16*)(lds + RW_AL);
    LAS bf16* AT = (LAS bf16*)(lds + RW_AT); LAS bf16* RT = (LAS bf16*)(lds + RW_RT); LAS bf16* BT = (LAS bf16*)(lds + RW_BT); LAS bf16* KT = (LAS bf16*)(lds + RW_KT);
    LAS bf16* BPT = (LAS bf16*)(lds + RW_BPT); LAS bf16* KPT = (LAS bf16*)(lds + RW_KPT); LAS bf16* VT = (LAS bf16*)(lds + RW_VT);
    LAS bf16* LKA = (LAS bf16*)(lds + RW_LKA); LAS bf16* LRB = (LAS bf16*)(lds + RW_LRB); LAS bf16* LRK = (LAS bf16*)(lds + RW_LRK); LAS bf16* NTI = (LAS bf16*)(lds + RW_NTI);
    LAS float* LBA = (LAS float*)(lds + RW_LBA); LAS float* LAM = (LAS float*)(lds + RW_LAM);
    const int mi = wave >> 2, ni = wave & 3, fr = lane & 15, fq = lane >> 4;
    const int cc = h * HD + ni * 16 + fr;
    bf16x8 Bw[2], Ba[2];
#pragma unroll
    for (int ks = 0; ks < 2; ++ks) { unsigned w[4], a[4];
#pragma unroll
        for (int j = 0; j < 4; ++j) { const int k0 = ks * 32 + fq * 8 + 2 * j; const size_t i0 = (size_t)(d * 64 + k0) * RW + cc, i1 = i0 + RW;
            w[j] = cvt_pk_bf16(P.w2[i0], P.w2[i1]); a[j] = cvt_pk_bf16(P.a2[i0], P.a2[i1]); }
        Bw[ks] = __builtin_bit_cast(bf16x8, (v4u){w[0], w[1], w[2], w[3]}); Ba[ks] = __builtin_bit_cast(bf16x8, (v4u){a[0], a[1], a[2], a[3]}); }
    const float w0c = P.w0[d * RW + cc], a0c = P.a0[d * RW + cc], kkc = P.k_k[cc], kac = P.k_a[cc];
    const int st_t = tid >> 4, st_s = tid & 15;
    float kk4[4], rk4[4];
#pragma unroll
    for (int j = 0; j < 4; ++j) { kk4[j] = P.k_k[h * HD + st_s * 4 + j]; rk4[j] = P.r_k[h * HD + st_s * 4 + j]; }
    f32x4 S[4]; bf16x8 Sb[2];
#pragma unroll
    for (int kt = 0; kt < 4; ++kt) S[kt] = (f32x4){0.f, 0.f, 0.f, 0.f};
    Sb[0] = (bf16x8){0, 0, 0, 0, 0, 0, 0, 0}; Sb[1] = Sb[0];

    for (int ci = 0; ci < SEQL / RC; ++ci) {
        const int t0 = (d ? (SEQL / RC - 1 - ci) : ci) * RC;
        for (int p = tid; p < RC * 40; p += NWAVES * 64) {
            const int t = p / 40, rem = p - t * 40, seg = rem >> 3, c8 = (rem & 7) * 8; const int tt = t0 + (d ? RC - 1 - t : t); const size_t row = (size_t)seq * SEQL + tt;
            float o[8];
            if (seg < 3) { const int col = seg * RW + h * HD + c8; shift8(P.RKV + col, RKW, row, tt, P.mu + col, o);
                LAS float* dst = (seg == 0 ? sR : (seg == 1 ? sKD : sV)) + t * 64 + c8;
                *(LAS f32x4*)dst = (f32x4){o[0], o[1], o[2], o[3]}; *(LAS f32x4*)(dst + 4) = (f32x4){o[4], o[5], o[6], o[7]}; }
            else { const int scol = (seg == 3 ? SM_WLOW : SM_ALOW) + d * 64 + c8, mcol = (seg == 3 ? MU_WLOW : MU_ALOW) + d * 64 + c8;
                shift8(P.SMALL + scol, SMW, row, tt, P.mu + mcol, o);
                if (seg == 3) {
#pragma unroll
                    for (int j = 0; j < 8; ++j) o[j] = ftanh(o[j]); }
                v4u w; w.x = cvt_pk_bf16(o[0], o[1]); w.y = cvt_pk_bf16(o[2], o[3]); w.z = cvt_pk_bf16(o[4], o[5]); w.w = cvt_pk_bf16(o[6], o[7]);
                *(LAS v4u*)((seg == 3 ? sTW : sAL) + t * 72 + c8) = w; }
        }
        __syncthreads();
        { float s = 0.f;
#pragma unroll
          for (int j = 0; j < 4; ++j) { const float q = sKD[st_t * 64 + st_s * 4 + j] * kk4[j]; s += q * q; }
          s = red16(s); if (st_s == 0) sINV[st_t] = 1.0f / sqrtf(s + 1e-12f); }
        f32x4 accw = (f32x4){0.f, 0.f, 0.f, 0.f}, acca = accw;
#pragma unroll
        for (int ks = 0; ks < 2; ++ks) { const bf16x8 aw = *(const LAS bf16x8*)(sTW + (mi * 16 + fr) * 72 + ks * 32 + fq * 8), aa = *(const LAS bf16x8*)(sAL + (mi * 16 + fr) * 72 + ks * 32 + fq * 8);
            accw = __builtin_amdgcn_mfma_f32_16x16x32_bf16(aw, Bw[ks], accw, 0, 0, 0); acca = __builtin_amdgcn_mfma_f32_16x16x32_bf16(aa, Ba[ks], acca, 0, 0, 0); }
        __syncthreads();
#pragma unroll
        for (int i = 0; i < 4; ++i) { const int t = mi * 16 + fq * 4 + i, c = ni * 16 + fr;
            const float lw = -0.875035265f * fsigmoid(accw[i] + w0c);
            const float av = fsigmoid(acca[i] + a0c);
            const float kr = sKD[t * 64 + c], kkv = kr * kkc * sINV[t];
            sW[t * 64 + c] = lw; sKK[t * 64 + c] = kkv; sB[t * 64 + c] = kkv * av; sKD[t * 64 + c] = kr * (1.0f + (av - 1.0f) * kac); }
        __syncthreads();
        { float s = 0.f;
#pragma unroll
          for (int j = 0; j < 4; ++j) s += sR[st_t * 64 + st_s * 4 + j] * sKD[st_t * 64 + st_s * 4 + j] * rk4[j];
          s = red16(s); if (st_s == 0) P.BON[((size_t)d * M + (size_t)seq * SEQL + t0 + (d ? RC - 1 - st_t : st_t)) * NH + h] = s; }
        { const int c = tid >> 8, k = (tid >> 2) & 63, qq = tid & 3, sb = 16 * c + 4 * qq;
          float lw[4], cum[4];
#pragma unroll
          for (int i = 0; i < 4; ++i) lw[i] = sW[(sb + i) * 64 + k];
          cum[0] = lw[0]; cum[1] = cum[0] + lw[1]; cum[2] = cum[1] + lw[2]; cum[3] = cum[2] + lw[3];
          const float q0 = quad_bcast(cum[3], 0), q1 = quad_bcast(cum[3], 1), q2 = quad_bcast(cum[3], 2), q3 = quad_bcast(cum[3], 3);
          const float off = (qq > 0 ? q0 : 0.f) + (qq > 1 ? q1 : 0.f) + (qq > 2 ? q2 : 0.f), c15 = (q0 + q1) + (q2 + q3);
          float bp[4], kp[4], vv[4];
#pragma unroll
          for (int i = 0; i < 4; ++i) { const int s = sb + i, sl = 4 * qq + i; const float cs = off + cum[i];
              const float lam = __builtin_amdgcn_exp2f(cs), ilam = __builtin_amdgcn_exp2f(-cs), lprev = __builtin_amdgcn_exp2f(cs - lw[i]), rat = __builtin_amdgcn_exp2f(c15 - cs);
              const float kkv = sKK[s * 64 + k], bv = sB[s * 64 + k], kd = sKD[s * 64 + k], rv = sR[s * 64 + k];
              AT[(c * 16 + sl) * 72 + k] = (bf16)f2bf(kkv * lprev); RT[(c * 16 + sl) * 72 + k] = (bf16)f2bf(rv * lam); BT[(c * 16 + sl) * 72 + k] = (bf16)f2bf(bv * ilam); KT[(c * 16 + sl) * 72 + k] = (bf16)f2bf(kd * ilam);
              bp[i] = bv * rat; kp[i] = kd * rat; vv[i] = sV[s * 64 + k]; }
          *(LAS bf16x4*)(BPT + (c * 64 + k) * 16 + 4 * qq) = pk4(bp[0], bp[1], bp[2], bp[3]); *(LAS bf16x4*)(KPT + (c * 64 + k) * 16 + 4 * qq) = pk4(kp[0], kp[1], kp[2], kp[3]);
          *(LAS bf16x4*)(VT + (c * 64 + k) * 16 + 4 * qq) = pk4(vv[0], vv[1], vv[2], vv[3]);
          if (qq == 0) LAM[c * 64 + k] = __builtin_amdgcn_exp2f(c15); }
        __syncthreads();
        { const int c = wave >> 2, mat = wave & 3; const LAS bf16* Ax = (mat < 2 ? AT : RT) + c * 16 * 72; const LAS bf16* Bx = ((mat & 1) == 0 ? BT : KT) + c * 16 * 72;
          f32x4 acc = (f32x4){0.f, 0.f, 0.f, 0.f};
#pragma unroll
          for (int ks = 0; ks < 2; ++ks) { const bf16x8 a = *(const LAS bf16x8*)(Ax + fr * 72 + ks * 32 + fq * 8), b = *(const LAS bf16x8*)(Bx + fr * 72 + ks * 32 + fq * 8);
              acc = __builtin_amdgcn_mfma_f32_16x16x32_bf16(a, b, acc, 0, 0, 0); }
#pragma unroll
          for (int i = 0; i < 4; ++i) { const int s = 4 * fq + i, j = fr; const bool keep = mat < 2 ? (j < s) : (j <= s); const float v = keep ? acc[i] : 0.f;
              if (mat == 0) LBA[c * 256 + s * 16 + j] = v; else (mat == 1 ? LKA : (mat == 2 ? LRB : LRK))[c * 256 + s * 16 + j] = (bf16)f2bf(v); } }
        __syncthreads();
        if (wave == 0 && lane < 32) { const int c = lane >> 4, col = lane & 15; float T[16];
#pragma unroll
            for (int s = 0; s < 16; ++s) { float t = (s == col) ? 1.0f : 0.f;
                const LAS float* Lr = LBA + c * 256 + s * 16;
#pragma unroll
                for (int j = 0; j < s; ++j) t -= Lr[j] * T[j];
                T[s] = t; NTI[c * 256 + s * 16 + col] = (bf16)f2bf(-t); } }
        __syncthreads();
        if (wave < 4) {
#pragma unroll
            for (int c = 0; c < 2; ++c) {
                const bf16x4 vt = *(const LAS bf16x4*)(VT + (c * 64 + 16 * wave + fr) * 16 + 4 * fq);
                f32x4 w1 = __builtin_amdgcn_mfma_f32_16x16x16bf16_1k(*(const LAS bf16x4*)(LKA + c * 256 + fr * 16 + 4 * fq), vt, (f32x4){0.f, 0.f, 0.f, 0.f}, 0, 0, 0);
                f32x4 y = __builtin_amdgcn_mfma_f32_16x16x16bf16_1k(*(const LAS bf16x4*)(LRK + c * 256 + fr * 16 + 4 * fq), vt, (f32x4){0.f, 0.f, 0.f, 0.f}, 0, 0, 0);
#pragma unroll
                for (int ks = 0; ks < 2; ++ks) { const LAS bf16* ar = AT + (c * 16 + fr) * 72 + 32 * ks + 4 * fq; const LAS bf16* rr = RT + (c * 16 + fr) * 72 + 32 * ks + 4 * fq;
                    w1 = __builtin_amdgcn_mfma_f32_16x16x32_bf16(cat8(*(const LAS bf16x4*)ar, *(const LAS bf16x4*)(ar + 16)), Sb[ks], w1, 0, 0, 0);
                    y = __builtin_amdgcn_mfma_f32_16x16x32_bf16(cat8(*(const LAS bf16x4*)rr, *(const LAS bf16x4*)(rr + 16)), Sb[ks], y, 0, 0, 0); }
                const f32x4 sa = __builtin_amdgcn_mfma_f32_16x16x16bf16_1k(*(const LAS bf16x4*)(NTI + c * 256 + fr * 16 + 4 * fq), pk4(w1[0], w1[1], w1[2], w1[3]), (f32x4){0.f, 0.f, 0.f, 0.f}, 0, 0, 0);
                const bf16x4 sab = pk4(sa[0], sa[1], sa[2], sa[3]);
                y = __builtin_amdgcn_mfma_f32_16x16x16bf16_1k(*(const LAS bf16x4*)(LRB + c * 256 + fr * 16 + 4 * fq), sab, y, 0, 0, 0);
#pragma unroll
                for (int i = 0; i < 4; ++i) sY[(16 * c + 4 * fq + i) * 64 + 16 * wave + fr] = y[i];
#pragma unroll
                for (int kt = 0; kt < 4; ++kt) { const f32x4 lm = *(const LAS f32x4*)(LAM + c * 64 + 16 * kt + 4 * fq); f32x4 sn = S[kt] * lm;
                    sn = __builtin_amdgcn_mfma_f32_16x16x16bf16_1k(*(const LAS bf16x4*)(BPT + (c * 64 + 16 * kt + fr) * 16 + 4 * fq), sab, sn, 0, 0, 0);
                    sn = __builtin_amdgcn_mfma_f32_16x16x16bf16_1k(*(const LAS bf16x4*)(KPT + (c * 64 + 16 * kt + fr) * 16 + 4 * fq), vt, sn, 0, 0, 0);
                    S[kt] = sn; }
#pragma unroll
                for (int ks = 0; ks < 2; ++ks) Sb[ks] = cat8(pk4(S[2 * ks][0], S[2 * ks][1], S[2 * ks][2], S[2 * ks][3]), pk4(S[2 * ks + 1][0], S[2 * ks + 1][1], S[2 * ks + 1][2], S[2 * ks + 1][3]));
            }
        }
        __syncthreads();
        { const f32x4 yv = *(const LAS f32x4*)(sY + st_t * 64 + st_s * 4); h16x4 o; o[0] = (_Float16)yv[0]; o[1] = (_Float16)yv[1]; o[2] = (_Float16)yv[2]; o[3] = (_Float16)yv[3];
          *(h16x4*)(P.Y + ((size_t)seq * SEQL + t0 + (d ? RC - 1 - st_t : st_t)) * RW + h * HD + st_s * 4) = o; }
    }
}

constexpr int C3_MU = 115840, C3_KK = 117120, C3_TSCR = 117376, C3_RAW = 118912;
static_assert(C3_RAW + 32 * 656 <= LDSCTL_OFF && 32 * 656 <= 24576, "rwkv LDS map");
constexpr int C3_R = 0, C3_KR = 8192, C3_V = 16384, C3_TW = 24576, C3_AL = 29184, C3_INV = 33792, C3_BONP = 33920  , C3_Y = 34944, C3_LBA = 43136, C3_LX = 45184, C3_TB = 53376, C3_TBSZ = 31232;
constexpr int T_AT = 0, T_RT = 4608, T_BT = 9216, T_KT = 13824, T_BPT = 18432, T_KPT = 22528, T_VT = 26624, T_LAM = 30720, X_LKA = 0, X_LRB = 1024, X_LRK = 2048, X_NTI = 3072;
__device__ __forceinline__ bf16 bf1(float x) { return __builtin_bit_cast(bf16, (__bf16)x); }
__device__ __forceinline__ float bf2f_(bf16 b) { return __builtin_bit_cast(float, (unsigned)b << 16); }
__device__ __forceinline__ void rwkv_chain3(LAS unsigned char* lds, const RwkvP& P, int seq, int h, int d, int tid, int lane, int wave, const int probe) {
    LAS float* sR = (LAS float*)(lds + C3_R); LAS float* sKr = (LAS float*)(lds + C3_KR); LAS float* sV = (LAS float*)(lds + C3_V);
    LAS bf16* sTW = (LAS bf16*)(lds + C3_TW); LAS bf16* sAL = (LAS bf16*)(lds + C3_AL); LAS float* sINV = (LAS float*)(lds + C3_INV); LAS float* sBONP = (LAS float*)(lds + C3_BONP);
    LAS float* sY = (LAS float*)(lds + C3_Y); LAS float* LBA = (LAS float*)(lds + C3_LBA);
    constexpr int NR = SEQL / RC;
    const int mi = wave >> 2, ni = wave & 3, fr = lane & 15, fq = lane >> 4;
    const int cc = h * HD + ni * 16 + fr;
    bf16x8 Bw[2], Ba[2];
#pragma unroll
    for (int ks = 0; ks < 2; ++ks) { unsigned w[4], a[4];
#pragma unroll
        for (int j = 0; j < 4; ++j) { const int k0 = ks * 32 + fq * 8 + 2 * j; const size_t i0 = (size_t)(d * 64 + k0) * RW + cc, i1 = i0 + RW;
            w[j] = cvt_pk_bf16(P.w2[i0], P.w2[i1]); a[j] = cvt_pk_bf16(P.a2[i0], P.a2[i1]); }
        Bw[ks] = __builtin_bit_cast(bf16x8, (v4u){w[0], w[1], w[2], w[3]}); Ba[ks] = __builtin_bit_cast(bf16x8, (v4u){a[0], a[1], a[2], a[3]}); }
    const float w0c = P.w0[d * RW + cc], a0c = P.a0[d * RW + cc], kkc = P.k_k[cc], kac = P.k_a[cc], rkc = P.r_k[cc];
    const int st_t = tid >> 4, st_s = tid & 15;
    LAS float* sMU = (LAS float*)(lds + C3_MU); LAS float* sKK = (LAS float*)(lds + C3_KK);
    if (tid < 320) { const int sg = tid >> 6, c = tid & 63; sMU[tid] = P.mu[sg < 3 ? sg * RW + h * HD + c : (sg == 3 ? MU_WLOW : MU_ALOW) + d * 64 + c]; } else if (tid < 384) sKK[tid - 320] = P.k_k[h * HD + tid - 320];
    LAS bf16* sRAW0 = (LAS bf16*)(lds + C3_RAW); LAS bf16* sRAW1 = (LAS bf16*)(lds + C3_R);
    LAS float* sINVB = (LAS float*)(lds + C3_TW);
    int prr[3], pcol[3], psrc[3];
#pragma unroll
    for (int it = 0; it < 3; ++it) { const int p = tid + it * NWAVES * 64; const int rr = p / 40, rem = p - rr * 40, sg = rem >> 3, c8 = (rem & 7) * 8; prr[it] = rr; pcol[it] = sg * 64 + c8;
        psrc[it] = sg < 3 ? sg * RW + h * HD + c8 : (sg == 3 ? DS_TW : DS_AL) + d * 64 + c8; }
    v4u gc[3]; float ginv = 0.f;
#define C3_ISSUE(q) do { const int _t0 = (d ? (NR - 1 - (q)) : (q)) * RC; _Pragma("unroll") for (int it = 0; it < 3; ++it) { const int tt = _t0 + (d ? RC - 1 - prr[it] : prr[it]); \
        gc[it] = ((tid + it * NWAVES * 64) < RC * 40) ? *(const v4u*)(P.RKV + ((size_t)seq * SEQL + tt) * DSW + psrc[it]) : (v4u){0u, 0u, 0u, 0u}; } \
        if (tid < RC) ginv = ((const float*)(P.RKV + ((size_t)seq * SEQL + _t0 + (d ? RC - 1 - tid : tid)) * DSW + DS_INV))[h]; } while (0)
#define C3_RAWWR(q) do { LAS bf16* sRAW = ((q) & 1) ? sRAW1 : sRAW0; _Pragma("unroll") for (int it = 0; it < 3; ++it) if ((tid + it * NWAVES * 64) < RC * 40) *(LAS v4u*)(sRAW + prr[it] * 328 + pcol[it]) = gc[it]; \
        if (tid < RC) sINVB[((q) & 1) * 32 + tid] = ginv; } while (0)
    f32x4 S[4]; bf16x8 Sb[2];
#pragma unroll
    for (int kt = 0; kt < 4; ++kt) S[kt] = (f32x4){0.f, 0.f, 0.f, 0.f};
    Sb[0] = (bf16x8){0, 0, 0, 0, 0, 0, 0, 0}; Sb[1] = Sb[0];
    const int vw = wave & 3;
    C3_ISSUE(0); C3_RAWWR(0); C3_ISSUE(1);
    __syncthreads();
#ifdef TPROBE
    unsigned long long tpa0 = 0, tpa1 = 0, tps0 = 0, tps1 = 0, tpr0 = 0, tpt0 = 0, tpr1 = 0, tpt1 = 0;
#define TPT(k) do { const bool inr = i >= 4 && i < NR - 4; \
        if (wave == TP_WAVE) { if ((k) == 0) tpr0 = __builtin_amdgcn_s_memtime(); if ((k) == TP_FROM) tps0 = __builtin_amdgcn_s_memtime(); if ((k) == TP_TO && inr) tpa0 += __builtin_amdgcn_s_memtime() - tps0; if ((k) == 6 && inr) tpt0 += __builtin_amdgcn_s_memtime() - tpr0; } \
        if (wave == TP2_WAVE) { if ((k) == 0) tpr1 = __builtin_amdgcn_s_memtime(); if ((k) == TP2_FROM) tps1 = __builtin_amdgcn_s_memtime(); if ((k) == TP2_TO && inr) tpa1 += __builtin_amdgcn_s_memtime() - tps1; if ((k) == 6 && inr) tpt1 += __builtin_amdgcn_s_memtime() - tpr1; } } while (0)
#else
#define TPT(k) do { } while (0)
#endif
    for (int i = 0; i <= NR + 1; ++i) {
        TPT(0);
        if (i + 1 < NR && probe != 7) C3_RAWWR(i + 1);
        if (i + 2 < NR && probe != 7) C3_ISSUE(i + 2);
        if (i >= 2 && probe == 0) { const int q = i - 2, t0 = (d ? (NR - 1 - q) : q) * RC;
            const f32x4 yv = *(const LAS f32x4*)(sY + st_t * 64 + st_s * 4); h16x4 o; o[0] = (_Float16)yv[0]; o[1] = (_Float16)yv[1]; o[2] = (_Float16)yv[2]; o[3] = (_Float16)yv[3];
            *(h16x4*)(P.Y + ((size_t)seq * SEQL + t0 + (d ? RC - 1 - st_t : st_t)) * RW + h * HD + st_s * 4) = o; }
        if (i >= 1 && i <= NR && tid < RC && probe == 0) { const int q = i - 1, t0 = (d ? (NR - 1 - q) : q) * RC; const f32x4 b = *(const LAS f32x4*)(sBONP + ((i - 1) & 1) * 128 + tid * 4);
            P.BON[((size_t)d * M + (size_t)seq * SEQL + t0 + (d ? RC - 1 - tid : tid)) * NH + h] = (b[0] + b[1]) + (b[2] + b[3]); }
        TPT(7);
        if (i < NR && probe != 3 && probe != 6) { LAS unsigned char* tb = lds + C3_TB + (i & 1) * C3_TBSZ;
            LAS bf16* AT = (LAS bf16*)(tb + T_AT); LAS bf16* RT = (LAS bf16*)(tb + T_RT); LAS bf16* BT = (LAS bf16*)(tb + T_BT); LAS bf16* KT = (LAS bf16*)(tb + T_KT);
            LAS bf16* BPT = (LAS bf16*)(tb + T_BPT); LAS bf16* KPT = (LAS bf16*)(tb + T_KPT); LAS bf16* VT = (LAS bf16*)(tb + T_VT); LAS float* LAM = (LAS float*)(tb + T_LAM);
            const LAS bf16* rawb = (i & 1) ? sRAW1 : sRAW0; const LAS float* invb = sINVB + (i & 1) * 32;
            const int c = mi, k = ni * 16 + fr;
            f32x4 accw = (f32x4){0.f, 0.f, 0.f, 0.f}, acca = accw;
#pragma unroll
            for (int ks = 0; ks < 2; ++ks) { const bf16x8 aw = *(const LAS bf16x8*)(rawb + (c * 16 + fr) * 328 + 192 + ks * 32 + fq * 8), aa = *(const LAS bf16x8*)(rawb + (c * 16 + fr) * 328 + 256 + ks * 32 + fq * 8);
                accw = __builtin_amdgcn_mfma_f32_16x16x32_bf16(aw, Bw[ks], accw, 0, 0, 0); acca = __builtin_amdgcn_mfma_f32_16x16x32_bf16(aa, Ba[ks], acca, 0, 0, 0); }
            float lw[4], kkv[4], bv[4], kd[4], rv[4], vv[4], cum[4]; float bon[4];
            const f32x4 inv4 = *(const LAS f32x4*)(invb + 16 * c + 4 * fq);
#pragma unroll
            for (int j = 0; j < 4; ++j) { const int s = 16 * c + 4 * fq + j;
                lw[j] = -0.875035265f * fsigmoid(accw[j] + w0c); const float av = fsigmoid(acca[j] + a0c);
                const float kr = bf2f_(rawb[s * 328 + 64 + k]); kkv[j] = kr * kkc * inv4[j]; bv[j] = kkv[j] * av; kd[j] = kr * (1.0f + (av - 1.0f) * kac); rv[j] = bf2f_(rawb[s * 328 + k]); vv[j] = bf2f_(rawb[s * 328 + 128 + k]);
                bon[j] = rv[j] * kd[j] * rkc; }
            cum[0] = lw[0]; cum[1] = cum[0] + lw[1]; cum[2] = cum[1] + lw[2]; cum[3] = cum[2] + lw[3];
            const float q0 = __shfl(cum[3], fr), q1 = __shfl(cum[3], fr + 16), q2 = __shfl(cum[3], fr + 32), q3 = __shfl(cum[3], fr + 48);
            const float off = (fq > 0 ? q0 : 0.f) + (fq > 1 ? q1 : 0.f) + (fq > 2 ? q2 : 0.f), c15 = (q0 + q1) + (q2 + q3);
            const float l15 = __builtin_amdgcn_exp2f(c15);
            float bp[4], kp[4]; float lprev = __builtin_amdgcn_exp2f(off);
#pragma unroll
            for (int j = 0; j < 4; ++j) { const int sl = 4 * fq + j; const float cs = off + cum[j];
                const float lam = __builtin_amdgcn_exp2f(cs), ilam = __builtin_amdgcn_exp2f(-cs), rat = l15 * ilam;
                AT[(c * 16 + sl) * 72 + k] = bf1(kkv[j] * lprev); RT[(c * 16 + sl) * 72 + k] = bf1(rv[j] * lam); BT[(c * 16 + sl) * 72 + k] = bf1(bv[j] * ilam); KT[(c * 16 + sl) * 72 + k] = bf1(kd[j] * ilam);
                bp[j] = bv[j] * rat; kp[j] = kd[j] * rat; lprev = lam; }
            *(LAS bf16x4*)(BPT + (c * 64 + k) * 16 + 4 * fq) = pk4(bp[0], bp[1], bp[2], bp[3]); *(LAS bf16x4*)(KPT + (c * 64 + k) * 16 + 4 * fq) = pk4(kp[0], kp[1], kp[2], kp[3]);
            *(LAS bf16x4*)(VT + (c * 64 + k) * 16 + 4 * fq) = pk4(vv[0], vv[1], vv[2], vv[3]);
            if (fq == 0) LAM[c * 64 + k] = l15;
            { const float s0 = red16(bon[0]), s1 = red16(bon[1]), s2 = red16(bon[2]), s3 = red16(bon[3]);
              if (fr == 0) { LAS float* bo = sBONP + (i & 1) * 128 + (16 * c + 4 * fq) * 4 + ni; bo[0] = s0; bo[4] = s1; bo[8] = s2; bo[12] = s3; } }
        }
        TPT(1);
        __syncthreads();
        TPT(2);
#pragma unroll
        for (int half = 0; half < 2; ++half) {
            if (wave < 4) {
                {
                if (i < NR && probe != 2 && probe != 6) { LAS unsigned char* tb = lds + C3_TB + (i & 1) * C3_TBSZ; LAS unsigned char* lx = lds + C3_LX + (i & 1) * 4096; (void)tb;
                    const int c = wave & 1;
                    if (half == 0)
#pragma unroll
                    for (int mm = 0; mm < 3; ++mm) if (wave >= 2 || mm == 0) { const int mat = wave < 2 ? 0 : mm + 1;
                        const LAS bf16* Ax = (const LAS bf16*)(tb + (mat < 2 ? T_AT : T_RT)) + c * 16 * 72; const LAS bf16* Bx = (const LAS bf16*)(tb + ((mat & 1) == 0 ? T_BT : T_KT)) + c * 16 * 72; f32x4 acc = (f32x4){0.f, 0.f, 0.f, 0.f};
#pragma unroll
                        for (int ks = 0; ks < 2; ++ks) { const bf16x8 a = *(const LAS bf16x8*)(Ax + fr * 72 + ks * 32 + fq * 8), b = *(const LAS bf16x8*)(Bx + fr * 72 + ks * 32 + fq * 8);
                            acc = __builtin_amdgcn_mfma_f32_16x16x32_bf16(a, b, acc, 0, 0, 0); }
#pragma unroll
                        for (int j = 0; j < 4; ++j) { const int s = 4 * fq + j, jj = fr; const bool keep = mat < 2 ? (jj < s) : (jj <= s); const float v = keep ? acc[j] : 0.f;
                            if (mat == 0) LBA[c * 256 + s * 16 + jj] = v; else ((LAS bf16*)(lx + (mat == 1 ? X_LKA : (mat == 2 ? X_LRB : X_LRK))))[c * 256 + s * 16 + jj] = bf1(v); } }
                    if (wave < 2) { LAS bf16* NTI = (LAS bf16*)(lx + X_NTI) + c * 256; const LAS float* L = LBA + c * 256;
                        LAS float* TS = (LAS float*)(lds + C3_TSCR) + c * 192;
                        if (half == 0) {
                        LDS_WAIT(); __builtin_amdgcn_wave_barrier();
                        if (lane < 16) { const int blk = lane >> 3, col = lane & 7; float T[8];
#pragma unroll
                            for (int s = 0; s < 8; ++s) { float t = (s == col) ? 1.0f : 0.f; const LAS float* Lr = L + (8 * blk + s) * 16 + 8 * blk;
#pragma unroll
                                for (int j = 0; j < s; ++j) t -= Lr[j] * T[j];
                                T[s] = t; TS[blk * 64 + s * 8 + col] = t; NTI[(8 * blk + s) * 16 + 8 * blk + col] = bf1(-t); if (blk == 0) NTI[s * 16 + 8 + col] = (bf16)0; } }
                        } else {
                        { const int r = lane >> 3, cq = lane & 7; float x = 0.f;
#pragma unroll
                          for (int j = 0; j < 8; ++j) x += L[(8 + r) * 16 + j] * TS[j * 8 + cq];
                          TS[128 + r * 8 + cq] = x; }
                        LDS_WAIT(); __builtin_amdgcn_wave_barrier();
                        { const int r = lane >> 3, cq = lane & 7; float y = 0.f;
#pragma unroll
                          for (int j = 0; j < 8; ++j) y += TS[64 + r * 8 + j] * TS[128 + j * 8 + cq];
                          NTI[(8 + r) * 16 + cq] = bf1(y); } } }
                }
                }
            } else {
            if (i >= 1 && i <= NR && probe != 1 && probe != 6) { const int c = half; LAS unsigned char* tb = lds + C3_TB + ((i - 1) & 1) * C3_TBSZ; LAS unsigned char* lx = lds + C3_LX + ((i - 1) & 1) * 4096;
                const LAS bf16* AT = (const LAS bf16*)(tb + T_AT); const LAS bf16* RT = (const LAS bf16*)(tb + T_RT); const LAS bf16* BPT = (const LAS bf16*)(tb + T_BPT); const LAS bf16* KPT = (const LAS bf16*)(tb + T_KPT);
                const LAS bf16* VT = (const LAS bf16*)(tb + T_VT); const LAS float* LAM = (const LAS float*)(tb + T_LAM);
                const LAS bf16* LKA = (const LAS bf16*)(lx + X_LKA); const LAS bf16* LRB = (const LAS bf16*)(lx + X_LRB); const LAS bf16* LRK = (const LAS bf16*)(lx + X_LRK); const LAS bf16* NTI = (const LAS bf16*)(lx + X_NTI);
                const bf16x4 vt = *(const LAS bf16x4*)(VT + (c * 64 + 16 * vw + fr) * 16 + 4 * fq);
                f32x4 w1 = __builtin_amdgcn_mfma_f32_16x16x16bf16_1k(*(const LAS bf16x4*)(LKA + c * 256 + fr * 16 + 4 * fq), vt, (f32x4){0.f, 0.f, 0.f, 0.f}, 0, 0, 0);
                f32x4 y = __builtin_amdgcn_mfma_f32_16x16x16bf16_1k(*(const LAS bf16x4*)(LRK + c * 256 + fr * 16 + 4 * fq), vt, (f32x4){0.f, 0.f, 0.f, 0.f}, 0, 0, 0);
#pragma unroll
                for (int ks = 0; ks < 2; ++ks) { const LAS bf16* ar = AT + (c * 16 + fr) * 72 + 32 * ks + 4 * fq; const LAS bf16* rr = RT + (c * 16 + fr) * 72 + 32 * ks + 4 * fq;
                    w1 = __builtin_amdgcn_mfma_f32_16x16x32_bf16(cat8(*(const LAS bf16x4*)ar, *(const LAS bf16x4*)(ar + 16)), Sb[ks], w1, 0, 0, 0);
                    y = __builtin_amdgcn_mfma_f32_16x16x32_bf16(cat8(*(const LAS bf16x4*)rr, *(const LAS bf16x4*)(rr + 16)), Sb[ks], y, 0, 0, 0); }
                const f32x4 sa = __builtin_amdgcn_mfma_f32_16x16x16bf16_1k(*(const LAS bf16x4*)(NTI + c * 256 + fr * 16 + 4 * fq), pk4(w1[0], w1[1], w1[2], w1[3]), (f32x4){0.f, 0.f, 0.f, 0.f}, 0, 0, 0);
                const bf16x4 sab = pk4(sa[0], sa[1], sa[2], sa[3]);
                y = __builtin_amdgcn_mfma_f32_16x16x16bf16_1k(*(const LAS bf16x4*)(LRB + c * 256 + fr * 16 + 4 * fq), sab, y, 0, 0, 0);
#pragma unroll
                for (int j = 0; j < 4; ++j) sY[(16 * c + 4 * fq + j) * 64 + 16 * vw + fr] = y[j];
#pragma unroll
                for (int kt = 0; kt < 4; ++kt) { const f32x4 lm = *(const LAS f32x4*)(LAM + c * 64 + 16 * kt + 4 * fq); f32x4 sn = S[kt] * lm;
                    sn = __builtin_amdgcn_mfma_f32_16x16x16bf16_1k(*(const LAS bf16x4*)(BPT + (c * 64 + 16 * kt + fr) * 16 + 4 * fq), sab, sn, 0, 0, 0);
                    sn = __builtin_amdgcn_mfma_f32_16x16x16bf16_1k(*(const LAS bf16x4*)(KPT + (c * 64 + 16 * kt + fr) * 16 + 4 * fq), vt, sn, 0, 0, 0);
                    S[kt] = sn; }
#pragma unroll
                for (int ks = 0; ks < 2; ++ks) Sb[ks] = cat8(pk4(S[2 * ks][0], S[2 * ks][1], S[2 * ks][2], S[2 * ks][3]), pk4(S[2 * ks + 1][0], S[2 * ks + 1][1], S[2 * ks + 1][2], S[2 * ks + 1][3]));
            }
            }
            if (half == 0) TPT(3); else TPT(5);
            __syncthreads();
            if (half == 0) TPT(4); else TPT(6);
        }
    }
#ifdef TPROBE
    if (seq == 0 && h == 3 && d == 0 && lane == 0) { if (wave == TP_WAVE) P.tp[0] = 100.0f * (float)tpa0 / (float)tpt0; if (wave == TP2_WAVE) P.tp[1] = 100.0f * (float)tpa1 / (float)tpt1; }
#endif
#undef C3_ISSUE
#undef C3_RAWWR
}

constexpr int S5_WL = 14592;
struct S5Pm { const bf16* SMALL; const float *a_re, *a_im, *log_step, *b_re, *b_im, *c_re, *c_im; _Float16* Yp; };
__device__ __forceinline__ void s5_wave(LAS unsigned char* wl, const S5Pm& P, int seq, int g, int d, int lane) {
    LAS float* BU = (LAS float*)wl; LAS bf16* ST = (LAS bf16*)(wl + 10240);
    const int fr = lane & 15, fq = lane >> 4; const int dg = d * S5G + g;
    const float dt = expf(P.log_step[dg]);
    float lr, li;
    { const float are = P.a_re[dg * S5P + lane], aim = P.a_im[dg * S5P + lane]; const float mag = expf(are * dt); lr = mag * cosf(aim * dt); li = mag * sinf(aim * dt); }
    bf16x4 Bre[4], Bim[4];
#pragma unroll
    for (int jj = 0; jj < 4; ++jj) { const int p = 16 * jj + fr; const float are = P.a_re[dg * S5P + p], aim = P.a_im[dg * S5P + p]; const float mag = expf(are * dt);
        const float pr = mag * cosf(aim * dt), pi = mag * sinf(aim * dt); const float nr = pr - 1.0f, nim = pi, den = 1.0f / (are * are + aim * aim);
        const float cr = (nr * are + nim * aim) * den, ci = (nim * are - nr * aim) * den;
        float vr[4], vi[4];
#pragma unroll
        for (int j = 0; j < 4; ++j) { const size_t bi = ((size_t)dg * S5P + p) * S5C + 4 * fq + j; const float br = P.b_re[bi], bim = P.b_im[bi]; vr[j] = cr * br - ci * bim; vi[j] = cr * bim + ci * br; }
        Bre[jj] = __builtin_bit_cast(bf16x4, (v2u){cvt_pk_bf16(vr[0], vr[1]), cvt_pk_bf16(vr[2], vr[3])}); Bim[jj] = __builtin_bit_cast(bf16x4, (v2u){cvt_pk_bf16(vi[0], vi[1]), cvt_pk_bf16(vi[2], vi[3])}); }
    bf16x8 Cf[4];
#pragma unroll
    for (int ks = 0; ks < 4; ++ks) { const int k0 = (ks & 1) * 32 + fq * 8; const float* src = (ks < 2 ? P.c_re : P.c_im) + ((size_t)g * S5C + fr) * S5P + k0; const float sg = ks < 2 ? 1.0f : -1.0f;
        const f32x4 c0 = *(const f32x4*)src, c1 = *(const f32x4*)(src + 4);
        Cf[ks] = __builtin_bit_cast(bf16x8, (v4u){cvt_pk_bf16(sg * c0[0], sg * c0[1]), cvt_pk_bf16(sg * c0[2], sg * c0[3]), cvt_pk_bf16(sg * c1[0], sg * c1[1]), cvt_pk_bf16(sg * c1[2], sg * c1[3])}); }
    float xr = 0.f, xi = 0.f;
    const bf16* ub = P.SMALL + DS_U + g * S5C + 4 * fq;
    constexpr int NCH = SEQL / 16;
    v2u un1 = *(const v2u*)(ub + ((size_t)seq * SEQL + (size_t)(d ? NCH - 1 : 0) * 16 + fr) * DSW), un2 = *(const v2u*)(ub + ((size_t)seq * SEQL + (size_t)(d ? NCH - 2 : 1) * 16 + fr) * DSW);
    for (int ci = 0; ci < NCH; ++ci) {
        const int ch = d ? (NCH - 1 - ci) : ci; const size_t tok0 = (size_t)seq * SEQL + (size_t)ch * 16;
        const bf16x4 ua = __builtin_bit_cast(bf16x4, un1); un1 = un2;
        { const int cn = ci + 2 < NCH ? ci + 2 : ci; const int chn = d ? (NCH - 1 - cn) : cn; un2 = *(const v2u*)(ub + ((size_t)seq * SEQL + (size_t)chn * 16 + fr) * DSW); }
        const f32x4 z = (f32x4){0.f, 0.f, 0.f, 0.f};
#pragma unroll
        for (int jt = 0; jt < 8; ++jt) { const f32x4 acc = __builtin_amdgcn_mfma_f32_16x16x16bf16_1k(ua, jt < 4 ? Bre[jt] : Bim[jt - 4], z, 0, 0, 0);
            *(LAS f32x4*)(BU + (jt * 16 + fr) * 20 + 4 * fq) = acc; }
        LDS_WAIT(); __builtin_amdgcn_wave_barrier();
        float bre[16], bim[16];
#pragma unroll
        for (int j = 0; j < 4; ++j) { const f32x4 a = *(const LAS f32x4*)(BU + lane * 20 + 4 * j), b = *(const LAS f32x4*)(BU + (64 + lane) * 20 + 4 * j);
#pragma unroll
            for (int e = 0; e < 4; ++e) { bre[4 * j + e] = a[e]; bim[4 * j + e] = b[e]; } }
#pragma unroll
        for (int s = 0; s < 16; ++s) { const int t = d ? 15 - s : s; const float br = bre[t], bi = bim[t];
            const float nxr = lr * xr - li * xi + br, nxi = lr * xi + li * xr + bi; xr = nxr; xi = nxi;
            const unsigned pk = cvt_pk_bf16(xr, xi); ST[t * 136 + lane] = (bf16)(pk & 0xffffu); ST[t * 136 + 64 + lane] = (bf16)(pk >> 16); }
        LDS_WAIT(); __builtin_amdgcn_wave_barrier();
        f32x4 y = z;
#pragma unroll
        for (int ks = 0; ks < 4; ++ks) { const bf16x8 a = *(const LAS bf16x8*)(ST + fr * 136 + ks * 32 + fq * 8); y = __builtin_amdgcn_mfma_f32_16x16x32_bf16(a, Cf[ks], y, 0, 0, 0); }
        { LAS _Float16* YT = (LAS _Float16*)BU;
#pragma unroll
          for (int i = 0; i < 4; ++i) YT[(4 * fq + i) * 16 + fr] = (_Float16)y[i];
          LDS_WAIT(); __builtin_amdgcn_wave_barrier();
          if (lane < 32) { const v4u o = *(const LAS v4u*)(YT + lane * 8); *(v4u*)(P.Yp + (tok0 + (lane >> 1)) * S5D + g * S5C + (lane & 1) * 8) = o; } }
        LDS_WAIT(); __builtin_amdgcn_wave_barrier();
    }
}


#ifndef RWKV_REF
#define RWKV_REF 0
#endif
#ifndef RWKV_SEQ
#define RWKV_SEQ 0
#endif
#ifndef S5_REF
#define S5_REF 0
#endif
__device__ __forceinline__ float bf2f(bf16 b) { return __builtin_bit_cast(float, (unsigned)b << 16); }
__device__ __forceinline__ float shift1(const bf16* base, size_t ld, size_t row, int t, float mu) {
    const float c = bf2f(base[row * ld]), p = t > 0 ? bf2f(base[(row - 1) * ld]) : 0.f, n = t < SEQL - 1 ? bf2f(base[(row + 1) * ld]) : 0.f;
    return c + (0.5f * (p + n) - c) * mu;
}
__device__ __forceinline__ void rwkv_ref_wave(LAS float* sl, const RwkvP& P, int seq, int h, int d, int lane) {
    LAS float* vtw = sl; LAS float* val = sl + 64; LAS float* vkk = sl + 128; LAS float* vw = sl + 192; LAS float* vb = sl + 256; LAS float* vkd = sl + 320; LAS float* vr = sl + 384;
    const int c = h * HD + lane;
    LAS float* Sm = sl + 512 + lane * 65;
    for (int k = 0; k < 64; ++k) Sm[k] = 0.f;
    const float mur = P.mu[c], muk = P.mu[RW + c], muv = P.mu[2 * RW + c], muw = P.mu[MU_WLOW + d * 64 + lane], mua = P.mu[MU_ALOW + d * 64 + lane];
    const float w0c = P.w0[d * RW + c], a0c = P.a0[d * RW + c], kkc = P.k_k[c], kac = P.k_a[c], rkc = P.r_k[c];
    for (int s = 0; s < SEQL; ++s) { const int t = d ? SEQL - 1 - s : s; const size_t row = (size_t)seq * SEQL + t;
        const float r = shift1(P.RKV + c, RKW, row, t, mur), k = shift1(P.RKV + RW + c, RKW, row, t, muk), v = shift1(P.RKV + 2 * RW + c, RKW, row, t, muv);
        const float wl = tanhf(shift1(P.SMALL + SM_WLOW + d * 64 + lane, SMW, row, t, muw)), al = shift1(P.SMALL + SM_ALOW + d * 64 + lane, SMW, row, t, mua);
        vtw[lane] = wl; val[lane] = al; LDS_WAIT(); __builtin_amdgcn_wave_barrier();
        float wp = w0c, ap = a0c;
#pragma unroll 4
        for (int q = 0; q < 64; ++q) { wp += vtw[q] * P.w2[(size_t)(d * 64 + q) * RW + c]; ap += val[q] * P.a2[(size_t)(d * 64 + q) * RW + c]; }
        const float sp = log1pf(expf(-wp));
        const float w = expf(-expf(-sp - 0.5f)), a = 1.0f / (1.0f + expf(-ap));
        float kk = k * kkc; const float nn = wave_sum(kk * kk); kk = kk / sqrtf(nn + 1e-12f);
        const float kd = k * (1.0f + (a - 1.0f) * kac), b = kk * a;
        const float bon = wave_sum(r * kd * rkc); if (lane == 0) P.BON[((size_t)d * M + row) * NH + h] = bon;
        LDS_WAIT(); __builtin_amdgcn_wave_barrier();
        vkk[lane] = kk; vw[lane] = w; vb[lane] = b; vkd[lane] = kd; vr[lane] = r; LDS_WAIT(); __builtin_amdgcn_wave_barrier();
        float sa = 0.f;
#pragma unroll 8
        for (int q = 0; q < 64; ++q) sa -= Sm[q] * vkk[q];
        float y = 0.f;
#pragma unroll 8
        for (int q = 0; q < 64; ++q) { const float sn = Sm[q] * vw[q] + sa * vb[q] + v * vkd[q]; Sm[q] = sn; y += sn * vr[q]; }
        P.Y[row * RW + c] = (_Float16)y;
        LDS_WAIT(); __builtin_amdgcn_wave_barrier();
    }
}
__device__ __forceinline__ void s5_ref_wave(const S5Pm& P, int seq, int g, int d, int lane) {
    const int dg = d * S5G + g; const float dt = expf(P.log_step[dg]);
    const float are = P.a_re[dg * S5P + lane], aim = P.a_im[dg * S5P + lane]; const float mag = expf(are * dt); const float lr = mag * cosf(aim * dt), li = mag * sinf(aim * dt);
    const float nr = lr - 1.0f, nim = li, den = 1.0f / (are * are + aim * aim); const float cr = (nr * are + nim * aim) * den, ci = (nim * are - nr * aim) * den;
    float bbr[16], bbi[16], cre[16], cim[16];
#pragma unroll
    for (int c = 0; c < 16; ++c) { const float br = P.b_re[((size_t)dg * S5P + lane) * S5C + c], bim = P.b_im[((size_t)dg * S5P + lane) * S5C + c]; bbr[c] = cr * br - ci * bim; bbi[c] = cr * bim + ci * br;
        cre[c] = P.c_re[((size_t)g * S5C + c) * S5P + lane]; cim[c] = P.c_im[((size_t)g * S5C + c) * S5P + lane]; }
    float xr = 0.f, xi = 0.f;
    for (int s = 0; s < SEQL; ++s) { const int t = d ? SEQL - 1 - s : s; const size_t row = (size_t)seq * SEQL + t;
        float br = 0.f, bi = 0.f;
#pragma unroll
        for (int c = 0; c < 16; ++c) { const float u = bf2f(P.SMALL[row * SMW + SM_U + g * S5C + c]); br += u * bbr[c]; bi += u * bbi[c]; }
        const float nxr = lr * xr - li * xi + br, nxi = lr * xi + li * xr + bi; xr = nxr; xi = nxi;
#pragma unroll
        for (int c = 0; c < 16; ++c) { const float y = wave_sum(xr * cre[c] - xi * cim[c]); if (lane == c) P.Yp[row * S5D + g * S5C + c] = (_Float16)y; }
    }
}

struct Args { const float* in[37]; float* out; unsigned char* ws; int ph_lo, ph_hi, li, pad; };
enum { I_XP = 0, I_XS, I_NF1, I_F1G, I_F1U, I_F1D, I_NMIX, I_WIN, I_MU, I_W0, I_W2, I_A0, I_A2, I_G2, I_KK, I_KA, I_RK, I_LNW, I_LNB, I_SARE, I_SAIM, I_SLOG, I_SBRE, I_SBIM, I_SCRE, I_SCIM, I_SD, I_SWGLU, I_SBGLU, I_PR, I_PS, I_WO, I_NF2, I_F2G, I_F2U, I_F2D, I_NFIN };
constexpr int N_PHASES = 15;

#define KAS __attribute__((address_space(4)))
__device__ __forceinline__ const KAS unsigned char* kargs() { const KAS unsigned char* p = (const KAS unsigned char*)__builtin_amdgcn_kernarg_segment_ptr(); asm volatile("" : "+s"(p)); return p; }
#define ARGIN(k) (*(const float* const KAS*)(kp + 8 * (k)))
#define ECV (*(const int KAS*)(kargs() + 8 * 40 + 4))
#define PHASE_BEGIN() int tid = threadIdx.x; asm volatile("" : "+v"(tid)); const int lane = tid & 63; (void)lane; const KAS unsigned char* kp = kargs(); (void)kp; \
    unsigned char* ws = *(unsigned char* const KAS*)(kp + 8 * 38); (void)ws; float* X = *(float* const KAS*)(kp + 8 * 37); (void)X;
#define SS1 ((unsigned long long*)(ws + WS_CTL + 65536))
#define SS2 ((unsigned long long*)(ws + WS_CTL + 65536 + 196608))
#define SS3 ((unsigned long long*)(ws + WS_CTL + 65536 + 2 * 196608))
#define XN ((bf16*)(ws + WS_XN))
#define HB ((bf16*)(ws + WS_H))
#define WGU ((bf16*)(ws + WS_WGU))
#define WGU2 ((bf16*)(ws + WS_WGU2))
#define GB ((bf16*)(ws + WS_GATES))
#define WDN ((bf16*)(ws + WS_WDN))
#define WINA ((bf16*)(ws + WS_WINA))
#define WING ((bf16*)(ws + WS_WING))
#define WPR ((bf16*)(ws + WS_WPR))
#define WPS ((bf16*)(ws + WS_WPS))
#define WOUT ((bf16*)(ws + WS_WOUT))
#define G2T ((bf16*)(ws + WS_G2T))
#define WGLU ((bf16*)(ws + WS_WGLU))
#define BON ((float*)(ws + WS_BON))
#define SG ((bf16*)(ws + WS_SG))
#define RKV ((bf16*)(ws + WS_RKV))
#define SMALL ((bf16*)(ws + WS_SMALL))
#define GATES ((bf16*)(ws + WS_GATES))
#define DS ((bf16*)X)
#define YF ((_Float16*)(ws + WS_YF))
#define YB ((_Float16*)(ws + WS_YB))
#define S5F ((_Float16*)(ws + WS_S5F))
#define S5B ((_Float16*)(ws + WS_S5B))
#define TB ((bf16*)(ws + WS_YF))
#define YR ((bf16*)(ws + WS_YB))
#define YS0 ((bf16*)(ws + WS_S5F))
#define YS ((bf16*)(ws + WS_S5B))
#define MRG ((bf16*)(ws + WS_XN))
__global__ void __launch_bounds__(NWAVES * 64, 2) hyb_fwd(Args args_unused) {
    extern __shared__ __attribute__((aligned(16))) unsigned char lds_raw[];
    LAS unsigned char* lds = (LAS unsigned char*)lds_raw;
    volatile LAS unsigned* MISC = (volatile LAS unsigned*)(lds + MISC_OFF);
    const int wave = __builtin_amdgcn_readfirstlane((int)threadIdx.x >> 6);
    const int G = gridDim.x, bx = blockIdx.x;
    const int gw = bx * NWAVES + wave, NGW = G * NWAVES;
    for (int u = threadIdx.x; u < (LDS_BYTES - LDSCTL_OFF) / 4; u += NWAVES * 64) ((LAS unsigned*)(lds + LDSCTL_OFF))[u] = 0u;
    __syncthreads();
    int lo, hi, li; unsigned* ctl;
    { const KAS unsigned char* kp = kargs(); ctl = (unsigned*)(*(unsigned char* const KAS*)(kp + 8 * 38) + WS_CTL); lo = *(const int KAS*)(kp + 8 * 39); hi = *(const int KAS*)(kp + 8 * 39 + 4); li = *(const int KAS*)(kp + 8 * 40); }
    XcdBarrier bar; bar.bar = ctl + CW_BAR + li * XCD_BAR_WORDS; bar.x = 0; bar.st = nullptr;
    if (!MK_SPLIT) bar = xcd_barrier_post(ctl + CW_BAR + li * XCD_BAR_WORDS, MISC + 8);
#ifdef L2_PROBE
#define FIX_PROBE(ph) do { if (li == 1 && lo == (ph)) S.fix = bx & 7; } while (0)
#else
#define FIX_PROBE(ph) do { } while (0)
#endif
#define IN(k) (lo <= (k) && (k) < hi)
#define SEAM(k) do { if (IN(k) && IN((k) + 1)) xcd_barrier(bar); } while (0)
    LAS float* scr = (LAS float*)(lds + wave * 16384);

    if (IN(0)) { PHASE_BEGIN();
        constexpr int I0 = (D / 64) * (FF / 32), I2 = (FF / 64) * (D / 32), I3 = (D / 64) * (NA / 32), I4 = (D / 64) * (NGATE / 32), I5 = (RW / 64) * (D / 32), I6 = (S5D / 64) * (D / 32), I7 = (D / 64) * (D / 32), I8 = (128 / 64) * (RW / 32), I9 = (S5D / 64) * (S5D / 32);
        constexpr int NIT = 2 * I0; (void)I2; (void)I3; (void)I4; (void)I5; (void)I6; (void)I7; (void)I8; (void)I9;
        for (int it = gw; it < NIT; it += NGW) { int r = it;
            if (r < I0) { transpose_item(ARGIN(I_F1G), FF, FF, WGU, D, 1, scr, r, lane); continue; } r -= I0;
            transpose_item(ARGIN(I_F1U), FF, FF, WGU, D, 2, scr, r, lane);
        }
        rms_rows<false>(ARGIN(I_XP), ARGIN(I_XS), MP, ARGIN(I_NF1), XN, nullptr, gw, NGW, lane);
    }
    SEAM(0);
    if (IN(1)) { PHASE_BEGIN(); pg8::Gemm g{XN, WGU, M, NGU, D, 0}; pg8::StaticOrder S; S.init(M, NGU, G, bx); FIX_PROBE(1); pg8::EpiSwiGLU E{HB, FF, nullptr, FF / 64};
        pg8::gemm_phase<pg8::EpiSwiGLU, pg8::StaticOrder, true, true>(lds, g, S, E);
        { const int nfull = (M / 256) * (NGU / 256) / G;
          if (nfull * G + bx >= (M / 256) * (NGU / 256)) { const int ntail = (M / 256) * (NGU / 256) - nfull * G, gw2 = (bx - ntail) * NWAVES + wave, NGW2 = (G - ntail) * NWAVES;
            constexpr int I2 = (FF / 64) * (D / 32), I3 = (D / 64) * (NA / 32), I4 = (D / 64) * (NGATE / 32);
            constexpr int NIT2 = I2 + I3 + I4;
            for (int it = gw2; it < NIT2; it += NGW2) { int r = it;
                if (r < I2) { transpose_item(ARGIN(I_F1D), D, D, WDN, FF, 0, scr, r, lane); continue; } r -= I2;
                if (r < I3) { transpose_item(ARGIN(I_WIN), INC, NA, WINA, D, 0, scr, r, lane); continue; } r -= I3;
                transpose_item(ARGIN(I_WIN) + NA, INC, NGATE, WING, D, 0, scr, r, lane); }
            const v4u z = (v4u){0u, 0u, 0u, 0u};
            for (int i = gw2 * 64 + lane; i < (4096 - NA) * D / 8; i += NGW2 * 64) *(v4u*)(WINA + (size_t)NA * D + (size_t)i * 8) = z; } }
    }
    SEAM(1);
    if (IN(2)) { PHASE_BEGIN(); pg8::Gemm g{HB, WDN, M, D, FF, 0, 1}; pg8::StaticOrder S; S.init(M, D, G, bx); S.rev = 1;
        pg8::EpiRes2<0, 0> E{ARGIN(I_XP), ARGIN(I_XS), MP, nullptr, nullptr, XN, ARGIN(I_NMIX), nullptr, D, 0.5f, SS1};
        pg8::gemm_phase<pg8::EpiRes2<0, 0>, pg8::StaticOrder, true, true>(lds, g, S, E); }
    SEAM(2);
    if (IN(4)) { PHASE_BEGIN(); pg8::Gemm g{XN, WINA, M, 4096, D, 0}; pg8::StaticOrder S; S.init(M, 4096, G, bx); pg8::EpiBf<0> E{RKV, RKW, SMALL, SMW, RKW / 256, nullptr, 0, nullptr, 0, 0, nullptr, SS1};
        pg8::gemm_phase<pg8::EpiBf<0>, pg8::StaticOrder, true, true>(lds, g, S, E);
        if (!MK_SPLIT) xcd_barrier(bar);
        { const float* mu = ARGIN(I_MU); const float* kkp = ARGIN(I_KK);
          constexpr int RUN = 32, NRUN = M / RUN;
          for (int item = gw; item < 8 * NRUN; item += NGW) { const int cb = item & 7, run = item >> 3, tok0 = run * RUN, t0 = tok0 & (SEQL - 1);
            if (cb == 7) {
#pragma unroll 8
                for (int j = 0; j < RUN; ++j) *(v4u*)(DS + (size_t)(tok0 + j) * DSW + DS_U + 8 * lane) = *(const v4u*)(SMALL + (size_t)(tok0 + j) * SMW + SM_U + 8 * lane);
                continue; }
            const int sel = lane >> 4;
            const bool rd = cb < 6 || sel < 3;
            const bf16* src = cb < 6 ? RKV + cb * 512 + 8 * lane : SMALL + 8 * lane; const size_t ld = cb < 6 ? RKW : SMW;
            const int mcol = cb < 6 ? cb * 512 + 8 * lane : RKW + 8 * lane;
            f32x4 m0 = (f32x4){0.f, 0.f, 0.f, 0.f}, m1 = m0, k0 = m0, k1 = m0;
            if (rd) { m0 = *(const f32x4*)(mu + mcol); m1 = *(const f32x4*)(mu + mcol + 4); }
            if (cb == 2 || cb == 3) { k0 = *(const f32x4*)(kkp + mcol - RW); k1 = *(const f32x4*)(kkp + mcol - RW + 4); }
            float pv[8], cv[8], nv[8];
            ld8bf(src + (size_t)(tok0 - 1) * ld, rd && t0 > 0, pv); ld8bf(src + (size_t)tok0 * ld, rd, cv);
            v4u nx = (v4u){0u, 0u, 0u, 0u}; if (rd) nx = *(const v4u*)(src + (size_t)(tok0 + 1) * ld);
            for (int j = 0; j < RUN; ++j) { const int tok = tok0 + j;
                nv[0] = bf_lo(nx.x); nv[1] = bf_hi(nx.x); nv[2] = bf_lo(nx.y); nv[3] = bf_hi(nx.y); nv[4] = bf_lo(nx.z); nv[5] = bf_hi(nx.z); nv[6] = bf_lo(nx.w); nv[7] = bf_hi(nx.w);
                { const int tn = t0 + j + 2; nx = (v4u){0u, 0u, 0u, 0u}; if (rd && tn < SEQL) nx = *(const v4u*)(src + (size_t)(tok + 2) * ld); }
                float o[8];
#pragma unroll
                for (int e = 0; e < 8; ++e) { const float mm = e < 4 ? m0[e] : m1[e - 4]; o[e] = cv[e] + (0.5f * (pv[e] + nv[e]) - cv[e]) * mm; pv[e] = cv[e]; cv[e] = nv[e]; }
                bf16* drow = DS + (size_t)tok * DSW;
                if (cb < 6) { v4u w; w.x = cvt_pk_bf16(o[0], o[1]); w.y = cvt_pk_bf16(o[2], o[3]); w.z = cvt_pk_bf16(o[4], o[5]); w.w = cvt_pk_bf16(o[6], o[7]); *(v4u*)(drow + cb * 512 + 8 * lane) = w;
                    if (cb == 2 || cb == 3) { float s = 0.f;
#pragma unroll
                        for (int e = 0; e < 8; ++e) { const float q = o[e] * (e < 4 ? k0[e] : k1[e - 4]); s += q * q; }
                        s = red8(s); if ((lane & 7) == 0) ((float*)(drow + DS_INV))[(mcol - RW) >> 6] = 1.0f / sqrtf(s + 1e-12f); } }
                else { const int c8 = (lane & 15) * 8;
                    if (sel == 0) {
#pragma unroll
                        for (int e = 0; e < 8; ++e) o[e] = ftanh(o[e]); }
                    if (sel == 2) {
#pragma unroll
                        for (int e = 0; e < 8; ++e) o[e] = fsigmoid(o[e]); }
                    v4u w; w.x = cvt_pk_bf16(o[0], o[1]); w.y = cvt_pk_bf16(o[2], o[3]); w.z = cvt_pk_bf16(o[4], o[5]); w.w = cvt_pk_bf16(o[6], o[7]);
                    if (sel == 3) w = (v4u){0u, 0u, 0u, 0u};
                    if (sel >= 2) *(v4u*)(SG + (size_t)tok * 256 + (sel - 2) * 128 + c8) = w; else *(v4u*)(drow + DS_TW + sel * 128 + c8) = w; } } } }
    }
    SEAM(4);
    if (IN(5)) { PHASE_BEGIN();
        { const int job = bx;
#ifdef P5_SKIP
            if (!(li == 1 && ((P5_SKIP == 1) == (job < NSEQ * NH * 2))))
#endif
            if (job < NSEQ * NH * 2) { const int seq = job / (NH * 2), h = (job >> 1) & (NH - 1), d = job & 1;
                RwkvP P{DS, SMALL, ARGIN(I_MU), ARGIN(I_W0), ARGIN(I_W2), ARGIN(I_A0), ARGIN(I_A2), ARGIN(I_KK), ARGIN(I_KA), ARGIN(I_RK), d ? YB : YF, BON
#ifdef TPROBE
                    , (float*)(ws + WS_CTL + 8192)
#endif
                };
#if RWKV_REF
                if (wave == 0) rwkv_ref_wave((LAS float*)lds, P, seq, h, d, lane);
                __syncthreads();
#else
#if RWKV_SEQ
                rwkv_chain(lds, P, seq, h, d, tid, lane, wave); __syncthreads();
#else
#ifdef C3_PROBE
                if (li == 1) rwkv_chain3(lds, P, seq, h, d, tid, lane, wave, C3_PROBE); else
#endif
                rwkv_chain3(lds, P, seq, h, d, tid, lane, wave, 0);
                __syncthreads();
#endif
#endif
            }
            else if (wave < 6) { const int j = (job - NSEQ * NH * 2) * 6 + wave;        const int seq = j / (S5G * 2), g = (j >> 1) & (S5G - 1), d = j & 1;
                S5Pm P{DS, ARGIN(I_SARE), ARGIN(I_SAIM), ARGIN(I_SLOG), ARGIN(I_SBRE), ARGIN(I_SBIM), ARGIN(I_SCRE), ARGIN(I_SCIM), d ? S5B : S5F};
#if S5_REF
                s5_ref_wave(P, seq, g, d, lane);
#else
                s5_wave(lds + wave * S5_WL, P, seq, g, d, lane);
#endif
            }
        }
    }
    if (IN(5) && bx >= NSEQ * NH * 2) {
        PHASE_BEGIN();
        __syncthreads();
            { const int gw2 = (bx - NSEQ * NH * 2) * NWAVES + wave, NGW2 = (G - NSEQ * NH * 2) * NWAVES;
              constexpr int I5 = (RW / 64) * (D / 32), I6 = (S5D / 64) * (D / 32), I7 = (D / 64) * (D / 32), I8 = (128 / 64) * (RW / 32), I9 = (S5D / 64) * (S5D / 32);
              for (int it = gw2; it < I5 + I6 + I7 + I8 + I9; it += NGW2) { int r = it;
                  if (r < I5) { transpose_item(ARGIN(I_PR), D, D, WPR, RW, 0, scr, r, lane); continue; } r -= I5;
                  if (r < I6) { transpose_item(ARGIN(I_PS), D, D, WPS, S5D, 0, scr, r, lane); continue; } r -= I6;
                  if (r < I7) { transpose_item(ARGIN(I_WO), D, D, WOUT, D, 0, scr, r, lane); continue; } r -= I7;
                  if (r < I8) { transpose_item(ARGIN(I_G2), RW, RW, G2T, 256, 0, scr, r, lane); continue; } r -= I8;
                  transpose_item(ARGIN(I_SWGLU), S5D, S5D, WGLU, S5D, 0, scr, r, lane); }
              const v4u z = (v4u){0u, 0u, 0u, 0u};
              for (int i = gw2 * 64 + lane; i < RW * 16; i += NGW2 * 64) *(v4u*)(G2T + (size_t)(i >> 4) * 256 + 128 + (i & 15) * 8) = z; }
            if (ECV) { constexpr int I0 = (D / 64) * (FF / 32); const int gw2 = (bx - NSEQ * NH * 2) * NWAVES + wave, NGW2 = (G - NSEQ * NH * 2) * NWAVES;
                for (int it = gw2; it < 2 * I0; it += NGW2) { if (it < I0) transpose_item(ARGIN(I_F2G), FF, FF, WGU2, D, 1, scr, it, lane); else transpose_item(ARGIN(I_F2U), FF, FF, WGU2, D, 2, scr, it - I0, lane); } }
    }
    SEAM(5);
    if (IN(6)) { PHASE_BEGIN();
        const int c0 = 16 * lane, h = lane >> 2;
        for (int tok = gw; tok < M; tok += NGW) { const int t = tok & (SEQL - 1);
            { const h16x8 f0 = *(const h16x8*)(YF + (size_t)tok * RW + c0), f1 = *(const h16x8*)(YF + (size_t)tok * RW + c0 + 8), b0 = *(const h16x8*)(YB + (size_t)tok * RW + c0), b1 = *(const h16x8*)(YB + (size_t)tok * RW + c0 + 8);
              float y[16]; float s = 0.f;
#pragma unroll
              for (int j = 0; j < 8; ++j) { y[j] = (float)f0[j] + (float)b0[j]; y[8 + j] = (float)f1[j] + (float)b1[j]; }
#pragma unroll
              for (int j = 0; j < 16; ++j) s += y[j];
              const float mean = red4(s) * (1.f / 64.f); float q = 0.f;
#pragma unroll
              for (int j = 0; j < 16; ++j) { y[j] -= mean; q += y[j] * y[j]; }
              const float rstd = 1.0f / sqrtf(red4(q) * (1.f / 64.f) + GN_EPS);
              const float bonus = BON[(size_t)tok * NH + h] + BON[((size_t)M + tok) * NH + h];
              float v0[8], v1[8]; ld8bf(DS + (size_t)tok * DSW + 2 * RW + c0, true, v0); ld8bf(DS + (size_t)tok * DSW + 2 * RW + c0 + 8, true, v1); (void)t;
              const float* lw = ARGIN(I_LNW) + c0; const float* lb = ARGIN(I_LNB) + c0; float o[16];
#pragma unroll
              for (int j = 0; j < 16; ++j) o[j] = y[j] * rstd * lw[j] + lb[j] + bonus * (j < 8 ? v0[j] : v1[j - 8]);
              v4u w0, w1; w0.x = cvt_pk_bf16(o[0], o[1]); w0.y = cvt_pk_bf16(o[2], o[3]); w0.z = cvt_pk_bf16(o[4], o[5]); w0.w = cvt_pk_bf16(o[6], o[7]);
              w1.x = cvt_pk_bf16(o[8], o[9]); w1.y = cvt_pk_bf16(o[10], o[11]); w1.z = cvt_pk_bf16(o[12], o[13]); w1.w = cvt_pk_bf16(o[14], o[15]);
              *(v4u*)(TB + (size_t)tok * RW + c0) = w0; *(v4u*)(TB + (size_t)tok * RW + c0 + 8) = w1; }
            { const int c = 8 * lane; const h16x8 pf = *(const h16x8*)(S5F + (size_t)tok * S5D + c), pb = *(const h16x8*)(S5B + (size_t)tok * S5D + c);
              float uu[8]; ld8bf(DS + (size_t)tok * DSW + DS_U + c, true, uu); const f32x4 d0 = *(const f32x4*)(ARGIN(I_SD) + c), d1 = *(const f32x4*)(ARGIN(I_SD) + c + 4); float o[8];
#pragma unroll
              for (int j = 0; j < 8; ++j) { const float yy = (float)pf[j] + (float)pb[j] + (j < 4 ? d0[j] : d1[j - 4]) * uu[j]; o[j] = 0.5f * yy * (1.0f + ftanh(0.7978845608028654f * (yy + 0.044715f * yy * yy * yy))); }
              v4u w; w.x = cvt_pk_bf16(o[0], o[1]); w.y = cvt_pk_bf16(o[2], o[3]); w.z = cvt_pk_bf16(o[4], o[5]); w.w = cvt_pk_bf16(o[6], o[7]);
              *(v4u*)(YS0 + (size_t)tok * S5D + c) = w; }
        }
    }
    SEAM(6);
    if (IN(7)) { PHASE_BEGIN();
        { pg8::Gemm g{XN, WING, M, NGATE, D, 0}; pg8::StaticOrder S; S.init(M, NGATE, G, bx);
          pg8::EpiBf<1> E{GATES, NGATE, nullptr, 0, 0, nullptr, 0, nullptr, 0, 0, nullptr, SS1};
          pg8::gemm_phase<pg8::EpiBf<1>, pg8::StaticOrder, true, true>(lds, g, S, E); }
        __syncthreads();
        { pg8::Gemm g{SG, G2T, M, RW, 256, 0}; pg8::StaticOrder S; S.init(M, RW, G, bx); pg8::EpiBf<2> E{YR, RW, nullptr, 0, 0, TB, RW, nullptr, 0, 0, nullptr, nullptr};
          pg8::gemm_phase<pg8::EpiBf<2>, pg8::StaticOrder, true, true>(lds, g, S, E); }
        __syncthreads();
        { pg8::Gemm g{YS0, WGLU, M, S5D, S5D, 0}; pg8::StaticOrder S; S.init(M, S5D, G, bx); pg8::EpiBf<3> E{YS, S5D, nullptr, 0, 0, YS0, S5D, nullptr, 0, 0, ARGIN(I_SBGLU), nullptr};
          pg8::gemm_phase<pg8::EpiBf<3>, pg8::StaticOrder, true, true>(lds, g, S, E); }
    }
    SEAM(7);
    if (IN(9)) { PHASE_BEGIN();
        { pg8::Gemm g{YR, WPR, M, D, RW, 0}; pg8::StaticOrder S; S.init(M, D, G, bx); pg8::EpiBf<4> E{GATES, NGATE, nullptr, 0, 0, nullptr, 0, GATES, NGATE, 0, nullptr, nullptr};
          pg8::gemm_phase<pg8::EpiBf<4>, pg8::StaticOrder, true, true>(lds, g, S, E); }
        VM_WAIT(); __syncthreads();
        { pg8::Gemm g{YS, WPS, M, D, S5D, 0}; pg8::StaticOrder S; S.init(M, D, G, bx); pg8::EpiBf<5> E{GATES, NGATE, nullptr, 0, 0, GATES, NGATE, GATES, NGATE, D, nullptr, nullptr};
          pg8::gemm_phase<pg8::EpiBf<5>, pg8::StaticOrder, true, true>(lds, g, S, E); }
    }
    SEAM(9);
    if (IN(10)) { PHASE_BEGIN(); pg8::Gemm g{GATES, WOUT, M, D, D, NGATE}; pg8::StaticOrder S; S.init(M, D, G, bx);
        pg8::EpiRes2<1, 0> E{nullptr, nullptr, 0, XN, ARGIN(I_NMIX), XN, ARGIN(I_NF2), nullptr, D, 1.0f, SS2};
        pg8::gemm_phase<pg8::EpiRes2<1, 0>, pg8::StaticOrder, true, true>(lds, g, S, E); }
    SEAM(10);
    if (!ECV) {
    if (IN(11)) { PHASE_BEGIN();
        constexpr int I0 = (D / 64) * (FF / 32);
        for (int it = gw; it < 2 * I0; it += NGW) { if (it < I0) transpose_item(ARGIN(I_F2G), FF, FF, WGU, D, 1, scr, it, lane); else transpose_item(ARGIN(I_F2U), FF, FF, WGU, D, 2, scr, it - I0, lane); }
    }
    SEAM(11);
    }
    if (IN(12)) { PHASE_BEGIN(); pg8::Gemm g{XN, ECV ? WGU2 : WGU, M, NGU, D, 0}; pg8::StaticOrder S; S.init(M, NGU, G, bx); pg8::EpiSwiGLU E{HB, FF, SS2, FF / 64};
        pg8::gemm_phase<pg8::EpiSwiGLU, pg8::StaticOrder, true, true>(lds, g, S, E);
        { const int nfull = (M / 256) * (NGU / 256) / G;
          if (nfull * G + bx >= (M / 256) * (NGU / 256)) { const int ntail = (M / 256) * (NGU / 256) - nfull * G, gw2 = (bx - ntail) * NWAVES + wave, NGW2 = (G - ntail) * NWAVES;
            constexpr int I2 = (FF / 64) * (D / 32);
            for (int it = gw2; it < I2; it += NGW2) transpose_item(ARGIN(I_F2D), D, D, WDN, FF, 0, scr, it, lane); } }
    }
    SEAM(12);
    if (IN(13)) { PHASE_BEGIN(); pg8::Gemm g{HB, WDN, M, D, FF, 0, 1}; pg8::StaticOrder S; S.init(M, D, G, bx); S.rev = 1;
        pg8::EpiRes2<1, 0> E{nullptr, nullptr, 0, XN, ARGIN(I_NF2), XN, ARGIN(I_NFIN), nullptr, D, 0.5f, SS3};
        pg8::gemm_phase<pg8::EpiRes2<1, 0>, pg8::StaticOrder, true, true>(lds, g, S, E); }
    SEAM(13);
    if (IN(14)) { PHASE_BEGIN(); scale_rows(XN, SS3, X, gw, NGW, lane); }
#undef IN
#undef SEAM
}


#ifndef MK_CHECK
#define MK_CHECK 0
#endif
#if MK_CHECK
constexpr int CK_R = 512, CK_C = 128, CW_ERR = 16;
constexpr size_t CK_EXP = 512 * 1024;
__device__ __forceinline__ int ck_row(int i) { return i < 8 ? (i == 0 ? 0 : i == 1 ? 255 : i == 2 ? 256 : i == 3 ? 8191 : i == 4 ? 8192 : i == 5 ? M - 1 : i == 6 ? 4095 : 4096) : (int)(((long)i * 9973 + 131) % M); }
__device__ __forceinline__ int ck_col(int j, int N) { return j == 0 ? 0 : j == 1 ? N - 1 : (int)(((long)j * 7919 + 17) % N); }
__device__ __forceinline__ float dotbb(const bf16* a, const bf16* b, int K) { float s = 0.f; for (int k = 0; k < K; ++k) s += bf2f(a[k]) * bf2f(b[k]); return s; }
__device__ __forceinline__ float rbf(float x) { return bf2f((bf16)f2bf(x)); }
#ifndef CK_WATCH
#define CK_WATCH 80
#endif
#ifndef CK_SEL
#define CK_SEL 0
#endif
__device__ int ck_m, ck_n;
__device__ __forceinline__ void ck_fail_at(unsigned* ctl, int stage, float got, float exp, float tolr, float tola, int m, int n) {
    if (!(fabsf(got - exp) <= tolr * fabsf(exp) + tola)) { atomicMin(&ctl[CW_ERR], (unsigned)stage);
        if (stage == CK_WATCH) { atomicAdd(&ctl[32], 1u); if (!(got >= 0.f && got <= 1.f)) atomicAdd(&ctl[41], 1u); atomicMin(&ctl[33], (unsigned)(m >> 8)); atomicMax(&ctl[34], (unsigned)(m >> 8)); atomicMin(&ctl[35], (unsigned)(n >> 8)); atomicMax(&ctl[36], (unsigned)(n >> 8));
            atomicMin(&ctl[37], (unsigned)(m & 255)); atomicMax(&ctl[38], (unsigned)(m & 255)); atomicMin(&ctl[39], (unsigned)(n & 255)); atomicMax(&ctl[40], (unsigned)(n & 255)); } } }
#define ck_fail(ctl, stage, got, exp, tolr, tola) ck_fail_at(ctl, stage, got, exp, tolr, tola, m, (int)(j))
__device__ __forceinline__ float sigm(float x) { return 1.0f / (1.0f + expf(-x)); }
__global__ void hyb_chk(Args a, int stage, int pre) {
    unsigned char* ws = a.ws; unsigned* ctl = (unsigned*)(ws + WS_CTL); float* EXP = (float*)(ws + CK_EXP); float* X = a.out;
    const int i = blockIdx.x, m = ck_row(i);
    const float* xin = m < MP ? a.in[I_XP] + (size_t)m * D : a.in[I_XS] + (size_t)(m - MP) * D;
    for (int j = threadIdx.x; j < CK_C; j += blockDim.x) {
        if (stage == 1 || stage == 12) {
            const float* g = stage == 1 ? a.in[I_NF1] : a.in[I_NF2]; const float* xr = stage == 1 ? xin : X + (size_t)m * D; const int n = ck_col(j, D);
            float ss = 0.f; for (int k = 0; k < D; ++k) ss += xr[k] * xr[k]; const float e = xr[n] / sqrtf(ss / D + RMS_EPS) * g[n];
            ck_fail(ctl, stage * 10 + 0, bf2f(XN[(size_t)m * D + n]), e, 0.01f, 0.01f);
            const float* wg = a.in[stage == 1 ? I_F1G : I_F2G]; const float* wu = a.in[stage == 1 ? I_F1U : I_F2U]; const float* wd = a.in[stage == 1 ? I_F1D : I_F2D];
            { const int k = m % D, c = ck_col(j, FF); ck_fail(ctl, stage * 10 + 1, bf2f(WGU[(size_t)((c >> 7) * 256 + (c & 127)) * D + k]), wg[(size_t)k * FF + c], 0.005f, 1e-6f);
              ck_fail(ctl, stage * 10 + 2, bf2f(WGU[(size_t)((c >> 7) * 256 + 128 + (c & 127)) * D + k]), wu[(size_t)k * FF + c], 0.005f, 1e-6f); }
            { const int k = m % FF, c = ck_col(j, D); ck_fail(ctl, stage * 10 + 3, bf2f(WDN[(size_t)c * FF + k]), wd[(size_t)k * D + c], 0.005f, 1e-6f); }
            if (stage == 1) { const int k = m % D; { const int c = ck_col(j, 4096); ck_fail(ctl, 14, bf2f(WINA[(size_t)c * D + k]), c < NA ? a.in[I_WIN][(size_t)k * INC + c] : 0.f, 0.005f, 1e-6f);
                ck_fail(ctl, 15, bf2f(WING[(size_t)c * D + k]), a.in[I_WIN][(size_t)k * INC + NA + c], 0.005f, 1e-6f); }
              { const int c = ck_col(j, D); ck_fail(ctl, 16, bf2f(WPR[(size_t)c * RW + (k % RW)]), a.in[I_PR][(size_t)(k % RW) * D + c], 0.005f, 1e-6f);
                ck_fail(ctl, 17, bf2f(WPS[(size_t)c * S5D + (k % S5D)]), a.in[I_PS][(size_t)(k % S5D) * D + c], 0.005f, 1e-6f);
                ck_fail(ctl, 18, bf2f(WOUT[(size_t)c * D + k]), a.in[I_WO][(size_t)k * D + c], 0.005f, 1e-6f); }
              { const int c = ck_col(j, RW), kk = k % 256; ck_fail(ctl, 19, bf2f(G2T[(size_t)c * 256 + kk]), kk < 128 ? a.in[I_G2][(size_t)kk * RW + c] : 0.f, 0.005f, 1e-6f); }
              { const int c = ck_col(j, S5D), kk = k % S5D; ck_fail(ctl, 19, bf2f(WGLU[(size_t)c * S5D + kk]), a.in[I_SWGLU][(size_t)kk * S5D + c], 0.005f, 1e-6f); } }
        }
        if (stage == 2 || stage == 13) { const int c = ck_col(j, FF); const bf16* xr = XN + (size_t)m * D;
            const float gg = dotbb(xr, WGU + (size_t)((c >> 7) * 256 + (c & 127)) * D, D), uu = dotbb(xr, WGU + (size_t)((c >> 7) * 256 + 128 + (c & 127)) * D, D);
            ck_fail(ctl, stage * 10, bf2f(HB[(size_t)m * FF + c]), gg * sigm(gg) * uu, 0.02f, 0.01f); }
        if (stage == 3) { const int n = ck_col(j, D); ck_fail(ctl, 30, X[(size_t)m * D + n], xin[n] + 0.5f * dotbb(HB + (size_t)m * FF, WDN + (size_t)n * FF, FF), 0.005f, 0.005f); }
        if (stage == 4) { const int n = ck_col(j, D); const float* xr = X + (size_t)m * D; float ss = 0.f; for (int k = 0; k < D; ++k) ss += xr[k] * xr[k];
            ck_fail(ctl, 40, bf2f(XN[(size_t)m * D + n]), xr[n] / sqrtf(ss / D + RMS_EPS) * a.in[I_NMIX][n], 0.01f, 0.01f); }
        if (stage == 5) { const int n = ck_col(j, 4096); const float e = dotbb(XN + (size_t)m * D, WINA + (size_t)n * D, D);
            const float got = n < RKW ? bf2f(RKV[(size_t)m * RKW + n]) : bf2f(SMALL[(size_t)m * SMW + n - RKW]); ck_fail(ctl, 50, got, e, 0.01f, 0.01f); }
        if (stage == 7) { const int n = ck_col(j, 128); const int t = m & (SEQL - 1);
            const float c = bf2f(SMALL[(size_t)m * SMW + SM_GLOW + n]), pv = t > 0 ? bf2f(SMALL[(size_t)(m - 1) * SMW + SM_GLOW + n]) : 0.f, nx = t < SEQL - 1 ? bf2f(SMALL[(size_t)(m + 1) * SMW + SM_GLOW + n]) : 0.f;
            ck_fail(ctl, 70, bf2f(SG[(size_t)m * 256 + n]), sigm(c + (0.5f * (pv + nx) - c) * a.in[I_MU][MU_GLOW + n]), 0.01f, 0.005f);
            ck_fail(ctl, 71, bf2f(SG[(size_t)m * 256 + 128 + n]), 0.f, 0.f, 0.f); }
        if (stage == 8) { const int n = ck_col(j, NGATE); const float e = sigm(dotbb(XN + (size_t)m * D, WING + (size_t)n * D, D));
            if (pre) EXP[i * CK_C + j] = e; else { ck_fail_at(ctl, 89, bf2f(GATES[(size_t)m * NGATE + n]), EXP[i * CK_C + j], 0.01f, 0.005f, m, n); ck_fail(ctl, 85, e, EXP[i * CK_C + j], 0.001f, 0.0001f);
                const int k = (m * 7 + j) % D; ck_fail(ctl, 86, bf2f(WING[(size_t)n * D + k]), a.in[I_WIN][(size_t)k * INC + NA + n], 0.005f, 1e-6f);
                const float* xr = X + (size_t)m * D; float ss = 0.f; for (int q = 0; q < D; ++q) ss += xr[q] * xr[q]; const int nn = ck_col(j, D);
                ck_fail(ctl, 87, bf2f(XN[(size_t)m * D + nn]), xr[nn] / sqrtf(ss / D + RMS_EPS) * a.in[I_NMIX][nn], 0.01f, 0.01f); } }
        if (stage == 9) { { const int n = ck_col(j, RW); ck_fail(ctl, 90, bf2f(YR[(size_t)m * RW + n]), dotbb(SG + (size_t)m * 256, G2T + (size_t)n * 256, 256) * bf2f(TB[(size_t)m * RW + n]), 0.02f, 0.01f); }
            { const int n = ck_col(j, S5D); const float y0 = bf2f(YS0[(size_t)m * S5D + n]); ck_fail(ctl, 91, bf2f(YS[(size_t)m * S5D + n]), sigm(dotbb(YS0 + (size_t)m * S5D, WGLU + (size_t)n * S5D, S5D) + a.in[I_SBGLU][n]) * y0, 0.02f, 0.01f); } }
        if (stage == 10) { const int n = ck_col(j, D); const float t1 = rbf(bf2f(GATES[(size_t)m * NGATE + n]) * dotbb(YR + (size_t)m * RW, WPR + (size_t)n * RW, RW));
            ck_fail(ctl, 100, bf2f(MRG[(size_t)m * D + n]), t1 + bf2f(GATES[(size_t)m * NGATE + D + n]) * dotbb(YS + (size_t)m * S5D, WPS + (size_t)n * S5D, S5D), 0.02f, 0.01f); }
        if (stage == 11 || stage == 14) { const int n = ck_col(j, D);
            if (pre) EXP[i * CK_C + j] = X[(size_t)m * D + n] + (stage == 11 ? dotbb(MRG + (size_t)m * D, WOUT + (size_t)n * D, D) : 0.5f * dotbb(HB + (size_t)m * FF, WDN + (size_t)n * FF, FF));
            else ck_fail(ctl, stage * 10, X[(size_t)m * D + n], EXP[i * CK_C + j], 0.005f, 0.005f); }
        if (stage == 15) { const int n = ck_col(j, D); const float* xr = X + (size_t)m * D;
            if (pre) { float ss = 0.f; for (int k = 0; k < D; ++k) ss += xr[k] * xr[k]; EXP[i * CK_C + j] = xr[n] / sqrtf(ss / D + RMS_EPS) * a.in[I_NFIN][n]; }
            else ck_fail(ctl, 150, xr[n], EXP[i * CK_C + j], 0.001f, 0.001f); }
    }
}
__global__ void hyb_chk_report(Args a) { unsigned* ctl = (unsigned*)(a.ws + WS_CTL); const unsigned e = ctl[CW_ERR]; if (e == 0xffffffffu) return;
    unsigned va, vb;
    if (CK_SEL == 0) { va = 0; vb = e; }
    else if (CK_SEL == 1) { va = ctl[33] + 1; vb = ctl[34] + 1; }
    else if (CK_SEL == 2) { va = ctl[35] + 1; vb = ctl[36] + 1; }
    else if (CK_SEL == 3) { va = (ctl[37] >> 2) + 1; vb = (ctl[38] >> 2) + 1; }
    else if (CK_SEL == 4) { va = (ctl[39] >> 2) + 1; vb = (ctl[40] >> 2) + 1; }
    else if (CK_SEL == 5) { const unsigned c = ctl[32]; va = 1; vb = c > 99 ? 99 : c; }
    else { const unsigned c = ctl[32], o = ctl[41]; va = 1 + (98u * o) / (c ? c : 1u); vb = 1 + c / 1000u; }
    const size_t i = (size_t)blockIdx.x * blockDim.x + threadIdx.x;
    if (va && i < 4000000) a.out[i] = (float)va * 10.0f;
    if (i == 0) a.out[(size_t)MP * D + 12345] = (float)vb * 1000.0f; }
__global__ void hyb_chk_init(Args a) { unsigned* ctl = (unsigned*)(a.ws + WS_CTL); if (threadIdx.x == 0) { ctl[CW_ERR] = 0xffffffffu; ctl[33] = 0xffffffffu; ctl[35] = 0xffffffffu; ctl[37] = 0xffffffffu; ctl[39] = 0xffffffffu; } }
#endif

#ifdef TPROBE
__global__ void hyb_tp_report(Args a) { const float* tp = (const float*)(a.ws + WS_CTL + 8192); const size_t i = (size_t)blockIdx.x * blockDim.x + threadIdx.x; if (i == 0) a.out[0] = rintf(tp[0] * 0.2f) * 500.f; if (i < 3355443) a.out[(size_t)MP * D + i] = rintf(tp[1] * 0.2f) * 5.f; }
#endif
extern "C" void kernel_launch(void* const* d_in, const int* in_sizes, int n_in, void* d_out, int out_size, void* d_ws, size_t ws_size, hipStream_t stream) {
    static int grid = 0;
    if (grid == 0) {
        if (n_in != 37 || in_sizes[0] != MP * D || out_size != M * D || ws_size < WS_END) { fprintf(stderr, "kernel_launch: unexpected problem (n_in %d, in0 %d, out %d, ws %zu, need %zu); nothing launched\n", n_in, n_in > 0 ? in_sizes[0] : -1, out_size, ws_size, (size_t)WS_END); grid = -1; return; }
        int dev = 0, cus = 0, per_cu = 0;
        if (hipGetDevice(&dev) != hipSuccess || hipDeviceGetAttribute(&cus, hipDeviceAttributeMultiprocessorCount, dev) != hipSuccess) { grid = -1; return; }
        if (hipFuncSetAttribute((const void*)hyb_fwd, hipFuncAttributeMaxDynamicSharedMemorySize, LDS_BYTES) != hipSuccess) { fprintf(stderr, "kernel_launch: hipFuncSetAttribute failed\n"); grid = -1; return; }
        if (hipOccupancyMaxActiveBlocksPerMultiprocessor(&per_cu, (const void*)hyb_fwd, NWAVES * 64, LDS_BYTES) != hipSuccess || per_cu < 1) fprintf(stderr, "kernel_launch: occupancy query reports %d\n", per_cu);
        (void)hipGetLastError();
        grid = cus;
        if (grid != 256) { fprintf(stderr, "kernel_launch: needs exactly 256 CUs (got %d); nothing launched\n", grid); grid = -1; return; }
        fprintf(stderr, "kernel_launch: grid %d, ws %zu\n", grid, ws_size);
    }
    if (grid < 0) return;
    if (hipMemsetAsync((char*)d_ws + WS_CTL, 0, CTL_ZERO_BYTES, stream) != hipSuccess) return;
    Args a{};
    for (int i = 0; i < 37; ++i) a.in[i] = (const float*)d_in[i];
    a.out = (float*)d_out; a.ws = (unsigned char*)d_ws; a.pad = ws_size >= WS_END2 ? 1 : 0;
#if MK_SPLIT
#if MK_CHECK
    hipLaunchKernelGGL(hyb_chk_init, dim3(1), dim3(64), 0, stream, a);
#endif
    for (int p = 0; p < N_PHASES; ++p) { a.ph_lo = p; a.ph_hi = p + 1;
#if MK_CHECK
        if (p == 7 || p == 10 || p == 13 || p == 14) hipLaunchKernelGGL(hyb_chk, dim3(CK_R), dim3(128), 0, stream, a, p + 1, 1);
#endif
        hipLaunchKernelGGL(hyb_fwd, dim3(grid), dim3(NWAVES * 64), LDS_BYTES, stream, a);
#if MK_CHECK
        if (p != 5) hipLaunchKernelGGL(hyb_chk, dim3(CK_R), dim3(128), 0, stream, a, p + 1, 0);
#endif
    }
#if MK_CHECK
    hipLaunchKernelGGL(hyb_chk_report, dim3(4000000 / 256), dim3(256), 0, stream, a);
#endif
#else
#ifdef DUP_PHASE
    a.ph_lo = 0; a.ph_hi = DUP_PHASE + 1; a.li = 0; hipLaunchKernelGGL(hyb_fwd, dim3(grid), dim3(NWAVES * 64), LDS_BYTES, stream, a);
    a.ph_lo = DUP_PHASE; a.ph_hi = N_PHASES; a.li = 1; hipLaunchKernelGGL(hyb_fwd, dim3(grid), dim3(NWAVES * 64), LDS_BYTES, stream, a);
#else
    a.ph_lo = 0; a.ph_hi = N_PHASES; hipLaunchKernelGGL(hyb_fwd, dim3(grid), dim3(NWAVES * 64), LDS_BYTES, stream, a);
#ifdef TPROBE
    hipLaunchKernelGGL(hyb_tp_report, dim3(13108), dim3(256), 0, stream, a);
#endif
#endif
#endif
}
```

```cpp
#include <hip/hip_runtime.h>
#include <cstdio>
#include <cstdint>
#ifndef MK_SPLIT
#define MK_SPLIT 0
#endif
#define RWKV_REF 0
#define S5_REF 0
#define MK_CHECK 0
namespace pg8 {
#define PG8_LAS __attribute__((address_space(3)))
typedef unsigned short bf16_t;
typedef short bf16x8 __attribute__((ext_vector_type(8)));
typedef float f32x4 __attribute__((ext_vector_type(4)));
typedef unsigned u32x4 __attribute__((ext_vector_type(4)));
constexpr int BM = 256, BK = 64, HALF = 128, HTB = HALF * BK * 2  , STAGE_BYTES = 8 * HTB, NXCD = 8, WGM = 8;

__host__ __device__ __forceinline__ int lds_byte(int r, int c) { const int st = (r >> 4) * 2 + (c >> 5), rr = r & 15, cc = c & 31, ob = rr * 64 + cc * 2; return st * 1024 + (ob ^ (((ob >> 9) & 1) << 5)); }
__host__ __device__ __forceinline__ void stage_rc(int b, int& R, int& C) { const int st = b / 1024, sb = b % 1024, swz = sb ^ (((sb >> 9) & 1) << 5); R = (st >> 1) * 16 + swz / 64; C = (st & 1) * 32 + (swz % 64) / 2; }
__host__ __device__ __forceinline__ int perm32(int rho) { const int n = rho >> 4, i = rho & 15; return 8 * (i >> 2) + 4 * n + (i & 3); }

struct Unit { int pm, pn; };
struct Gemm { const bf16_t* A; const bf16_t* Bt; int M, N, K; int lda; int atile; };

struct StaticOrder {
    int nM, nN, nwg, G, c, fix, base, lim, rev;
    __host__ __device__ void init(int M, int N, int G_, int c_) { nM = M / BM; nN = N / BM; nwg = nM * nN; G = G_; c = c_; fix = -1; base = 0; lim = nwg; rev = 0; }
    __host__ __device__ bool next(int i, Unit& u) const {
        const long L = (long)base + (long)i * G + c; if (L >= lim) return false;
        int wgid = (int)L; { const int q = nwg / NXCD, r = nwg % NXCD, xcd = wgid % NXCD, off = wgid / NXCD; wgid = (xcd < r ? xcd * (q + 1) : r * (q + 1) + (xcd - r) * q) + off; }
        const int nig = WGM * nN, gid = wgid / nig, fm = gid * WGM, gsz = (nM - fm) < WGM ? (nM - fm) : WGM;
        u.pm = fm + ((wgid % nig) % gsz); u.pn = (wgid % nig) / gsz; if (rev) u.pm = nM - 1 - u.pm;
        if (fix >= 0) { u.pm = fix; u.pn = fix; } return true;
    }
    __device__ __forceinline__ void a_ready(const Unit&) const {}
    __device__ __forceinline__ void done(const Unit&) const {}
};
struct PanelOrder {
    int nN, c, rounds, nM, rev;
    __host__ __device__ void init(int M, int N, int G_, int c_) { nN = N / BM; nM = M / BM; c = c_; rounds = nM * nN / G_; rev = 0; }
    __host__ __device__ bool next(int i, Unit& u) const { if (i >= rounds) return false; const int x = c % NXCD, j = c / NXCD, ppx = 32 / nN; u.pm = (i * NXCD + x) * ppx + (j % ppx); u.pn = j / ppx; if (rev) u.pm = nM - 1 - u.pm; return true; }
    __device__ __forceinline__ void a_ready(const Unit&) const {}
    __device__ __forceinline__ void done(const Unit&) const {}
};

typedef __bf16 bf16x2_n __attribute__((ext_vector_type(2)));
typedef float f32x2_n __attribute__((ext_vector_type(2)));
__device__ __forceinline__ unsigned cvt_pk_bf16(float lo, float hi) { const bf16x2_n r = __builtin_convertvector((f32x2_n){lo, hi}, bf16x2_n); return __builtin_bit_cast(unsigned, r); }
__device__ __forceinline__ float bf_lo(unsigned w) { return __builtin_bit_cast(float, w << 16); }
__device__ __forceinline__ float bf_hi(unsigned w) { return __builtin_bit_cast(float, w & 0xffff0000u); }
__device__ __forceinline__ float fsigmoid(float x) { return __builtin_amdgcn_rcpf(1.0f + __builtin_amdgcn_exp2f(-1.4426950408889634f * x)); }
__device__ __forceinline__ u32x4 pack8(const f32x4& a, const f32x4& b) { u32x4 w; w.x = cvt_pk_bf16(a[0], a[1]); w.y = cvt_pk_bf16(a[2], a[3]); w.z = cvt_pk_bf16(b[0], b[1]); w.w = cvt_pk_bf16(b[2], b[3]); return w; }
__device__ __forceinline__ void unpack8(const u32x4& w, f32x4& a, f32x4& b) { a = (f32x4){bf_lo(w.x), bf_hi(w.x), bf_lo(w.y), bf_hi(w.y)}; b = (f32x4){bf_lo(w.z), bf_hi(w.z), bf_lo(w.w), bf_hi(w.w)}; }

struct EpiSwiGLU {
    static constexpr bool PERM = true, AFTER_DRAIN = false, MIDK = false;
    bf16_t* H; int ldh; const unsigned long long* ss; int nkt;
    __device__ __forceinline__ void operator()(const f32x4 (&acc)[2][2][4][2], const Unit& u, int wr, int wc, int fr, int fq) const {
        const int row0 = u.pm * BM + wr * 64 + fr, col0 = u.pn * HALF + wc * 32 + 8 * fq;
#pragma unroll
        for (int ai = 0; ai < 2; ++ai)
#pragma unroll
            for (int m = 0; m < 4; ++m) { bf16_t* rowp = nkt ? H + ((size_t)(u.pm * nkt + (col0 >> 6)) * BM + (wr * 64 + fr + ai * HALF + m * 16)) * BK + (col0 & 63) : H + (size_t)(row0 + ai * HALF + m * 16) * ldh + col0;
                const float rs = ss ? 1.0f / sqrtf((float)ss[row0 + ai * HALF + m * 16] * (1.0f / (16777216.0f * 2048.0f)) + 1e-6f) : 1.0f;
                f32x4 o[2];
#pragma unroll
                for (int n = 0; n < 2; ++n) { const f32x4 g = acc[ai][0][m][n] * rs, up = acc[ai][1][m][n] * rs;
#pragma unroll
                    for (int j = 0; j < 4; ++j) o[n][j] = g[j] * fsigmoid(g[j]) * up[j]; }
                *(u32x4*)rowp = pack8(o[0], o[1]); }
    }
};
struct EpiResid {
    static constexpr bool PERM = false, AFTER_DRAIN = false, MIDK = false;
    const float* in_lo; const float* in_hi; int split; float* out; int ldc; float scale;
    __device__ __forceinline__ void operator()(const f32x4 (&acc)[2][2][4][2], const Unit& u, int wr, int wc, int fr, int fq) const {
        const int row0 = u.pm * BM + wr * 64 + fr, col0 = u.pn * BM + wc * 32 + 4 * fq;
        const float* inb = (u.pm * BM < split) ? in_lo : in_hi - (size_t)split * ldc;
#pragma unroll
        for (int ai = 0; ai < 2; ++ai) { f32x4 bs[4][2][2];
#pragma unroll
            for (int m = 0; m < 4; ++m) { const size_t off = (size_t)(row0 + ai * HALF + m * 16) * ldc + col0;
#pragma unroll
                for (int bj = 0; bj < 2; ++bj)
#pragma unroll
                    for (int n = 0; n < 2; ++n) bs[m][bj][n] = *(const f32x4*)(inb + off + bj * HALF + n * 16); }
#pragma unroll
            for (int m = 0; m < 4; ++m) { const size_t off = (size_t)(row0 + ai * HALF + m * 16) * ldc + col0;
#pragma unroll
                for (int bj = 0; bj < 2; ++bj)
#pragma unroll
                    for (int n = 0; n < 2; ++n) *(f32x4*)(out + off + bj * HALF + n * 16) = bs[m][bj][n] + acc[ai][bj][m][n] * scale; }
            asm volatile("" ::: "memory"); }
    }
};
template <int MODE> struct EpiBf {
    static constexpr bool PERM = true, AFTER_DRAIN = false, MIDK = false;
    bf16_t* O0; int ld0; bf16_t* O1; int ld1; int nsplit;
    const bf16_t* T; int ldt;
    const bf16_t* G; int ldg; int goff; const float* bias; const unsigned long long* ss;
    __device__ __forceinline__ void operator()(const f32x4 (&acc)[2][2][4][2], const Unit& u, int wr, int wc, int fr, int fq) const {
        const int row0 = u.pm * BM + wr * 64 + fr;
        bf16_t* base = O0; int ld = ld0; int colt = u.pn * BM;
        if (MODE == 0) { if (u.pn >= nsplit) { base = O1; ld = ld1; colt = (u.pn - nsplit) * BM; } }
        const int col0 = colt + wc * 32 + 8 * fq;
#pragma unroll
        for (int ai = 0; ai < 2; ++ai)
#pragma unroll
            for (int m = 0; m < 4; ++m) { const int row = row0 + ai * HALF + m * 16;
                const float rs = (MODE <= 1 && ss) ? 1.0f / sqrtf((float)ss[row] * (1.0f / (16777216.0f * 2048.0f)) + 1e-6f) : 1.0f;
#pragma unroll
                for (int bj = 0; bj < 2; ++bj) { f32x4 v0 = acc[ai][bj][m][0], v1 = acc[ai][bj][m][1]; const int col = col0 + bj * HALF;
                    if (MODE <= 1) { v0 = v0 * rs; v1 = v1 * rs; }
                    if (MODE == 1) {
#pragma unroll
                        for (int j = 0; j < 4; ++j) { v0[j] = fsigmoid(v0[j]); v1[j] = fsigmoid(v1[j]); } }
                    if (MODE == 2) { f32x4 t0, t1; unpack8(*(const u32x4*)(T + (size_t)row * ldt + col), t0, t1); v0 = v0 * t0; v1 = v1 * t1; }
                    if (MODE == 3) { f32x4 t0, t1; unpack8(*(const u32x4*)(T + (size_t)row * ldt + col), t0, t1); const f32x4 b0 = *(const f32x4*)(bias + col), b1 = *(const f32x4*)(bias + col + 4);
#pragma unroll
                        for (int j = 0; j < 4; ++j) { v0[j] = fsigmoid(v0[j] + b0[j]) * t0[j]; v1[j] = fsigmoid(v1[j] + b1[j]) * t1[j]; } }
                    if (MODE == 4) { f32x4 g0, g1; unpack8(*(const u32x4*)(G + (size_t)row * ldg + col), g0, g1); v0 = v0 * g0; v1 = v1 * g1; }
                    if (MODE == 5) { f32x4 g0, g1, t0, t1; unpack8(*(const u32x4*)(G + (size_t)row * ldg + goff + col), g0, g1); unpack8(*(const u32x4*)(T + (size_t)row * ldt + col), t0, t1); v0 = t0 + v0 * g0; v1 = t1 + v1 * g1; }
                    *(u32x4*)(base + (size_t)row * ld + col) = pack8(v0, v1); } }
    }
};


struct EpiMerge {
    static constexpr bool PERM = true, AFTER_DRAIN = false, MIDK = true;
    bf16_t* G; int ldg; int goff; int tsplit;
    __device__ __forceinline__ void mid(f32x4 (&acc)[2][2][4][2], const Unit& u, int wr, int wc, int fr, int fq) const {
        const bf16_t* gb = G + (size_t)(u.pm * BM + wr * 64 + fr) * ldg + (u.pn * BM + wc * 32 + 8 * fq);
        asm volatile("" : "+v"(gb));
#pragma unroll
        for (int ai = 0; ai < 2; ++ai) { u32x4 ga[4][2], gc[4][2];
#pragma unroll
            for (int m = 0; m < 4; ++m) { const bf16_t* gp = gb + (size_t)(ai * HALF + m * 16) * ldg;
#pragma unroll
                for (int bj = 0; bj < 2; ++bj) { ga[m][bj] = *(const u32x4*)(gp + bj * HALF); gc[m][bj] = *(const u32x4*)(gp + goff + bj * HALF); } }
#pragma unroll
            for (int m = 0; m < 4; ++m)
#pragma unroll
                for (int bj = 0; bj < 2; ++bj) { f32x4 a0, a1, b0, b1; unpack8(ga[m][bj], a0, a1); unpack8(gc[m][bj], b0, b1);
#pragma unroll
                    for (int j = 0; j < 4; ++j) { acc[ai][bj][m][0][j] *= a0[j] * __builtin_amdgcn_rcpf(fmaxf(b0[j], 1e-30f)); acc[ai][bj][m][1][j] *= a1[j] * __builtin_amdgcn_rcpf(fmaxf(b1[j], 1e-30f)); } }
            asm volatile("" : "+v"(gb) :: "memory"); }
    }
    __device__ __forceinline__ void operator()(const f32x4 (&acc)[2][2][4][2], const Unit& u, int wr, int wc, int fr, int fq) const {
        const int row0 = u.pm * BM + wr * 64 + fr, col0 = u.pn * BM + wc * 32 + 8 * fq;
#pragma unroll
        for (int ai = 0; ai < 2; ++ai)
#pragma unroll
            for (int m = 0; m < 4; ++m) { bf16_t* gp = G + (size_t)(row0 + ai * HALF + m * 16) * ldg + col0;
#pragma unroll
                for (int bj = 0; bj < 2; ++bj) { f32x4 b0, b1; unpack8(*(const u32x4*)(gp + goff + bj * HALF), b0, b1);
                    *(u32x4*)(gp + bj * HALF) = pack8(acc[ai][bj][m][0] * b0, acc[ai][bj][m][1] * b1); } }
    }
};

template <int SRC, int DST> struct EpiRes2 {
    static constexpr bool PERM = true, AFTER_DRAIN = false, MIDK = false;
    const float* in_lo; const float* in_hi; int split; const bf16_t* xg_in; const float* gin; bf16_t* xg_out; const float* gout; float* xf_out; int ldc; float scale; unsigned long long* ss;
    __device__ __forceinline__ void operator()(const f32x4 (&acc)[2][2][4][2], const Unit& u, int wr, int wc, int fr, int fq) const {
        const int row0 = u.pm * BM + wr * 64 + fr, col0 = u.pn * BM + wc * 32 + 8 * fq;
        const float* inb = (u.pm * BM < split) ? in_lo : in_hi - (size_t)split * ldc;
        f32x4 gi[2][2], go[2][2];
#pragma unroll
        for (int bj = 0; bj < 2; ++bj)
#pragma unroll
            for (int n = 0; n < 2; ++n) { const int c = col0 + bj * HALF + 4 * n;
                if (SRC == 1) { const f32x4 g = *(const f32x4*)(gin + c); gi[bj][n] = (f32x4){1.0f / g[0], 1.0f / g[1], 1.0f / g[2], 1.0f / g[3]}; }
                if (DST == 0) go[bj][n] = *(const f32x4*)(gout + c); }
#pragma unroll
        for (int ai = 0; ai < 2; ++ai)
#pragma unroll
            for (int m = 0; m < 4; ++m) { const int row = row0 + ai * HALF + m * 16; const size_t off = (size_t)row * ldc + col0; f32x4 x[2][2]; float s = 0.f;
#pragma unroll
                for (int bj = 0; bj < 2; ++bj) {
                    if (SRC == 0) { x[bj][0] = __builtin_nontemporal_load((const f32x4*)(inb + off + bj * HALF)); x[bj][1] = __builtin_nontemporal_load((const f32x4*)(inb + off + bj * HALF + 4)); }
                    else { f32x4 t0, t1; unpack8(*(const u32x4*)(xg_in + off + bj * HALF), t0, t1); x[bj][0] = t0 * gi[bj][0]; x[bj][1] = t1 * gi[bj][1]; } }
#pragma unroll
                for (int bj = 0; bj < 2; ++bj)
#pragma unroll
                    for (int n = 0; n < 2; ++n) { x[bj][n] = x[bj][n] + acc[ai][bj][m][n] * scale; const f32x4 q = x[bj][n] * x[bj][n]; s += (q[0] + q[1]) + (q[2] + q[3]); }
#pragma unroll
                for (int bj = 0; bj < 2; ++bj) {
                    if (DST == 0) *(u32x4*)(xg_out + off + bj * HALF) = pack8(x[bj][0] * go[bj][0], x[bj][1] * go[bj][1]);
                    else { *(f32x4*)(xf_out + off + bj * HALF) = x[bj][0]; *(f32x4*)(xf_out + off + bj * HALF + 4) = x[bj][1]; } }
                s += __shfl_xor(s, 16); s += __shfl_xor(s, 32);
                if (fq == 0) __hip_atomic_fetch_add(ss + row, (unsigned long long)(s * 16777216.0f + 0.5f), __ATOMIC_RELAXED, __HIP_MEMORY_SCOPE_AGENT); }
    }
};
template <class Epi, class Sched, bool ALIGN_EPI = false, bool SP2 = false>
__device__ __forceinline__ void gemm_phase(PG8_LAS unsigned char* lds, const Gemm g, const Sched& S, const Epi& E) {
    int tid_l = threadIdx.x; asm volatile("" : "+v"(tid_l));
    const int tid = tid_l, wid = __builtin_amdgcn_readfirstlane(tid >> 6), lane = tid & 63, wr = wid >> 2, wc = wid & 3, fr = lane & 15, fq = lane >> 4;
    const int K = g.K, nt = K / BK, lda = g.atile ? BK : (g.lda ? g.lda : K);
    unsigned voffA[2], voffB[2];
#pragma unroll
    for (int i = 0; i < 2; ++i) { int R, C; stage_rc(tid * 16 + i * 8192, R, C); const int Rb = Epi::PERM ? ((R & ~31) + perm32(R & 31)) : R;
        voffA[i] = (unsigned)(R * lda + C) * 2u; voffB[i] = (unsigned)(Rb * K + C) * 2u; }
    const size_t kstep = (size_t)(BK * 2);
    const size_t hstep = (size_t)HALF * K * 2;
    const size_t tstep = 2 * hstep;
    const size_t hstepA = (size_t)HALF * lda * 2, tstepA = g.atile ? (size_t)BM * K * 2 : 2 * hstepA;
    const size_t kstepA = g.atile ? (size_t)BM * BK * 2 : kstep;
    const unsigned ldsw = (unsigned)wid * 1024u;
    const int aoff = lds_byte(wr * 64 + fr, fq * 8), boff = lds_byte(wc * 32 + fr, fq * 8);
#define PG8_SA(b, h) (((b) * 2 + (h)) * HTB)
#define PG8_SB(b, h) ((4 + (b) * 2 + (h)) * HTB)
#define PG8_STAGE(bufoff, gbase, voff) do { _Pragma("unroll") for (int _i = 0; _i < 2; ++_i) \
        __builtin_amdgcn_global_load_lds((const unsigned*)((const char*)(gbase) + (voff)[_i]), (PG8_LAS unsigned*)(lds + (bufoff) + ldsw + _i * 8192), 16, 0, 0); } while (0)
#define PG8_LDA(dst, b, h) do { _Pragma("unroll") for (int m = 0; m < 4; ++m) _Pragma("unroll") for (int k = 0; k < 2; ++k) dst[m][k] = *(const PG8_LAS bf16x8*)(lds + PG8_SA(b, h) + aoff + m * 2048 + k * 1024); } while (0)
#define PG8_LDB(dst, b, h) do { _Pragma("unroll") for (int n = 0; n < 2; ++n) _Pragma("unroll") for (int k = 0; k < 2; ++k) dst[n][k] = *(const PG8_LAS bf16x8*)(lds + PG8_SB(b, h) + boff + n * 2048 + k * 1024); } while (0)
#define PG8_MMA(ai, bj, At, Bt) do { __builtin_amdgcn_s_setprio(1); _Pragma("unroll") for (int m = 0; m < 4; ++m) _Pragma("unroll") for (int n = 0; n < 2; ++n) _Pragma("unroll") for (int k = 0; k < 2; ++k) \
        acc[ai][bj][m][n] = __builtin_amdgcn_mfma_f32_16x16x32_bf16(Bt[n][k], At[m][k], acc[ai][bj][m][n], 0, 0, 0); __builtin_amdgcn_s_setprio(0); } while (0)
#define PG8_WAIT_V(n) asm volatile("s_waitcnt vmcnt(" #n ")" ::: "memory")
#define PG8_WAIT_L(n) asm volatile("s_waitcnt lgkmcnt(" #n ")" ::: "memory")
#define PG8_BAR __builtin_amdgcn_s_barrier()
#define PG8_SCHED __builtin_amdgcn_sched_barrier(0)
    Unit cur, nxt; int ui = 0;
    if (!S.next(0, cur)) return;
    f32x4 acc[2][2][4][2];
#pragma unroll
    for (int a = 0; a < 2; ++a)
#pragma unroll
        for (int b = 0; b < 2; ++b)
#pragma unroll
            for (int m = 0; m < 4; ++m)
#pragma unroll
                for (int n = 0; n < 2; ++n) acc[a][b][m][n] = (f32x4){0.f, 0.f, 0.f, 0.f};
    bf16x8 At[4][2], B0[2][2], B1[2][2];
    const char* cA = (const char*)g.A + (size_t)cur.pm * tstepA; const char* cB = (const char*)g.Bt + (size_t)cur.pn * tstep;
    S.a_ready(cur);
    if constexpr (SP2) {
        PG8_STAGE(PG8_SB(0, 0), cB, voffB); PG8_STAGE(PG8_SB(0, 1), cB + hstep, voffB); PG8_STAGE(PG8_SA(0, 0), cA, voffA); PG8_STAGE(PG8_SA(0, 1), cA + hstepA, voffA);
        if (wr == 1) PG8_BAR;
        PG8_WAIT_V(2); PG8_BAR;
        PG8_STAGE(PG8_SB(1, 0), cB + kstep, voffB); PG8_STAGE(PG8_SA(1, 0), cA + kstepA, voffA); PG8_STAGE(PG8_SB(1, 1), cB + hstep + kstep, voffB);
        PG8_WAIT_V(6); PG8_BAR;
    } else {
        PG8_STAGE(PG8_SB(0, 0), cB, voffB); PG8_STAGE(PG8_SA(0, 0), cA, voffA); PG8_STAGE(PG8_SB(0, 1), cB + hstep, voffB); PG8_STAGE(PG8_SA(0, 1), cA + hstepA, voffA);
        if (wr == 1) PG8_BAR;
        PG8_WAIT_V(4); PG8_BAR;
        PG8_STAGE(PG8_SB(1, 0), cB + kstep, voffB); PG8_STAGE(PG8_SA(1, 0), cA + kstepA, voffA); PG8_STAGE(PG8_SB(1, 1), cB + hstep + kstep, voffB);
        PG8_WAIT_V(6); PG8_BAR;
    }
    for (;;) {
        const bool has_next = S.next(ui + 1, nxt);
        const char* nA = has_next ? (const char*)g.A + (size_t)nxt.pm * tstepA : cA; const char* nB = has_next ? (const char*)g.Bt + (size_t)nxt.pn * tstep : cB;
        for (int t = 0; t < nt; t += 2) {
            if constexpr (Epi::MIDK) { if (t == E.tsplit) E.mid(acc, cur, wr, wc, fr, fq); }
            const bool last = (t == nt - 2);
            const char* a1 = cA + (size_t)(t + 1) * kstepA;
            const char* a2 = last ? nA : cA + (size_t)(t + 2) * kstepA; const char* b2 = last ? nB : cB + (size_t)(t + 2) * kstep;
            const char* a3 = a2 + kstepA; const char* b3 = b2 + kstep;
            if (last && has_next) S.a_ready(nxt);
            if constexpr (SP2) {
            PG8_LDB(B0, 0, 0); PG8_LDB(B1, 0, 1); PG8_SCHED; PG8_LDA(At, 0, 0); PG8_STAGE(PG8_SA(1, 1), a1 + hstepA, voffA);
            PG8_WAIT_V(8); PG8_WAIT_L(0); PG8_BAR; PG8_MMA(0, 0, At, B0); PG8_MMA(0, 1, At, B1); PG8_BAR; PG8_SCHED;
            PG8_LDA(At, 0, 1); PG8_STAGE(PG8_SB(0, 0), b2, voffB); PG8_STAGE(PG8_SB(0, 1), b2 + hstep, voffB); PG8_STAGE(PG8_SA(0, 0), a2, voffA);
            PG8_WAIT_V(8); PG8_WAIT_L(0); PG8_BAR; PG8_MMA(1, 0, At, B0); PG8_MMA(1, 1, At, B1); PG8_BAR; PG8_SCHED;
            PG8_LDB(B0, 1, 0); PG8_LDB(B1, 1, 1); PG8_SCHED; PG8_LDA(At, 1, 0); PG8_STAGE(PG8_SA(0, 1), a2 + hstepA, voffA);
            PG8_WAIT_V(8); PG8_WAIT_L(0); PG8_BAR; PG8_MMA(0, 0, At, B0); PG8_MMA(0, 1, At, B1); PG8_BAR; PG8_SCHED;
            PG8_LDA(At, 1, 1); PG8_STAGE(PG8_SB(1, 0), b3, voffB); PG8_STAGE(PG8_SB(1, 1), b3 + hstep, voffB); PG8_STAGE(PG8_SA(1, 0), a3, voffA);
            PG8_WAIT_V(8); PG8_WAIT_L(0); PG8_BAR; PG8_MMA(1, 0, At, B0); PG8_MMA(1, 1, At, B1); PG8_BAR; PG8_SCHED;
            } else {
            PG8_LDB(B0, 0, 0); PG8_SCHED; PG8_LDA(At, 0, 0); PG8_STAGE(PG8_SA(1, 1), a1 + hstepA, voffA);
            PG8_WAIT_L(8); PG8_BAR; PG8_WAIT_L(0); PG8_MMA(0, 0, At, B0); PG8_BAR; PG8_SCHED;
            PG8_LDB(B1, 0, 1); PG8_STAGE(PG8_SB(0, 0), b2, voffB);
            PG8_BAR; PG8_WAIT_L(0); PG8_MMA(0, 1, At, B1); PG8_BAR;
            PG8_LDA(At, 0, 1); PG8_STAGE(PG8_SA(0, 0), a2, voffA);
            PG8_BAR; PG8_WAIT_L(0); PG8_MMA(1, 0, At, B0); PG8_BAR; PG8_SCHED;
            PG8_STAGE(PG8_SB(0, 1), b2 + hstep, voffB);
            PG8_WAIT_V(6); PG8_BAR; PG8_MMA(1, 1, At, B1); PG8_BAR;
            PG8_LDB(B0, 1, 0); PG8_SCHED; PG8_LDA(At, 1, 0); PG8_STAGE(PG8_SA(0, 1), a2 + hstepA, voffA);
            PG8_WAIT_L(8); PG8_BAR; PG8_WAIT_L(0); PG8_MMA(0, 0, At, B0); PG8_BAR; PG8_SCHED;
            PG8_LDB(B1, 1, 1); PG8_STAGE(PG8_SB(1, 0), b3, voffB);
            PG8_BAR; PG8_WAIT_L(0); PG8_MMA(0, 1, At, B1); PG8_BAR;
            PG8_LDA(At, 1, 1); PG8_STAGE(PG8_SA(1, 0), a3, voffA);
            PG8_BAR; PG8_WAIT_L(0); PG8_MMA(1, 0, At, B0); PG8_BAR; PG8_SCHED;
            PG8_STAGE(PG8_SB(1, 1), b3 + hstep, voffB);
            PG8_WAIT_V(6); PG8_BAR; PG8_MMA(1, 1, At, B1); PG8_BAR;
            }
        }
        if constexpr (ALIGN_EPI) { if (wr == 0) PG8_BAR; }
        if constexpr (!Epi::AFTER_DRAIN) { E(acc, cur, wr, wc, fr, fq); S.done(cur); }
        if (!has_next) break;
#pragma unroll
        for (int a = 0; a < 2; ++a)
#pragma unroll
            for (int b = 0; b < 2; ++b)
#pragma unroll
                for (int m = 0; m < 4; ++m)
#pragma unroll
                    for (int n = 0; n < 2; ++n) acc[a][b][m][n] = (f32x4){0.f, 0.f, 0.f, 0.f};
        cur = nxt; cA = nA; cB = nB; ++ui;
        if constexpr (ALIGN_EPI) { if (wr == 1) PG8_BAR; }
    }
    PG8_WAIT_V(0);
    if constexpr (!ALIGN_EPI) { if (wr == 0) PG8_BAR; }
    PG8_BAR;
    if constexpr (Epi::AFTER_DRAIN) { E.fused(acc, cur, wr, wc, fr, fq, lds, wid, lane); S.done(cur); }
#undef PG8_SA
#undef PG8_SB
#undef PG8_STAGE
#undef PG8_LDA
#undef PG8_LDB
#undef PG8_MMA
#undef PG8_WAIT_V
#undef PG8_WAIT_L
#undef PG8_BAR
#undef PG8_SCHED
}
}

constexpr int NWAVES = 8;
constexpr int NSEQ = 6, SEQL = 4096, M = NSEQ * SEQL, MP = 2 * SEQL;
constexpr int D = 2048, FF = 5504, NGU = 2 * FF;
constexpr int NH = 16, HD = 64, RW = 1024;
constexpr int RKW = 3072, SMW = 1024, NGATE = 4096, INC = 8064, NA = 3968;
constexpr int SM_WLOW = 0, SM_ALOW = 128, SM_GLOW = 256, SM_U = 384;
constexpr int MU_WLOW = 3072, MU_ALOW = 3200, MU_GLOW = 3328;
constexpr int S5G = 32, S5C = 16, S5P = 64, S5D = 512;
constexpr int DSW = 4096, DS_TW = 3072, DS_AL = 3200, DS_U = 3456, DS_INV = 3968;
constexpr float RMS_EPS = 1e-6f, GN_EPS = 64e-5f;

constexpr size_t MiB = 1u << 20;
constexpr size_t WS_CTL = 0, CTL_ZERO_BYTES = 1 * MiB;
constexpr size_t WS_WINA = 1 * MiB, WS_WING = 17 * MiB, WS_WPR = 33 * MiB, WS_WPS = 37 * MiB, WS_WOUT = 39 * MiB, WS_G2T = 47 * MiB, WS_WGLU = 47 * MiB + 512 * 1024;
constexpr size_t WS_BON = 48 * MiB, WS_SG = 51 * MiB, WS_XN = 63 * MiB;
constexpr size_t WS_WGU = 159 * MiB, WS_WDN = 202 * MiB, WS_H = 224 * MiB;
constexpr size_t WS_RKV = 159 * MiB, WS_SMALL = 303 * MiB, WS_YF = 351 * MiB, WS_YB = 399 * MiB, WS_S5F = 447 * MiB, WS_S5B = 471 * MiB, WS_END = 495 * MiB;
constexpr size_t WS_WGU2 = 495 * MiB, WS_END2 = 538 * MiB;
constexpr size_t WS_GATES = 159 * MiB;
static_assert(WS_WGU2 + (size_t)NGU * D * 2 <= WS_END2, "early FFN2 weights");
static_assert(WS_WPR + (size_t)D * (RW + S5D) * 2 <= WS_WOUT && WS_WPS == WS_WPR + (size_t)D * RW * 2 && (size_t)M * (RW + S5D) * 2 <= (size_t)M * D * 4, "merged projection operands");
static_assert(WS_WGU + (size_t)NGU * D * 2 <= WS_WDN && WS_WDN + (size_t)D * FF * 2 <= WS_H && WS_H + (size_t)M * FF * 2 <= WS_END, "ffn map");
static_assert(WS_RKV + (size_t)M * RKW * 2 <= WS_SMALL && WS_SMALL + (size_t)M * SMW * 2 <= WS_YF && WS_YF + (size_t)M * RW * 2 <= WS_YB && WS_YB + (size_t)M * RW * 2 <= WS_S5F && WS_S5F + (size_t)M * S5D * 2 <= WS_S5B && WS_S5B + (size_t)M * S5D * 2 <= WS_END, "mixer map");
static_assert(WS_GATES + (size_t)M * NGATE * 2 <= WS_YF && WS_XN + (size_t)M * D * 2 <= WS_WGU && WS_SG + (size_t)M * 256 * 2 <= WS_XN && WS_BON + (size_t)2 * M * NH * 4 <= WS_SG, "map");
constexpr int CW_BAR = 4096;

constexpr int RING_BYTES = 131072;
constexpr int LDSCTL_OFF = 146432, MISC_OFF = LDSCTL_OFF + 320;
constexpr int LDS_BYTES = 147456;

#define GAS __attribute__((address_space(1)))
#define LAS __attribute__((address_space(3)))
typedef unsigned short bf16;
typedef unsigned v4u __attribute__((ext_vector_type(4)));
typedef unsigned v2u __attribute__((ext_vector_type(2)));
typedef float f32x4 __attribute__((ext_vector_type(4)));
typedef float f32x2 __attribute__((ext_vector_type(2)));
typedef short bf16x8 __attribute__((ext_vector_type(8)));
typedef short bf16x4 __attribute__((ext_vector_type(4)));
typedef _Float16 h16x4 __attribute__((ext_vector_type(4)));
typedef _Float16 h16x8 __attribute__((ext_vector_type(8)));
typedef GAS unsigned gu32;
#define RLX_AGENT __ATOMIC_RELAXED, __HIP_MEMORY_SCOPE_AGENT
#define LDS_WAIT() asm volatile("s_waitcnt lgkmcnt(0)" ::: "memory")
#define VM_WAIT() asm volatile("s_waitcnt vmcnt(0)" ::: "memory")
using pg8::cvt_pk_bf16; using pg8::bf_lo; using pg8::bf_hi; using pg8::fsigmoid;

#define XB_TMO      128
#define XB_XCNT(j)  (256  + 64 * (j))
#define XB_XSUB(j)  (1280 + 64 * (j))
#define XB_XGEN(j)  (2304 + 64 * (j))
#define XB_TOP      3328
#define XB_TOPGEN   3392
#define XCD_BAR_WORDS 3456
#define XB_SPIN_CAP (1u << 18)

__device__ __forceinline__ unsigned xb_ld(unsigned* p)              { return __hip_atomic_load(p, __ATOMIC_RELAXED, __HIP_MEMORY_SCOPE_AGENT); }
__device__ __forceinline__ unsigned xb_add(unsigned* p, unsigned v) { return __hip_atomic_fetch_add(p, v, __ATOMIC_RELAXED, __HIP_MEMORY_SCOPE_AGENT); }
__device__ __forceinline__ unsigned xb_xcc_id() { return (unsigned)__builtin_amdgcn_s_getreg((3 << 11) | 20) & 0xFu; }
#define XB_SPIN(cond, bar) do { unsigned _sp = 0; while (cond) { __builtin_amdgcn_s_sleep(1); \
    if ((++_sp & 255u) == 0u) { if (xb_ld(&(bar)[XB_TMO])) break; if (_sp > XB_SPIN_CAP) { atomicAdd(&(bar)[XB_TMO], 1u); break; } } } } while (0)

struct XcdBarrier {
    unsigned* bar; unsigned x;
    volatile LAS unsigned* st;
};
__device__ __forceinline__ XcdBarrier xcd_barrier_post(unsigned* bar, volatile LAS unsigned* st) {
    XcdBarrier b; b.bar = bar; b.x = xb_xcc_id(); b.st = st;
    if (threadIdx.x == 0) (void)xb_add(&bar[XB_XCNT(b.x)], 1u);
    return b;
}
__device__ __forceinline__ void xcd_barrier_complete(unsigned* bar, unsigned x, unsigned& nloc, unsigned& nx) {
    const unsigned G = gridDim.x * gridDim.y * gridDim.z;
    unsigned sum, cnt, mine, sp = 0u;
    for (;;) {
        sum = 0u; cnt = 0u; mine = 0u;
#pragma unroll
        for (unsigned j = 0; j < 16; ++j) { const unsigned c = xb_ld(&bar[XB_XCNT(j)]); sum += c; cnt += (c > 0u) ? 1u : 0u; mine = (j == x) ? c : mine; }
        if (sum == G) break;
        __builtin_amdgcn_s_sleep(1);
        if ((++sp & 255u) == 0u) { if (xb_ld(&bar[XB_TMO])) break; if (sp > XB_SPIN_CAP) { atomicAdd(&bar[XB_TMO], 1u); break; } }
    }
    nloc = mine > 0u ? mine : 1u; nx = cnt > 0u ? cnt : 1u;
}
__device__ __forceinline__ void xcd_barrier(const XcdBarrier& b) {
    asm volatile("s_waitcnt vmcnt(0)" ::: "memory");
    __syncthreads();
    if (threadIdx.x == 0) {
        unsigned* bar = b.bar;
        __builtin_amdgcn_s_waitcnt(0);
        unsigned nloc = b.st[0], nx = b.st[1];
        if (nloc == 0u) { xcd_barrier_complete(bar, b.x, nloc, nx); b.st[0] = nloc; b.st[1] = nx; }
        const unsigned old = xb_add(&bar[XB_XSUB(b.x)], 1u);
        const unsigned gen = old / nloc;
        if (old + 1u == (gen + 1u) * nloc) {
            __builtin_amdgcn_fence(__ATOMIC_RELEASE, "agent");
            asm volatile("s_waitcnt vmcnt(0)" ::: "memory");
            const unsigned og = xb_add(&bar[XB_TOP], 1u);
            const unsigned tg = og / nx;
            if (og + 1u == (tg + 1u) * nx) xb_add(&bar[XB_TOPGEN], 1u);
            else XB_SPIN(xb_ld(&bar[XB_TOPGEN]) == tg, bar);
            __builtin_amdgcn_fence(__ATOMIC_ACQUIRE, "agent");
            xb_add(&bar[XB_XGEN(b.x)], 1u);
            asm volatile("s_waitcnt vmcnt(0)" ::: "memory");
        } else {
            XB_SPIN(xb_ld(&bar[XB_XGEN(b.x)]) == gen, bar);
            __builtin_amdgcn_fence(__ATOMIC_ACQUIRE, "agent");
            asm volatile("s_waitcnt vmcnt(0)" ::: "memory");
        }
    }
    __syncthreads();
}

__device__ __forceinline__ float wave_sum(float v) {
#pragma unroll
    for (int o = 1; o < 64; o <<= 1) v += __shfl_xor(v, o);
    return v;
}
__device__ __forceinline__ float dpp_f(float v, const int ctrl_sel) {
    const int x = __builtin_bit_cast(int, v); int r;
    if (ctrl_sel == 0) r = __builtin_amdgcn_update_dpp(x, x, 0xB1, 0xF, 0xF, false);
    else if (ctrl_sel == 1) r = __builtin_amdgcn_update_dpp(x, x, 0x4E, 0xF, 0xF, false);
    else if (ctrl_sel == 2) r = __builtin_amdgcn_update_dpp(x, x, 0x141, 0xF, 0xF, false);
    else r = __builtin_amdgcn_update_dpp(x, x, 0x140, 0xF, 0xF, false);
    return __builtin_bit_cast(float, r);
}
__device__ __forceinline__ float red4(float v) { v += dpp_f(v, 0); v += dpp_f(v, 1); return v; }
__device__ __forceinline__ float red8(float v) { v += dpp_f(v, 0); v += dpp_f(v, 1); v += dpp_f(v, 2); return v; }
__device__ __forceinline__ float red16(float v) { v = red8(v); v += dpp_f(v, 3); return v; }
__device__ __forceinline__ float ftanh(float x) { const float e = __builtin_amdgcn_exp2f(2.8853900817779268f * x); return 1.0f - 2.0f * __builtin_amdgcn_rcpf(1.0f + e); }
__device__ __forceinline__ unsigned f2bf(float f) { unsigned u = __builtin_bit_cast(unsigned, f); return (u + 0x7fffu + ((u >> 16) & 1u)) >> 16; }

__device__ __forceinline__ void transpose_item(const float* W, int ldW, int ncols, bf16* WT, int ldT, int rowmode, LAS float* scr, int item, int lane) {
    const int nblk = ncols / 32, kb = item / nblk, nb = item % nblk, k0 = 64 * kb, n0 = 32 * nb;
    const int r0 = rowmode == 0 ? n0 : ((n0 >> 7) * 256 + (n0 & 127) + (rowmode == 2 ? 128 : 0));
#pragma unroll 8
    for (int i = 0; i < 32; ++i) { const int kk = 2 * i + (lane >> 5); scr[kk * 33 + (lane & 31)] = __builtin_nontemporal_load(W + (size_t)(k0 + kk) * ldW + n0 + (lane & 31)); }
    LDS_WAIT(); asm volatile("" ::: "memory");
    const int c = lane & 7;
#pragma unroll
    for (int j = 0; j < 4; ++j) { const int n = (lane >> 3) + 8 * j; const LAS float* s = scr + (8 * c) * 33 + n;
        v4u o; o.x = cvt_pk_bf16(s[0 * 33], s[1 * 33]); o.y = cvt_pk_bf16(s[2 * 33], s[3 * 33]); o.z = cvt_pk_bf16(s[4 * 33], s[5 * 33]); o.w = cvt_pk_bf16(s[6 * 33], s[7 * 33]);
        *(v4u*)(WT + (size_t)(r0 + n) * ldT + k0 + 8 * c) = o; }
    LDS_WAIT(); asm volatile("" ::: "memory");
}
__device__ __forceinline__ void rms_row_bf16(const float* xrow, const float* g, bf16* orow, int lane) {
    const f32x4* xr = (const f32x4*)xrow + lane; const f32x4* gr = (const f32x4*)g + lane;
    f32x4 v[8]; float s = 0.f;
#pragma unroll
    for (int j = 0; j < 8; ++j) { v[j] = xr[64 * j]; s += (v[j].x * v[j].x + v[j].y * v[j].y) + (v[j].z * v[j].z + v[j].w * v[j].w); }
    const float rstd = 1.0f / sqrtf(wave_sum(s) * (1.f / D) + RMS_EPS);
    v2u* o8 = (v2u*)orow + lane;
#pragma unroll
    for (int j = 0; j < 8; ++j) { const f32x4 gg = gr[64 * j]; v2u w; w.x = cvt_pk_bf16(v[j].x * rstd * gg.x, v[j].y * rstd * gg.y); w.y = cvt_pk_bf16(v[j].z * rstd * gg.z, v[j].w * rstd * gg.w); o8[64 * j] = w; }
}
__device__ __forceinline__ void rms_row_f32(float* xrow, const float* g, int lane) {
    f32x4* xr = (f32x4*)xrow + lane; const f32x4* gr = (const f32x4*)g + lane;
    f32x4 v[8]; float s = 0.f;
#pragma unroll
    for (int j = 0; j < 8; ++j) { v[j] = xr[64 * j]; s += (v[j].x * v[j].x + v[j].y * v[j].y) + (v[j].z * v[j].z + v[j].w * v[j].w); }
    const float rstd = 1.0f / sqrtf(wave_sum(s) * (1.f / D) + RMS_EPS);
#pragma unroll
    for (int j = 0; j < 8; ++j) { const f32x4 gg = gr[64 * j]; xr[64 * j] = (f32x4){v[j].x * rstd * gg.x, v[j].y * rstd * gg.y, v[j].z * rstd * gg.z, v[j].w * rstd * gg.w}; }
}
template <bool F32OUT> __device__ __forceinline__ void rms_rows(const float* lo, const float* hi, int split, const float* g, bf16* ob, float* of, int gw, int NGW, int lane) {
    f32x4 gg[8]; { const f32x4* gr = (const f32x4*)g + lane;
#pragma unroll
      for (int j = 0; j < 8; ++j) gg[j] = gr[64 * j]; }
    f32x4 nv[8];
    { const int m = gw; const f32x4* xr = (const f32x4*)(m < split ? lo + (size_t)m * D : hi + (size_t)(m - split) * D) + lane;
#pragma unroll
      for (int j = 0; j < 8; ++j) nv[j] = __builtin_nontemporal_load(xr + 64 * j); }
    for (int m = gw; m < M; m += NGW) {
        f32x4 v[8]; float s = 0.f;
#pragma unroll
        for (int j = 0; j < 8; ++j) { v[j] = nv[j]; s += (v[j].x * v[j].x + v[j].y * v[j].y) + (v[j].z * v[j].z + v[j].w * v[j].w); }
        { const int mn = m + NGW < M ? m + NGW : m; const f32x4* xr = (const f32x4*)(mn < split ? lo + (size_t)mn * D : hi + (size_t)(mn - split) * D) + lane;
#pragma unroll
          for (int j = 0; j < 8; ++j) nv[j] = __builtin_nontemporal_load(xr + 64 * j); }
        const float rstd = 1.0f / sqrtf(wave_sum(s) * (1.f / D) + RMS_EPS);
        if (F32OUT) { f32x4* o = (f32x4*)(of + (size_t)m * D) + lane;
#pragma unroll
            for (int j = 0; j < 8; ++j) o[64 * j] = (f32x4){v[j].x * rstd * gg[j].x, v[j].y * rstd * gg[j].y, v[j].z * rstd * gg[j].z, v[j].w * rstd * gg[j].w}; }
        else { v2u* o8 = (v2u*)(ob + (size_t)m * D) + lane;
#pragma unroll
            for (int j = 0; j < 8; ++j) { v2u w; w.x = cvt_pk_bf16(v[j].x * rstd * gg[j].x, v[j].y * rstd * gg[j].y); w.y = cvt_pk_bf16(v[j].z * rstd * gg[j].z, v[j].w * rstd * gg[j].w); o8[64 * j] = w; } }
    }
}
__device__ __forceinline__ void scale_rows(const bf16* xg, const unsigned long long* ss, float* out, int gw, int NGW, int lane) {
    v4u nv[4]; float ns;
    { const v4u* xr = (const v4u*)(xg + (size_t)gw * D) + lane; ns = (float)ss[gw];
#pragma unroll
      for (int j = 0; j < 4; ++j) nv[j] = xr[64 * j]; }
    for (int m = gw; m < M; m += NGW) { v4u v[4]; const float rstd = 1.0f / sqrtf(ns * (1.f / (16777216.0f * D)) + RMS_EPS);
#pragma unroll
        for (int j = 0; j < 4; ++j) v[j] = nv[j];
        { const int mn = m + NGW < M ? m + NGW : m; const v4u* xr = (const v4u*)(xg + (size_t)mn * D) + lane; ns = (float)ss[mn];
#pragma unroll
          for (int j = 0; j < 4; ++j) nv[j] = xr[64 * j]; }
        f32x4* o = (f32x4*)(out + (size_t)m * D) + 2 * lane;
#pragma unroll
        for (int j = 0; j < 4; ++j) { __builtin_nontemporal_store((f32x4){bf_lo(v[j].x) * rstd, bf_hi(v[j].x) * rstd, bf_lo(v[j].y) * rstd, bf_hi(v[j].y) * rstd}, o + 128 * j);
            __builtin_nontemporal_store((f32x4){bf_lo(v[j].z) * rstd, bf_hi(v[j].z) * rstd, bf_lo(v[j].w) * rstd, bf_hi(v[j].w) * rstd}, o + 128 * j + 1); } }
}
__device__ __forceinline__ void ld8bf(const bf16* p, bool ok, float (&o)[8]) {
    v4u w = (v4u){0u, 0u, 0u, 0u}; if (ok) w = *(const v4u*)p;
    o[0] = bf_lo(w.x); o[1] = bf_hi(w.x); o[2] = bf_lo(w.y); o[3] = bf_hi(w.y); o[4] = bf_lo(w.z); o[5] = bf_hi(w.z); o[6] = bf_lo(w.w); o[7] = bf_hi(w.w);
}
__device__ __forceinline__ void shift8(const bf16* base, size_t ld, size_t row, int t, const float* mu, float (&o)[8]) {
    float c[8], p[8], n[8];
    ld8bf(base + row * ld, true, c); ld8bf(base + (row - 1) * ld, t > 0, p); ld8bf(base + (row + 1) * ld, t < SEQL - 1, n);
    const f32x4 m0 = *(const f32x4*)mu, m1 = *(const f32x4*)(mu + 4);
#pragma unroll
    for (int j = 0; j < 8; ++j) { const float mm = j < 4 ? m0[j] : m1[j - 4]; o[j] = c[j] + (0.5f * (p[j] + n[j]) - c[j]) * mm; }
}

constexpr int RC = 32;
constexpr int RW_R = 0, RW_KD = 8192, RW_V = 16384, RW_KK = 24576, RW_W = 32768, RW_B = 40960, RW_Y = 49152, RW_TW = 57344, RW_AL = 61952, RW_INV = 66560;
struct RwkvP { const bf16* RKV; const bf16* SMALL; const float *mu, *w0, *w2, *a0, *a2, *k_k, *k_a, *r_k; _Float16* Y; float* BON;
#ifdef TPROBE
    float* tp;
#endif
};
__device__ __forceinline__ void rwkv_chain(LAS unsigned char* lds, const RwkvP& P, int seq, int h, int d, int tid, int lane, int wave) {
    LAS float* sR = (LAS float*)(lds + RW_R); LAS float* sKD = (LAS float*)(lds + RW_KD); LAS float* sV = (LAS float*)(lds + RW_V); LAS float* sKK = (LAS float*)(lds + RW_KK);
    LAS float* sW = (LAS float*)(lds + RW_W); LAS float* sB = (LAS float*)(lds + RW_B); LAS float* sY = (LAS float*)(lds + RW_Y); LAS float* sINV = (LAS float*)(lds + RW_INV);
    LAS bf16* sTW = (LAS bf16*)(lds + RW_TW); LAS bf16* sAL = (LAS bf16*)(lds + RW_AL);
    const int mi = wave >> 2, ni = wave & 3, fr = lane & 15, fq = lane >> 4;
    const int cc = h * HD + ni * 16 + fr;
    bf16x8 Bw[2], Ba[2];
#pragma unroll
    for (int ks = 0; ks < 2; ++ks) { unsigned w[4], a[4];
#pragma unroll
        for (int j = 0; j < 4; ++j) { const int k0 = ks * 32 + fq * 8 + 2 * j; const size_t i0 = (size_t)(d * 64 + k0) * RW + cc, i1 = i0 + RW;
            w[j] = cvt_pk_bf16(P.w2[i0], P.w2[i1]); a[j] = cvt_pk_bf16(P.a2[i0], P.a2[i1]); }
        Bw[ks] = __builtin_bit_cast(bf16x8, (v4u){w[0], w[1], w[2], w[3]}); Ba[ks] = __builtin_bit_cast(bf16x8, (v4u){a[0], a[1], a[2], a[3]}); }
    const float w0c = P.w0[d * RW + cc], a0c = P.a0[d * RW + cc], kkc = P.k_k[cc], kac = P.k_a[cc];
    const int ke = lane & 7, srow = wave * 8 + (lane >> 3);
    float S[8];
#pragma unroll
    for (int j = 0; j < 8; ++j) S[j] = 0.f;
    const int st_t = tid >> 4, st_s = tid & 15;
    float kk4[4], rk4[4];
#pragma unroll
    for (int j = 0; j < 4; ++j) { kk4[j] = P.k_k[h * HD + st_s * 4 + j]; rk4[j] = P.r_k[h * HD + st_s * 4 + j]; }

    for (int ci = 0; ci < SEQL / RC; ++ci) {
        const int t0 = (d ? (SEQL / RC - 1 - ci) : ci) * RC;
        for (int p = tid; p < RC * 40; p += NWAVES * 64) {
            const int t = p / 40, rem = p - t * 40, seg = rem >> 3, c8 = (rem & 7) * 8; const int tt = t0 + t; const size_t row = (size_t)seq * SEQL + tt;
            float o[8];
            if (seg < 3) { const int col = seg * RW + h * HD + c8; shift8(P.RKV + col, RKW, row, tt, P.mu + col, o);
                LAS float* dst = (seg == 0 ? sR : (seg == 1 ? sKD : sV)) + t * 64 + c8;
                *(LAS f32x4*)dst = (f32x4){o[0], o[1], o[2], o[3]}; *(LAS f32x4*)(dst + 4) = (f32x4){o[4], o[5], o[6], o[7]}; }
            else { const int scol = (seg == 3 ? SM_WLOW : SM_ALOW) + d * 64 + c8, mcol = (seg == 3 ? MU_WLOW : MU_ALOW) + d * 64 + c8;
                shift8(P.SMALL + scol, SMW, row, tt, P.mu + mcol, o);
                if (seg == 3) {
#pragma unroll
                    for (int j = 0; j < 8; ++j) o[j] = ftanh(o[j]); }
                v4u w; w.x = cvt_pk_bf16(o[0], o[1]); w.y = cvt_pk_bf16(o[2], o[3]); w.z = cvt_pk_bf16(o[4], o[5]); w.w = cvt_pk_bf16(o[6], o[7]);
                *(LAS v4u*)((seg == 3 ? sTW : sAL) + t * 72 + c8) = w; }
        }
        __syncthreads();
        { float s = 0.f;
#pragma unroll
          for (int j = 0; j < 4; ++j) { const float q = sKD[st_t * 64 + st_s * 4 + j] * kk4[j]; s += q * q; }
          s = red16(s); if (st_s == 0) sINV[st_t] = 1.0f / sqrtf(s + 1e-12f); }
        f32x4 accw = (f32x4){0.f, 0.f, 0.f, 0.f}, acca = accw;
#pragma unroll
        for (int ks = 0; ks < 2; ++ks) { const bf16x8 aw = *(const LAS bf16x8*)(sTW + (mi * 16 + fr) * 72 + ks * 32 + fq * 8), aa = *(const LAS bf16x8*)(sAL + (mi * 16 + fr) * 72 + ks * 32 + fq * 8);
            accw = __builtin_amdgcn_mfma_f32_16x16x32_bf16(aw, Bw[ks], accw, 0, 0, 0); acca = __builtin_amdgcn_mfma_f32_16x16x32_bf16(aa, Ba[ks], acca, 0, 0, 0); }
        __syncthreads();
#pragma unroll
        for (int i = 0; i < 4; ++i) { const int t = mi * 16 + fq * 4 + i, c = ni * 16 + fr;
            const float wv = __builtin_amdgcn_exp2f(-0.875035265f * fsigmoid(accw[i] + w0c));
            const float av = fsigmoid(acca[i] + a0c);
            const float kr = sKD[t * 64 + c], kkv = kr * kkc * sINV[t];
            sW[t * 64 + c] = wv; sKK[t * 64 + c] = kkv; sB[t * 64 + c] = kkv * av; sKD[t * 64 + c] = kr * (1.0f + (av - 1.0f) * kac); }
        __syncthreads();
        { float s = 0.f;
#pragma unroll
          for (int j = 0; j < 4; ++j) s += sR[st_t * 64 + st_s * 4 + j] * sKD[st_t * 64 + st_s * 4 + j] * rk4[j];
          s = red16(s); if (st_s == 0) P.BON[((size_t)d * M + (size_t)seq * SEQL + t0 + st_t) * NH + h] = s; }
#pragma unroll 2
        for (int s = 0; s < RC; ++s) { const int t = d ? RC - 1 - s : s; const int o = t * 64 + ke * 8;
            const f32x4 k0 = *(const LAS f32x4*)(sKK + o), k1 = *(const LAS f32x4*)(sKK + o + 4), w0 = *(const LAS f32x4*)(sW + o), w1 = *(const LAS f32x4*)(sW + o + 4);
            const f32x4 b0 = *(const LAS f32x4*)(sB + o), b1 = *(const LAS f32x4*)(sB + o + 4), d0 = *(const LAS f32x4*)(sKD + o), d1 = *(const LAS f32x4*)(sKD + o + 4);
            const f32x4 r0 = *(const LAS f32x4*)(sR + o), r1 = *(const LAS f32x4*)(sR + o + 4); const float vv = sV[t * 64 + srow];
            float sa0 = S[0] * k0[0], sa1 = S[4] * k1[0];
#pragma unroll
            for (int j = 1; j < 4; ++j) { sa0 += S[j] * k0[j]; sa1 += S[4 + j] * k1[j]; }
            const float sa = -red8(sa0 + sa1);
            float y0 = 0.f, y1 = 0.f;
#pragma unroll
            for (int j = 0; j < 4; ++j) { S[j] = S[j] * w0[j] + (sa * b0[j] + vv * d0[j]); S[4 + j] = S[4 + j] * w1[j] + (sa * b1[j] + vv * d1[j]); y0 += S[j] * r0[j]; y1 += S[4 + j] * r1[j]; }
            const float y = red8(y0 + y1);
            if (ke == 0) sY[t * 64 + srow] = y; }
        __syncthreads();
        { const f32x4 yv = *(const LAS f32x4*)(sY + st_t * 64 + st_s * 4); h16x4 o; o[0] = (_Float16)yv[0]; o[1] = (_Float16)yv[1]; o[2] = (_Float16)yv[2]; o[3] = (_Float16)yv[3];
          *(h16x4*)(P.Y + ((size_t)seq * SEQL + t0 + st_t) * RW + h * HD + st_s * 4) = o; }
    }
}

constexpr int RW_AT = 66688, RW_RT = 71296, RW_BT = 75904, RW_KT = 80512, RW_BPT = 85120, RW_KPT = 89216, RW_VT = 93312, RW_LKA = 97408, RW_LRB = 98432, RW_LRK = 99456, RW_NTI = 100480, RW_LBA = 101504, RW_LAM = 103552;
__device__ __forceinline__ float quad_bcast(float v, const int n) { const int x = __builtin_bit_cast(int, v); int r;
    if (n == 0) r = __builtin_amdgcn_update_dpp(x, x, 0x00, 0xF, 0xF, false); else if (n == 1) r = __builtin_amdgcn_update_dpp(x, x, 0x55, 0xF, 0xF, false);
    else if (n == 2) r = __builtin_amdgcn_update_dpp(x, x, 0xAA, 0xF, 0xF, false); else r = __builtin_amdgcn_update_dpp(x, x, 0xFF, 0xF, 0xF, false);
    return __builtin_bit_cast(float, r); }
__device__ __forceinline__ bf16x4 pk4(float a, float b, float c, float d) { return __builtin_bit_cast(bf16x4, (v2u){cvt_pk_bf16(a, b), cvt_pk_bf16(c, d)}); }
__device__ __forceinline__ bf16x8 cat8(bf16x4 lo, bf16x4 hi) { return __builtin_shufflevector(lo, hi, 0, 1, 2, 3, 4, 5, 6, 7); }
__device__ __forceinline__ void rwkv_chain2(LAS unsigned char* lds, const RwkvP& P, int seq, int h, int d, int tid, int lane, int wave) {
    LAS float* sR = (LAS float*)(lds + RW_R); LAS float* sKD = (LAS float*)(lds + RW_KD); LAS float* sV = (LAS float*)(lds + RW_V); LAS float* sKK = (LAS float*)(lds + RW_KK);
    LAS float* sW = (LAS float*)(lds + RW_W); LAS float* sB = (LAS float*)(lds + RW_B); LAS float* sY = (LAS float*)(lds + RW_Y); LAS float* sINV = (LAS float*)(lds + RW_INV);
    LAS bf16* sTW = (LAS bf16*)(lds + RW_TW); LAS bf16* sAL = (LAS bf16*)(lds + RW_AL);
    LAS bf16* AT = (LAS bf16*)(lds + RW_AT); LAS bf16* RT = (LAS bf16*)(lds + RW_RT); LAS bf16* BT = (LAS bf16*)(lds + RW_BT); LAS bf16* KT = (LAS bf16*)(lds + RW_KT);
    LAS bf16* BPT = (LAS bf16*)(lds + RW_BPT); LAS bf16* KPT = (LAS bf16*)(lds + RW_KPT); LAS bf16* VT = (LAS bf16*)(lds + RW_VT);
    LAS bf16* LKA = (LAS bf16*)(lds + RW_LKA); LAS bf16* LRB = (LAS bf16*)(lds + RW_LRB); LAS bf16* LRK = (LAS bf16*)(lds + RW_LRK); LAS bf16* NTI = (LAS bf16*)(lds + RW_NTI);
    LAS float* LBA = (LAS float*)(lds + RW_LBA); LAS float* LAM = (LAS float*)(lds + RW_LAM);
    const int mi = wave >> 2, ni = wave & 3, fr = lane & 15, fq = lane >> 4;
    const int cc = h * HD + ni * 16 + fr;
    bf16x8 Bw[2], Ba[2];
#pragma unroll
    for (int ks = 0; ks < 2; ++ks) { unsigned w[4], a[4];
#pragma unroll
        for (int j = 0; j < 4; ++j) { const int k0 = ks * 32 + fq * 8 + 2 * j; const size_t i0 = (size_t)(d * 64 + k0) * RW + cc, i1 = i0 + RW;
            w[j] = cvt_pk_bf16(P.w2[i0], P.w2[i1]); a[j] = cvt_pk_bf16(P.a2[i0], P.a2[i1]); }
        Bw[ks] = __builtin_bit_cast(bf16x8, (v4u){w[0], w[1], w[2], w[3]}); Ba[ks] = __builtin_bit_cast(bf16x8, (v4u){a[0], a[1], a[2], a[3]}); }
    const float w0c = P.w0[d * RW + cc], a0c = P.a0[d * RW + cc], kkc = P.k_k[cc], kac = P.k_a[cc];
    const int st_t = tid >> 4, st_s = tid & 15;
    float kk4[4], rk4[4];
#pragma unroll
    for (int j = 0; j < 4; ++j) { kk4[j] = P.k_k[h * HD + st_s * 4 + j]; rk4[j] = P.r_k[h * HD + st_s * 4 + j]; }
    f32x4 S[4]; bf16x8 Sb[2];
#pragma unroll
    for (int kt = 0; kt < 4; ++kt) S[kt] = (f32x4){0.f, 0.f, 0.f, 0.f};
    Sb[0] = (bf16x8){0, 0, 0, 0, 0, 0, 0, 0}; Sb[1] = Sb[0];

    for (int ci = 0; ci < SEQL / RC; ++ci) {
        const int t0 = (d ? (SEQL / RC - 1 - ci) : ci) * RC;
        for (int p = tid; p < RC * 40; p += NWAVES * 64) {
            const int t = p / 40, rem = p - t * 40, seg = rem >> 3, c8 = (rem & 7) * 8; const int tt = t0 + (d ? RC - 1 - t : t); const size_t row = (size_t)seq * SEQL + tt;
            float o[8];
            if (seg < 3) { const int col = seg * RW + h * HD + c8; shift8(P.RKV + col, RKW, row, tt, P.mu + col, o);
                LAS float* dst = (seg == 0 ? sR : (seg == 1 ? sKD : sV)) + t * 64 + c8;
                *(LAS f32x4*)dst = (f32x4){o[0], o[1], o[2], o[3]}; *(LAS f32x4*)(dst + 4) = (f32x4){o[4], o[5], o[6], o[7]}; }
            else { const int scol = (seg == 3 ? SM_WLOW : SM_ALOW) + d * 64 + c8, mcol = (seg == 3 ? MU_WLOW : MU_ALOW) + d * 64 + c8;
                shift8(P.SMALL + scol, SMW, row, tt, P.mu + mcol, o);
                if (seg == 3) {
#pragma unroll
                    for (int j = 0; j < 8; ++j) o[j] = ftanh(o[j]); }
                v4u w; w.x = cvt_pk_bf16(o[0], o[1]); w.y = cvt_pk_bf16(o[2], o[3]); w.z = cvt_pk_bf16(o[4], o[5]); w.w = cvt_pk_bf16(o[6], o[7]);
                *(LAS v4u*)((seg == 3 ? sTW : sAL) + t * 72 + c8) = w; }
        }
        __syncthreads();
        { float s = 0.f;
#pragma unroll
          for (int j = 0; j < 4; ++j) { const float q = sKD[st_t * 64 + st_s * 4 + j] * kk4[j]; s += q * q; }
          s = red16(s); if (st_s == 0) sINV[st_t] = 1.0f / sqrtf(s + 1e-12f); }
        f32x4 accw = (f32x4){0.f, 0.f, 0.f, 0.f}, acca = accw;
#pragma unroll
        for (int ks = 0; ks < 2; ++ks) { const bf16x8 aw = *(const LAS bf16x8*)(sTW + (mi * 16 + fr) * 72 + ks * 32 + fq * 8), aa = *(const LAS bf16x8*)(sAL + (mi * 16 + fr) * 72 + ks * 32 + fq * 8);
            accw = __builtin_amdgcn_mfma_f32_16x16x32_bf16(aw, Bw[ks], accw, 0, 0, 0); acca = __builtin_amdgcn_mfma_f32_16x16x32_bf16(aa, Ba[ks], acca, 0, 0, 0); }
        __syncthreads();
#pragma unroll
        for (int i = 0; i < 4; ++i) { const int t = mi * 16 + fq * 4 + i, c = ni * 16 + fr;
            const float lw = -0.875035265f * fsigmoid(accw[i] + w0c);
            const float av = fsigmoid(acca[i] + a0c);
            const float kr = sKD[t * 64 + c], kkv = kr * kkc * sINV[t];
            sW[t * 64 + c] = lw; sKK[t * 64 + c] = kkv; sB[t * 64 + c] = kkv * av; sKD[t * 64 + c] = kr * (1.0f + (av - 1.0f) * kac); }
        __syncthreads();
        { float s = 0.f;
#pragma unroll
          for (int j = 0; j < 4; ++j) s += sR[st_t * 64 + st_s * 4 + j] * sKD[st_t * 64 + st_s * 4 + j] * rk4[j];
          s = red16(s); if (st_s == 0) P.BON[((size_t)d * M + (size_t)seq * SEQL + t0 + (d ? RC - 1 - st_t : st_t)) * NH + h] = s; }
        { const int c = tid >> 8, k = (tid >> 2) & 63, qq = tid & 3, sb = 16 * c + 4 * qq;
          float lw[4], cum[4];
#pragma unroll
          for (int i = 0; i < 4; ++i) lw[i] = sW[(sb + i) * 64 + k];
          cum[0] = lw[0]; cum[1] = cum[0] + lw[1]; cum[2] = cum[1] + lw[2]; cum[3] = cum[2] + lw[3];
          const float q0 = quad_bcast(cum[3], 0), q1 = quad_bcast(cum[3], 1), q2 = quad_bcast(cum[3], 2), q3 = quad_bcast(cum[3], 3);
          const float off = (qq > 0 ? q0 : 0.f) + (qq > 1 ? q1 : 0.f) + (qq > 2 ? q2 : 0.f), c15 = (q0 + q1) + (q2 + q3);
          float bp[4], kp[4], vv[4];
#pragma unroll
          for (int i = 0; i < 4; ++i) { const int s = sb + i, sl = 4 * qq + i; const float cs = off + cum[i];
              const float lam = __builtin_amdgcn_exp2f(cs), ilam = __builtin_amdgcn_exp2f(-cs), lprev = __builtin_amdgcn_exp2f(cs - lw[i]), rat = __builtin_amdgcn_exp2f(c15 - cs);
              const float kkv = sKK[s * 64 + k], bv = sB[s * 64 + k], kd = sKD[s * 64 + k], rv = sR[s * 64 + k];
              AT[(c * 16 + sl) * 72 + k] = (bf16)f2bf(kkv * lprev); RT[(c * 16 + sl) * 72 + k] = (bf16)f2bf(rv * lam); BT[(c * 16 + sl) * 72 + k] = (bf16)f2bf(bv * ilam); KT[(c * 16 + sl) * 72 + k] = (bf16)f2bf(kd * ilam);
              bp[i] = bv * rat; kp[i] = kd * rat; vv[i] = sV[s * 64 + k]; }
          *(LAS bf16x4*)(BPT + (c * 64 + k) * 16 + 4 * qq) = pk4(bp[0], bp[1], bp[2], bp[3]); *(LAS bf16x4*)(KPT + (c * 64 + k) * 16 + 4 * qq) = pk4(kp[0], kp[1], kp[2], kp[3]);
          *(LAS bf16x4*)(VT + (c * 64 + k) * 16 + 4 * qq) = pk4(vv[0], vv[1], vv[2], vv[3]);
          if (qq == 0) LAM[c * 64 + k] = __builtin_amdgcn_exp2f(c15); }
        __syncthreads();
        { const int c = wave >> 2, mat = wave & 3; const LAS bf16* Ax = (mat < 2 ? AT : RT) + c * 16 * 72; const LAS bf16* Bx = ((mat & 1) == 0 ? BT : KT) + c * 16 * 72;
          f32x4 acc = (f32x4){0.f, 0.f, 0.f, 0.f};
#pragma unroll
          for (int ks = 0; ks < 2; ++ks) { const bf16x8 a = *(const LAS bf16x8*)(Ax + fr * 72 + ks * 32 + fq * 8), b = *(const LAS bf16x8*)(Bx + fr * 72 + ks * 32 + fq * 8);
              acc = __builtin_amdgcn_mfma_f32_16x16x32_bf16(a, b, acc, 0, 0, 0); }
#pragma unroll
          for (int i = 0; i < 4; ++i) { const int s = 4 * fq + i, j = fr; const bool keep = mat < 2 ? (j < s) : (j <= s); const float v = keep ? acc[i] : 0.f;
              if (mat == 0) LBA[c * 256 + s * 16 + j] = v; else (mat == 1 ? LKA : (mat == 2 ? LRB : LRK))[c * 256 + s * 16 + j] = (bf16)f2bf(v); } }
        __syncthreads();
        if (wave == 0 && lane < 32) { const int c = lane >> 4, col = lane & 15; float T[16];
#pragma unroll
            for (int s = 0; s < 16; ++s) { float t = (s == col) ? 1.0f : 0.f;
                const LAS float* Lr = LBA + c * 256 + s * 16;
#pragma unroll
                for (int j = 0; j < s; ++j) t -= Lr[j] * T[j];
                T[s] = t; NTI[c * 256 + s * 16 + col] = (bf16)f2bf(-t); } }
        __syncthreads();
        if (wave < 4) {
#pragma unroll
            for (int c = 0; c < 2; ++c) {
                const bf16x4 vt = *(const LAS bf16x4*)(VT + (c * 64 + 16 * wave + fr) * 16 + 4 * fq);
                f32x4 w1 = __builtin_amdgcn_mfma_f32_16x16x16bf16_1k(*(const LAS bf16x4*)(LKA + c * 256 + fr * 16 + 4 * fq), vt, (f32x4){0.f, 0.f, 0.f, 0.f}, 0, 0, 0);
                f32x4 y = __builtin_amdgcn_mfma_f32_16x16x16bf16_1k(*(const LAS bf16x4*)(LRK + c * 256 + fr * 16 + 4 * fq), vt, (f32x4){0.f, 0.f, 0.f, 0.f}, 0, 0, 0);
#pragma unroll
                for (int ks = 0; ks < 2; ++ks) { const LAS bf16* ar = AT + (c * 16 + fr) * 72 + 32 * ks + 4 * fq; const LAS bf16* rr = RT + (c * 16 + fr) * 72 + 32 * ks + 4 * fq;
                    w1 = __builtin_amdgcn_mfma_f32_16x16x32_bf16(cat8(*(const LAS bf16x4*)ar, *(const LAS bf16x4*)(ar + 16)), Sb[ks], w1, 0, 0, 0);
                    y = __builtin_amdgcn_mfma_f32_16x16x32_bf16(cat8(*(const LAS bf16x4*)rr, *(const LAS bf16x4*)(rr + 16)), Sb[ks], y, 0, 0, 0); }
                const f32x4 sa = __builtin_amdgcn_mfma_f32_16x16x16bf16_1k(*(const LAS bf16x4*)(NTI + c * 256 + fr * 16 + 4 * fq), pk4(w1[0], w1[1], w1[2], w1[3]), (f32x4){0.f, 0.f, 0.f, 0.f}, 0, 0, 0);
                const bf16x4 sab = pk4(sa[0], sa[1], sa[2], sa[3]);
                y = __builtin_amdgcn_mfma_f32_16x16x16bf16_1k(*(const LAS bf16x4*)(LRB + c * 256 + fr * 16 + 4 * fq), sab, y, 0, 0, 0);
#pragma unroll
                for (int i = 0; i < 4; ++i) sY[(16 * c + 4 * fq + i) * 64 + 16 * wave + fr] = y[i];
#pragma unroll
                for (int kt = 0; kt < 4; ++kt) { const f32x4 lm = *(const LAS f32x4*)(LAM + c * 64 + 16 * kt + 4 * fq); f32x4 sn = S[kt] * lm;
                    sn = __builtin_amdgcn_mfma_f32_16x16x16bf16_1k(*(const LAS bf16x4*)(BPT + (c * 64 + 16 * kt + fr) * 16 + 4 * fq), sab, sn, 0, 0, 0);
                    sn = __builtin_amdgcn_mfma_f32_16x16x16bf16_1k(*(const LAS bf16x4*)(KPT + (c * 64 + 16 * kt + fr) * 16 + 4 * fq), vt, sn, 0, 0, 0);
                    S[kt] = sn; }
#pragma unroll
                for (int ks = 0; ks < 2; ++ks) Sb[ks] = cat8(pk4(S[2 * ks][0], S[2 * ks][1], S[2 * ks][2], S[2 * ks][3]), pk4(S[2 * ks + 1][0], S[2 * ks + 1][1], S[2 * ks + 1][2], S[2 * ks + 1][3]));
            }
        }
        __syncthreads();
        { const f32x4 yv = *(const LAS f32x4*)(sY + st_t * 64 + st_s * 4); h16x4 o; o[0] = (_Float16)yv[0]; o[1] = (_Float16)yv[1]; o[2] = (_Float16)yv[2]; o[3] = (_Float16)yv[3];
          *(h16x4*)(P.Y + ((size_t)seq * SEQL + t0 + (d ? RC - 1 - st_t : st_t)) * RW + h * HD + st_s * 4) = o; }
    }
}

constexpr int C3_MU = 115840, C3_KK = 117120, C3_TSCR = 117376, C3_RAW = 118912;
static_assert(C3_RAW + 32 * 656 <= LDSCTL_OFF && 32 * 656 <= 24576, "rwkv LDS map");
constexpr int C3_R = 0, C3_KR = 8192, C3_V = 16384, C3_TW = 24576, C3_AL = 29184, C3_INV = 33792, C3_BONP = 33920  , C3_Y = 34944, C3_LBA = 43136, C3_LX = 45184, C3_TB = 53376, C3_TBSZ = 31232;
constexpr int T_AT = 0, T_RT = 4608, T_BT = 9216, T_KT = 13824, T_BPT = 18432, T_KPT = 22528, T_VT = 26624, T_LAM = 30720, X_LKA = 0, X_LRB = 1024, X_LRK = 2048, X_NTI = 3072;
__device__ __forceinline__ bf16 bf1(float x) { return __builtin_bit_cast(bf16, (__bf16)x); }
__device__ __forceinline__ float bf2f_(bf16 b) { return __builtin_bit_cast(float, (unsigned)b << 16); }
__device__ __forceinline__ void rwkv_chain3(LAS unsigned char* lds, const RwkvP& P, int seq, int h, int d, int tid, int lane, int wave, const int probe) {
    LAS float* sR = (LAS float*)(lds + C3_R); LAS float* sKr = (LAS float*)(lds + C3_KR); LAS float* sV = (LAS float*)(lds + C3_V);
    LAS bf16* sTW = (LAS bf16*)(lds + C3_TW); LAS bf16* sAL = (LAS bf16*)(lds + C3_AL); LAS float* sINV = (LAS float*)(lds + C3_INV); LAS float* sBONP = (LAS float*)(lds + C3_BONP);
    LAS float* sY = (LAS float*)(lds + C3_Y); LAS float* LBA = (LAS float*)(lds + C3_LBA);
    constexpr int NR = SEQL / RC;
    const int mi = wave >> 2, ni = wave & 3, fr = lane & 15, fq = lane >> 4;
    const int cc = h * HD + ni * 16 + fr;
    bf16x8 Bw[2], Ba[2];
#pragma unroll
    for (int ks = 0; ks < 2; ++ks) { unsigned w[4], a[4];
#pragma unroll
        for (int j = 0; j < 4; ++j) { const int k0 = ks * 32 + fq * 8 + 2 * j; const size_t i0 = (size_t)(d * 64 + k0) * RW + cc, i1 = i0 + RW;
            w[j] = cvt_pk_bf16(P.w2[i0], P.w2[i1]); a[j] = cvt_pk_bf16(P.a2[i0], P.a2[i1]); }
        Bw[ks] = __builtin_bit_cast(bf16x8, (v4u){w[0], w[1], w[2], w[3]}); Ba[ks] = __builtin_bit_cast(bf16x8, (v4u){a[0], a[1], a[2], a[3]}); }
    const float w0c = P.w0[d * RW + cc], a0c = P.a0[d * RW + cc], kkc = P.k_k[cc], kac = P.k_a[cc], rkc = P.r_k[cc];
    const int st_t = tid >> 4, st_s = tid & 15;
    LAS float* sMU = (LAS float*)(lds + C3_MU); LAS float* sKK = (LAS float*)(lds + C3_KK);
    if (tid < 320) { const int sg = tid >> 6, c = tid & 63; sMU[tid] = P.mu[sg < 3 ? sg * RW + h * HD + c : (sg == 3 ? MU_WLOW : MU_ALOW) + d * 64 + c]; } else if (tid < 384) sKK[tid - 320] = P.k_k[h * HD + tid - 320];
    LAS bf16* sRAW0 = (LAS bf16*)(lds + C3_RAW); LAS bf16* sRAW1 = (LAS bf16*)(lds + C3_R);
    LAS float* sINVB = (LAS float*)(lds + C3_TW);
    int prr[3], pcol[3], psrc[3];
#pragma unroll
    for (int it = 0; it < 3; ++it) { const int p = tid + it * NWAVES * 64; const int rr = p / 40, rem = p - rr * 40, sg = rem >> 3, c8 = (rem & 7) * 8; prr[it] = rr; pcol[it] = sg * 64 + c8;
        psrc[it] = sg < 3 ? sg * RW + h * HD + c8 : (sg == 3 ? DS_TW : DS_AL) + d * 64 + c8; }
    v4u gc[3]; float ginv = 0.f;
#define C3_ISSUE(q) do { const int _t0 = (d ? (NR - 1 - (q)) : (q)) * RC; _Pragma("unroll") for (int it = 0; it < 3; ++it) { const int tt = _t0 + (d ? RC - 1 - prr[it] : prr[it]); \
        gc[it] = ((tid + it * NWAVES * 64) < RC * 40) ? *(const v4u*)(P.RKV + ((size_t)seq * SEQL + tt) * DSW + psrc[it]) : (v4u){0u, 0u, 0u, 0u}; } \
        if (tid < RC) ginv = ((const float*)(P.RKV + ((size_t)seq * SEQL + _t0 + (d ? RC - 1 - tid : tid)) * DSW + DS_INV))[h]; } while (0)
#define C3_RAWWR(q) do { LAS bf16* sRAW = ((q) & 1) ? sRAW1 : sRAW0; _Pragma("unroll") for (int it = 0; it < 3; ++it) if ((tid + it * NWAVES * 64) < RC * 40) *(LAS v4u*)(sRAW + prr[it] * 328 + pcol[it]) = gc[it]; \
        if (tid < RC) sINVB[((q) & 1) * 32 + tid] = ginv; } while (0)
    f32x4 S[4]; bf16x8 Sb[2];
#pragma unroll
    for (int kt = 0; kt < 4; ++kt) S[kt] = (f32x4){0.f, 0.f, 0.f, 0.f};
    Sb[0] = (bf16x8){0, 0, 0, 0, 0, 0, 0, 0}; Sb[1] = Sb[0];
    const int vw = wave & 3;
    C3_ISSUE(0); C3_RAWWR(0); C3_ISSUE(1);
    __syncthreads();
#ifdef TPROBE
    unsigned long long tpa0 = 0, tpa1 = 0, tps0 = 0, tps1 = 0, tpr0 = 0, tpt0 = 0, tpr1 = 0, tpt1 = 0;
#define TPT(k) do { const bool inr = i >= 4 && i < NR - 4; \
        if (wave == TP_WAVE) { if ((k) == 0) tpr0 = __builtin_amdgcn_s_memtime(); if ((k) == TP_FROM) tps0 = __builtin_amdgcn_s_memtime(); if ((k) == TP_TO && inr) tpa0 += __builtin_amdgcn_s_memtime() - tps0; if ((k) == 6 && inr) tpt0 += __builtin_amdgcn_s_memtime() - tpr0; } \
        if (wave == TP2_WAVE) { if ((k) == 0) tpr1 = __builtin_amdgcn_s_memtime(); if ((k) == TP2_FROM) tps1 = __builtin_amdgcn_s_memtime(); if ((k) == TP2_TO && inr) tpa1 += __builtin_amdgcn_s_memtime() - tps1; if ((k) == 6 && inr) tpt1 += __builtin_amdgcn_s_memtime() - tpr1; } } while (0)
#else
#define TPT(k) do { } while (0)
#endif
    for (int i = 0; i <= NR + 1; ++i) {
        TPT(0);
        if (i + 1 < NR && probe != 7) C3_RAWWR(i + 1);
        if (i + 2 < NR && probe != 7) C3_ISSUE(i + 2);
        if (i >= 2 && probe == 0) { const int q = i - 2, t0 = (d ? (NR - 1 - q) : q) * RC;
            const f32x4 yv = *(const LAS f32x4*)(sY + st_t * 64 + st_s * 4); h16x4 o; o[0] = (_Float16)yv[0]; o[1] = (_Float16)yv[1]; o[2] = (_Float16)yv[2]; o[3] = (_Float16)yv[3];
            *(h16x4*)(P.Y + ((size_t)seq * SEQL + t0 + (d ? RC - 1 - st_t : st_t)) * RW + h * HD + st_s * 4) = o; }
        if (i >= 1 && i <= NR && tid < RC && probe == 0) { const int q = i - 1, t0 = (d ? (NR - 1 - q) : q) * RC; const f32x4 b = *(const LAS f32x4*)(sBONP + ((i - 1) & 1) * 128 + tid * 4);
            P.BON[((size_t)d * M + (size_t)seq * SEQL + t0 + (d ? RC - 1 - tid : tid)) * NH + h] = (b[0] + b[1]) + (b[2] + b[3]); }
        TPT(7);
        if (i < NR && probe != 3 && probe != 6) { LAS unsigned char* tb = lds + C3_TB + (i & 1) * C3_TBSZ;
            LAS bf16* AT = (LAS bf16*)(tb + T_AT); LAS bf16* RT = (LAS bf16*)(tb + T_RT); LAS bf16* BT = (LAS bf16*)(tb + T_BT); LAS bf16* KT = (LAS bf16*)(tb + T_KT);
            LAS bf16* BPT = (LAS bf16*)(tb + T_BPT); LAS bf16* KPT = (LAS bf16*)(tb + T_KPT); LAS bf16* VT = (LAS bf16*)(tb + T_VT); LAS float* LAM = (LAS float*)(tb + T_LAM);
            const LAS bf16* rawb = (i & 1) ? sRAW1 : sRAW0; const LAS float* invb = sINVB + (i & 1) * 32;
            const int c = mi, k = ni * 16 + fr;
            f32x4 accw = (f32x4){0.f, 0.f, 0.f, 0.f}, acca = accw;
#pragma unroll
            for (int ks = 0; ks < 2; ++ks) { const bf16x8 aw = *(const LAS bf16x8*)(rawb + (c * 16 + fr) * 328 + 192 + ks * 32 + fq * 8), aa = *(const LAS bf16x8*)(rawb + (c * 16 + fr) * 328 + 256 + ks * 32 + fq * 8);
                accw = __builtin_amdgcn_mfma_f32_16x16x32_bf16(aw, Bw[ks], accw, 0, 0, 0); acca = __builtin_amdgcn_mfma_f32_16x16x32_bf16(aa, Ba[ks], acca, 0, 0, 0); }
            float lw[4], kkv[4], bv[4], kd[4], rv[4], vv[4], cum[4]; float bon[4];
            const f32x4 inv4 = *(const LAS f32x4*)(invb + 16 * c + 4 * fq);
#pragma unroll
            for (int j = 0; j < 4; ++j) { const int s = 16 * c + 4 * fq + j;
                lw[j] = -0.875035265f * fsigmoid(accw[j] + w0c); const float av = fsigmoid(acca[j] + a0c);
                const float kr = bf2f_(rawb[s * 328 + 64 + k]); kkv[j] = kr * kkc * inv4[j]; bv[j] = kkv[j] * av; kd[j] = kr * (1.0f + (av - 1.0f) * kac); rv[j] = bf2f_(rawb[s * 328 + k]); vv[j] = bf2f_(rawb[s * 328 + 128 + k]);
                bon[j] = rv[j] * kd[j] * rkc; }
            cum[0] = lw[0]; cum[1] = cum[0] + lw[1]; cum[2] = cum[1] + lw[2]; cum[3] = cum[2] + lw[3];
            const float q0 = __shfl(cum[3], fr), q1 = __shfl(cum[3], fr + 16), q2 = __shfl(cum[3], fr + 32), q3 = __shfl(cum[3], fr + 48);
            const float off = (fq > 0 ? q0 : 0.f) + (fq > 1 ? q1 : 0.f) + (fq > 2 ? q2 : 0.f), c15 = (q0 + q1) + (q2 + q3);
            const float l15 = __builtin_amdgcn_exp2f(c15);
            float bp[4], kp[4]; float lprev = __builtin_amdgcn_exp2f(off);
#pragma unroll
            for (int j = 0; j < 4; ++j) { const int sl = 4 * fq + j; const float cs = off + cum[j];
                const float lam = __builtin_amdgcn_exp2f(cs), ilam = __builtin_amdgcn_exp2f(-cs), rat = l15 * ilam;
                AT[(c * 16 + sl) * 72 + k] = bf1(kkv[j] * lprev); RT[(c * 16 + sl) * 72 + k] = bf1(rv[j] * lam); BT[(c * 16 + sl) * 72 + k] = bf1(bv[j] * ilam); KT[(c * 16 + sl) * 72 + k] = bf1(kd[j] * ilam);
                bp[j] = bv[j] * rat; kp[j] = kd[j] * rat; lprev = lam; }
            *(LAS bf16x4*)(BPT + (c * 64 + k) * 16 + 4 * fq) = pk4(bp[0], bp[1], bp[2], bp[3]); *(LAS bf16x4*)(KPT + (c * 64 + k) * 16 + 4 * fq) = pk4(kp[0], kp[1], kp[2], kp[3]);
            *(LAS bf16x4*)(VT + (c * 64 + k) * 16 + 4 * fq) = pk4(vv[0], vv[1], vv[2], vv[3]);
            if (fq == 0) LAM[c * 64 + k] = l15;
            { const float s0 = red16(bon[0]), s1 = red16(bon[1]), s2 = red16(bon[2]), s3 = red16(bon[3]);
              if (fr == 0) { LAS float* bo = sBONP + (i & 1) * 128 + (16 * c + 4 * fq) * 4 + ni; bo[0] = s0; bo[4] = s1; bo[8] = s2; bo[12] = s3; } }
        }
        TPT(1);
        __syncthreads();
        TPT(2);
#pragma unroll
        for (int half = 0; half < 2; ++half) {
            if (wave < 4) {
                {
                if (i < NR && probe != 2 && probe != 6) { LAS unsigned char* tb = lds + C3_TB + (i & 1) * C3_TBSZ; LAS unsigned char* lx = lds + C3_LX + (i & 1) * 4096; (void)tb;
                    const int c = wave & 1;
                    if (half == 0)
#pragma unroll
                    for (int mm = 0; mm < 3; ++mm) if (wave >= 2 || mm == 0) { const int mat = wave < 2 ? 0 : mm + 1;
                        const LAS bf16* Ax = (const LAS bf16*)(tb + (mat < 2 ? T_AT : T_RT)) + c * 16 * 72; const LAS bf16* Bx = (const LAS bf16*)(tb + ((mat & 1) == 0 ? T_BT : T_KT)) + c * 16 * 72; f32x4 acc = (f32x4){0.f, 0.f, 0.f, 0.f};
#pragma unroll
                        for (int ks = 0; ks < 2; ++ks) { const bf16x8 a = *(const LAS bf16x8*)(Ax + fr * 72 + ks * 32 + fq * 8), b = *(const LAS bf16x8*)(Bx + fr * 72 + ks * 32 + fq * 8);
                            acc = __builtin_amdgcn_mfma_f32_16x16x32_bf16(a, b, acc, 0, 0, 0); }
#pragma unroll
                        for (int j = 0; j < 4; ++j) { const int s = 4 * fq + j, jj = fr; const bool keep = mat < 2 ? (jj < s) : (jj <= s); const float v = keep ? acc[j] : 0.f;
                            if (mat == 0) LBA[c * 256 + s * 16 + jj] = v; else ((LAS bf16*)(lx + (mat == 1 ? X_LKA : (mat == 2 ? X_LRB : X_LRK))))[c * 256 + s * 16 + jj] = bf1(v); } }
                    if (wave < 2) { LAS bf16* NTI = (LAS bf16*)(lx + X_NTI) + c * 256; const LAS float* L = LBA + c * 256;
                        LAS float* TS = (LAS float*)(lds + C3_TSCR) + c * 192;
                        if (half == 0) {
                        LDS_WAIT(); __builtin_amdgcn_wave_barrier();
                        if (lane < 16) { const int blk = lane >> 3, col = lane & 7; float T[8];
#pragma unroll
                            for (int s = 0; s < 8; ++s) { float t = (s == col) ? 1.0f : 0.f; const LAS float* Lr = L + (8 * blk + s) * 16 + 8 * blk;
#pragma unroll
                                for (int j = 0; j < s; ++j) t -= Lr[j] * T[j];
                                T[s] = t; TS[blk * 64 + s * 8 + col] = t; NTI[(8 * blk + s) * 16 + 8 * blk + col] = bf1(-t); if (blk == 0) NTI[s * 16 + 8 + col] = (bf16)0; } }
                        } else {
                        { const int r = lane >> 3, cq = lane & 7; float x = 0.f;
#pragma unroll
                          for (int j = 0; j < 8; ++j) x += L[(8 + r) * 16 + j] * TS[j * 8 + cq];
                          TS[128 + r * 8 + cq] = x; }
                        LDS_WAIT(); __builtin_amdgcn_wave_barrier();
                        { const int r = lane >> 3, cq = lane & 7; float y = 0.f;
#pragma unroll
                          for (int j = 0; j < 8; ++j) y += TS[64 + r * 8 + j] * TS[128 + j * 8 + cq];
                          NTI[(8 + r) * 16 + cq] = bf1(y); } } }
                }
                }
            } else {
            if (i >= 1 && i <= NR && probe != 1 && probe != 6) { const int c = half; LAS unsigned char* tb = lds + C3_TB + ((i - 1) & 1) * C3_TBSZ; LAS unsigned char* lx = lds + C3_LX + ((i - 1) & 1) * 4096;
                const LAS bf16* AT = (const LAS bf16*)(tb + T_AT); const LAS bf16* RT = (const LAS bf16*)(tb + T_RT); const LAS bf16* BPT = (const LAS bf16*)(tb + T_BPT); const LAS bf16* KPT = (const LAS bf16*)(tb + T_KPT);
                const LAS bf16* VT = (const LAS bf16*)(tb + T_VT); const LAS float* LAM = (const LAS float*)(tb + T_LAM);
                const LAS bf16* LKA = (const LAS bf16*)(lx + X_LKA); const LAS bf16* LRB = (const LAS bf16*)(lx + X_LRB); const LAS bf16* LRK = (const LAS bf16*)(lx + X_LRK); const LAS bf16* NTI = (const LAS bf16*)(lx + X_NTI);
                const bf16x4 vt = *(const LAS bf16x4*)(VT + (c * 64 + 16 * vw + fr) * 16 + 4 * fq);
                f32x4 w1 = __builtin_amdgcn_mfma_f32_16x16x16bf16_1k(*(const LAS bf16x4*)(LKA + c * 256 + fr * 16 + 4 * fq), vt, (f32x4){0.f, 0.f, 0.f, 0.f}, 0, 0, 0);
                f32x4 y = __builtin_amdgcn_mfma_f32_16x16x16bf16_1k(*(const LAS bf16x4*)(LRK + c * 256 + fr * 16 + 4 * fq), vt, (f32x4){0.f, 0.f, 0.f, 0.f}, 0, 0, 0);
#pragma unroll
                for (int ks = 0; ks < 2; ++ks) { const LAS bf16* ar = AT + (c * 16 + fr) * 72 + 32 * ks + 4 * fq; const LAS bf16* rr = RT + (c * 16 + fr) * 72 + 32 * ks + 4 * fq;
                    w1 = __builtin_amdgcn_mfma_f32_16x16x32_bf16(cat8(*(const LAS bf16x4*)ar, *(const LAS bf16x4*)(ar + 16)), Sb[ks], w1, 0, 0, 0);
                    y = __builtin_amdgcn_mfma_f32_16x16x32_bf16(cat8(*(const LAS bf16x4*)rr, *(const LAS bf16x4*)(rr + 16)), Sb[ks], y, 0, 0, 0); }
                const f32x4 sa = __builtin_amdgcn_mfma_f32_16x16x16bf16_1k(*(const LAS bf16x4*)(NTI + c * 256 + fr * 16 + 4 * fq), pk4(w1[0], w1[1], w1[2], w1[3]), (f32x4){0.f, 0.f, 0.f, 0.f}, 0, 0, 0);
                const bf16x4 sab = pk4(sa[0], sa[1], sa[2], sa[3]);
                y = __builtin_amdgcn_mfma_f32_16x16x16bf16_1k(*(const LAS bf16x4*)(LRB + c * 256 + fr * 16 + 4 * fq), sab, y, 0, 0, 0);
#pragma unroll
                for (int j = 0; j < 4; ++j) sY[(16 * c + 4 * fq + j) * 64 + 16 * vw + fr] = y[j];
#pragma unroll
                for (int kt = 0; kt < 4; ++kt) { const f32x4 lm = *(const LAS f32x4*)(LAM + c * 64 + 16 * kt + 4 * fq); f32x4 sn = S[kt] * lm;
                    sn = __builtin_amdgcn_mfma_f32_16x16x16bf16_1k(*(const LAS bf16x4*)(BPT + (c * 64 + 16 * kt + fr) * 16 + 4 * fq), sab, sn, 0, 0, 0);
                    sn = __builtin_amdgcn_mfma_f32_16x16x16bf16_1k(*(const LAS bf16x4*)(KPT + (c * 64 + 16 * kt + fr) * 16 + 4 * fq), vt, sn, 0, 0, 0);
                    S[kt] = sn; }
#pragma unroll
                for (int ks = 0; ks < 2; ++ks) Sb[ks] = cat8(pk4(S[2 * ks][0], S[2 * ks][1], S[2 * ks][2], S[2 * ks][3]), pk4(S[2 * ks + 1][0], S[2 * ks + 1][1], S[2 * ks + 1][2], S[2 * ks + 1][3]));
            }
            }
            if (half == 0) TPT(3); else TPT(5);
            __syncthreads();
            if (half == 0) TPT(4); else TPT(6);
        }
    }
#ifdef TPROBE
    if (seq == 0 && h == 3 && d == 0 && lane == 0) { if (wave == TP_WAVE) P.tp[0] = 100.0f * (float)tpa0 / (float)tpt0; if (wave == TP2_WAVE) P.tp[1] = 100.0f * (float)tpa1 / (float)tpt1; }
#endif
#undef C3_ISSUE
#undef C3_RAWWR
}

constexpr int S5_WL = 14592;
struct S5Pm { const bf16* SMALL; const float *a_re, *a_im, *log_step, *b_re, *b_im, *c_re, *c_im; _Float16* Yp; };
__device__ __forceinline__ void s5_wave(LAS unsigned char* wl, const S5Pm& P, int seq, int g, int d, int lane) {
    LAS float* BU = (LAS float*)wl; LAS bf16* ST = (LAS bf16*)(wl + 10240);
    const int fr = lane & 15, fq = lane >> 4; const int dg = d * S5G + g;
    const float dt = expf(P.log_step[dg]);
    float lr, li;
    { const float are = P.a_re[dg * S5P + lane], aim = P.a_im[dg * S5P + lane]; const float mag = expf(are * dt); lr = mag * cosf(aim * dt); li = mag * sinf(aim * dt); }
    bf16x4 Bre[4], Bim[4];
#pragma unroll
    for (int jj = 0; jj < 4; ++jj) { const int p = 16 * jj + fr; const float are = P.a_re[dg * S5P + p], aim = P.a_im[dg * S5P + p]; const float mag = expf(are * dt);
        const float pr = mag * cosf(aim * dt), pi = mag * sinf(aim * dt); const float nr = pr - 1.0f, nim = pi, den = 1.0f / (are * are + aim * aim);
        const float cr = (nr * are + nim * aim) * den, ci = (nim * are - nr * aim) * den;
        float vr[4], vi[4];
#pragma unroll
        for (int j = 0; j < 4; ++j) { const size_t bi = ((size_t)dg * S5P + p) * S5C + 4 * fq + j; const float br = P.b_re[bi], bim = P.b_im[bi]; vr[j] = cr * br - ci * bim; vi[j] = cr * bim + ci * br; }
        Bre[jj] = __builtin_bit_cast(bf16x4, (v2u){cvt_pk_bf16(vr[0], vr[1]), cvt_pk_bf16(vr[2], vr[3])}); Bim[jj] = __builtin_bit_cast(bf16x4, (v2u){cvt_pk_bf16(vi[0], vi[1]), cvt_pk_bf16(vi[2], vi[3])}); }
    bf16x8 Cf[4];
#pragma unroll
    for (int ks = 0; ks < 4; ++ks) { const int k0 = (ks & 1) * 32 + fq * 8; const float* src = (ks < 2 ? P.c_re : P.c_im) + ((size_t)g * S5C + fr) * S5P + k0; const float sg = ks < 2 ? 1.0f : -1.0f;
        const f32x4 c0 = *(const f32x4*)src, c1 = *(const f32x4*)(src + 4);
        Cf[ks] = __builtin_bit_cast(bf16x8, (v4u){cvt_pk_bf16(sg * c0[0], sg * c0[1]), cvt_pk_bf16(sg * c0[2], sg * c0[3]), cvt_pk_bf16(sg * c1[0], sg * c1[1]), cvt_pk_bf16(sg * c1[2], sg * c1[3])}); }
    float xr = 0.f, xi = 0.f;
    const bf16* ub = P.SMALL + SM_U + g * S5C + 4 * fq;
    constexpr int NCH = SEQL / 16;
    v2u un1 = *(const v2u*)(ub + ((size_t)seq * SEQL + (size_t)(d ? NCH - 1 : 0) * 16 + fr) * SMW), un2 = *(const v2u*)(ub + ((size_t)seq * SEQL + (size_t)(d ? NCH - 2 : 1) * 16 + fr) * SMW);
    for (int ci = 0; ci < NCH; ++ci) {
        const int ch = d ? (NCH - 1 - ci) : ci; const size_t tok0 = (size_t)seq * SEQL + (size_t)ch * 16;
        const bf16x4 ua = __builtin_bit_cast(bf16x4, un1); un1 = un2;
        { const int cn = ci + 2 < NCH ? ci + 2 : ci; const int chn = d ? (NCH - 1 - cn) : cn; un2 = *(const v2u*)(ub + ((size_t)seq * SEQL + (size_t)chn * 16 + fr) * SMW); }
        const f32x4 z = (f32x4){0.f, 0.f, 0.f, 0.f};
#pragma unroll
        for (int jt = 0; jt < 8; ++jt) { const f32x4 acc = __builtin_amdgcn_mfma_f32_16x16x16bf16_1k(ua, jt < 4 ? Bre[jt] : Bim[jt - 4], z, 0, 0, 0);
            *(LAS f32x4*)(BU + (jt * 16 + fr) * 20 + 4 * fq) = acc; }
        LDS_WAIT(); __builtin_amdgcn_wave_barrier();
        float bre[16], bim[16];
#pragma unroll
        for (int j = 0; j < 4; ++j) { const f32x4 a = *(const LAS f32x4*)(BU + lane * 20 + 4 * j), b = *(const LAS f32x4*)(BU + (64 + lane) * 20 + 4 * j);
#pragma unroll
            for (int e = 0; e < 4; ++e) { bre[4 * j + e] = a[e]; bim[4 * j + e] = b[e]; } }
#pragma unroll
        for (int s = 0; s < 16; ++s) { const int t = d ? 15 - s : s; const float br = bre[t], bi = bim[t];
            const float nxr = lr * xr - li * xi + br, nxi = lr * xi + li * xr + bi; xr = nxr; xi = nxi;
            const unsigned pk = cvt_pk_bf16(xr, xi); ST[t * 136 + lane] = (bf16)(pk & 0xffffu); ST[t * 136 + 64 + lane] = (bf16)(pk >> 16); }
        LDS_WAIT(); __builtin_amdgcn_wave_barrier();
        f32x4 y = z;
#pragma unroll
        for (int ks = 0; ks < 4; ++ks) { const bf16x8 a = *(const LAS bf16x8*)(ST + fr * 136 + ks * 32 + fq * 8); y = __builtin_amdgcn_mfma_f32_16x16x32_bf16(a, Cf[ks], y, 0, 0, 0); }
        { LAS _Float16* YT = (LAS _Float16*)BU;
#pragma unroll
          for (int i = 0; i < 4; ++i) YT[(4 * fq + i) * 16 + fr] = (_Float16)y[i];
          LDS_WAIT(); __builtin_amdgcn_wave_barrier();
          if (lane < 32) { const v4u o = *(const LAS v4u*)(YT + lane * 8); *(v4u*)(P.Yp + (tok0 + (lane >> 1)) * S5D + g * S5C + (lane & 1) * 8) = o; } }
        LDS_WAIT(); __builtin_amdgcn_wave_barrier();
    }
}


#ifndef RWKV_REF
#define RWKV_REF 0
#endif
#ifndef RWKV_SEQ
#define RWKV_SEQ 0
#endif
#ifndef S5_REF
#define S5_REF 0
#endif
__device__ __forceinline__ float bf2f(bf16 b) { return __builtin_bit_cast(float, (unsigned)b << 16); }
__device__ __forceinline__ float shift1(const bf16* base, size_t ld, size_t row, int t, float mu) {
    const float c = bf2f(base[row * ld]), p = t > 0 ? bf2f(base[(row - 1) * ld]) : 0.f, n = t < SEQL - 1 ? bf2f(base[(row + 1) * ld]) : 0.f;
    return c + (0.5f * (p + n) - c) * mu;
}
__device__ __forceinline__ void rwkv_ref_wave(LAS float* sl, const RwkvP& P, int seq, int h, int d, int lane) {
    LAS float* vtw = sl; LAS float* val = sl + 64; LAS float* vkk = sl + 128; LAS float* vw = sl + 192; LAS float* vb = sl + 256; LAS float* vkd = sl + 320; LAS float* vr = sl + 384;
    const int c = h * HD + lane;
    LAS float* Sm = sl + 512 + lane * 65;
    for (int k = 0; k < 64; ++k) Sm[k] = 0.f;
    const float mur = P.mu[c], muk = P.mu[RW + c], muv = P.mu[2 * RW + c], muw = P.mu[MU_WLOW + d * 64 + lane], mua = P.mu[MU_ALOW + d * 64 + lane];
    const float w0c = P.w0[d * RW + c], a0c = P.a0[d * RW + c], kkc = P.k_k[c], kac = P.k_a[c], rkc = P.r_k[c];
    for (int s = 0; s < SEQL; ++s) { const int t = d ? SEQL - 1 - s : s; const size_t row = (size_t)seq * SEQL + t;
        const float r = shift1(P.RKV + c, RKW, row, t, mur), k = shift1(P.RKV + RW + c, RKW, row, t, muk), v = shift1(P.RKV + 2 * RW + c, RKW, row, t, muv);
        const float wl = tanhf(shift1(P.SMALL + SM_WLOW + d * 64 + lane, SMW, row, t, muw)), al = shift1(P.SMALL + SM_ALOW + d * 64 + lane, SMW, row, t, mua);
        vtw[lane] = wl; val[lane] = al; LDS_WAIT(); __builtin_amdgcn_wave_barrier();
        float wp = w0c, ap = a0c;
#pragma unroll 4
        for (int q = 0; q < 64; ++q) { wp += vtw[q] * P.w2[(size_t)(d * 64 + q) * RW + c]; ap += val[q] * P.a2[(size_t)(d * 64 + q) * RW + c]; }
        const float sp = log1pf(expf(-wp));
        const float w = expf(-expf(-sp - 0.5f)), a = 1.0f / (1.0f + expf(-ap));
        float kk = k * kkc; const float nn = wave_sum(kk * kk); kk = kk / sqrtf(nn + 1e-12f);
        const float kd = k * (1.0f + (a - 1.0f) * kac), b = kk * a;
        const float bon = wave_sum(r * kd * rkc); if (lane == 0) P.BON[((size_t)d * M + row) * NH + h] = bon;
        LDS_WAIT(); __builtin_amdgcn_wave_barrier();
        vkk[lane] = kk; vw[lane] = w; vb[lane] = b; vkd[lane] = kd; vr[lane] = r; LDS_WAIT(); __builtin_amdgcn_wave_barrier();
        float sa = 0.f;
#pragma unroll 8
        for (int q = 0; q < 64; ++q) sa -= Sm[q] * vkk[q];
        float y = 0.f;
#pragma unroll 8
        for (int q = 0; q < 64; ++q) { const float sn = Sm[q] * vw[q] + sa * vb[q] + v * vkd[q]; Sm[q] = sn; y += sn * vr[q]; }
        P.Y[row * RW + c] = (_Float16)y;
        LDS_WAIT(); __builtin_amdgcn_wave_barrier();
    }
}
__device__ __forceinline__ void s5_ref_wave(const S5Pm& P, int seq, int g, int d, int lane) {
    const int dg = d * S5G + g; const float dt = expf(P.log_step[dg]);
    const float are = P.a_re[dg * S5P + lane], aim = P.a_im[dg * S5P + lane]; const float mag = expf(are * dt); const float lr = mag * cosf(aim * dt), li = mag * sinf(aim * dt);
    const float nr = lr - 1.0f, nim = li, den = 1.0f / (are * are + aim * aim); const float cr = (nr * are + nim * aim) * den, ci = (nim * are - nr * aim) * den;
    float bbr[16], bbi[16], cre[16], cim[16];
#pragma unroll
    for (int c = 0; c < 16; ++c) { const float br = P.b_re[((size_t)dg * S5P + lane) * S5C + c], bim = P.b_im[((size_t)dg * S5P + lane) * S5C + c]; bbr[c] = cr * br - ci * bim; bbi[c] = cr * bim + ci * br;
        cre[c] = P.c_re[((size_t)g * S5C + c) * S5P + lane]; cim[c] = P.c_im[((size_t)g * S5C + c) * S5P + lane]; }
    float xr = 0.f, xi = 0.f;
    for (int s = 0; s < SEQL; ++s) { const int t = d ? SEQL - 1 - s : s; const size_t row = (size_t)seq * SEQL + t;
        float br = 0.f, bi = 0.f;
#pragma unroll
        for (int c = 0; c < 16; ++c) { const float u = bf2f(P.SMALL[row * SMW + SM_U + g * S5C + c]); br += u * bbr[c]; bi += u * bbi[c]; }
        const float nxr = lr * xr - li * xi + br, nxi = lr * xi + li * xr + bi; xr = nxr; xi = nxi;
#pragma unroll
        for (int c = 0; c < 16; ++c) { const float y = wave_sum(xr * cre[c] - xi * cim[c]); if (lane == c) P.Yp[row * S5D + g * S5C + c] = (_Float16)y; }
    }
}

struct Args { const float* in[37]; float* out; unsigned char* ws; int ph_lo, ph_hi, li, pad; };
enum { I_XP = 0, I_XS, I_NF1, I_F1G, I_F1U, I_F1D, I_NMIX, I_WIN, I_MU, I_W0, I_W2, I_A0, I_A2, I_G2, I_KK, I_KA, I_RK, I_LNW, I_LNB, I_SARE, I_SAIM, I_SLOG, I_SBRE, I_SBIM, I_SCRE, I_SCIM, I_SD, I_SWGLU, I_SBGLU, I_PR, I_PS, I_WO, I_NF2, I_F2G, I_F2U, I_F2D, I_NFIN };
constexpr int N_PHASES = 15;

#define KAS __attribute__((address_space(4)))
__device__ __forceinline__ const KAS unsigned char* kargs() { const KAS unsigned char* p = (const KAS unsigned char*)__builtin_amdgcn_kernarg_segment_ptr(); asm volatile("" : "+s"(p)); return p; }
#define ARGIN(k) (*(const float* const KAS*)(kp + 8 * (k)))
#define ECV (*(const int KAS*)(kargs() + 8 * 40 + 4))
#define PHASE_BEGIN() int tid = threadIdx.x; asm volatile("" : "+v"(tid)); const int lane = tid & 63; (void)lane; const KAS unsigned char* kp = kargs(); (void)kp; \
    unsigned char* ws = *(unsigned char* const KAS*)(kp + 8 * 38); (void)ws; float* X = *(float* const KAS*)(kp + 8 * 37); (void)X;
#define SS1 ((unsigned long long*)(ws + WS_CTL + 65536))
#define SS2 ((unsigned long long*)(ws + WS_CTL + 65536 + 196608))
#define SS3 ((unsigned long long*)(ws + WS_CTL + 65536 + 2 * 196608))
#define XN ((bf16*)(ws + WS_XN))
#define HB ((bf16*)(ws + WS_H))
#define WGU ((bf16*)(ws + WS_WGU))
#define WGU2 ((bf16*)(ws + WS_WGU2))
#define GB ((bf16*)(ws + WS_GATES))
#define WDN ((bf16*)(ws + WS_WDN))
#define WINA ((bf16*)(ws + WS_WINA))
#define WING ((bf16*)(ws + WS_WING))
#define WPR ((bf16*)(ws + WS_WPR))
#define WPS ((bf16*)(ws + WS_WPS))
#define WOUT ((bf16*)(ws + WS_WOUT))
#define G2T ((bf16*)(ws + WS_G2T))
#define WGLU ((bf16*)(ws + WS_WGLU))
#define BON ((float*)(ws + WS_BON))
#define SG ((bf16*)(ws + WS_SG))
#define RKV ((bf16*)(ws + WS_RKV))
#define SMALL ((bf16*)(ws + WS_SMALL))
#define GATES ((bf16*)(ws + WS_GATES))
#define DS ((bf16*)X)
#define YF ((_Float16*)(ws + WS_YF))
#define YB ((_Float16*)(ws + WS_YB))
#define S5F ((_Float16*)(ws + WS_S5F))
#define S5B ((_Float16*)(ws + WS_S5B))
#define TB ((bf16*)(ws + WS_YF))
#define YR ((bf16*)(ws + WS_YB))
#define YS0 ((bf16*)(ws + WS_S5F))
#define YS ((bf16*)(ws + WS_S5B))
#define YRS ((bf16*)X)
#define WPRS ((bf16*)(ws + WS_WPR))
#define MRG ((bf16*)(ws + WS_XN))
__global__ void __launch_bounds__(NWAVES * 64, 2) hyb_fwd(Args args_unused) {
    extern __shared__ __attribute__((aligned(16))) unsigned char lds_raw[];
    LAS unsigned char* lds = (LAS unsigned char*)lds_raw;
    volatile LAS unsigned* MISC = (volatile LAS unsigned*)(lds + MISC_OFF);
    const int wave = __builtin_amdgcn_readfirstlane((int)threadIdx.x >> 6);
    const int G = gridDim.x, bx = blockIdx.x;
    const int gw = bx * NWAVES + wave, NGW = G * NWAVES;
    for (int u = threadIdx.x; u < (LDS_BYTES - LDSCTL_OFF) / 4; u += NWAVES * 64) ((LAS unsigned*)(lds + LDSCTL_OFF))[u] = 0u;
    __syncthreads();
    int lo, hi, li; unsigned* ctl;
    { const KAS unsigned char* kp = kargs(); ctl = (unsigned*)(*(unsigned char* const KAS*)(kp + 8 * 38) + WS_CTL); lo = *(const int KAS*)(kp + 8 * 39); hi = *(const int KAS*)(kp + 8 * 39 + 4); li = *(const int KAS*)(kp + 8 * 40); }
    XcdBarrier bar; bar.bar = ctl + CW_BAR + li * XCD_BAR_WORDS; bar.x = 0; bar.st = nullptr;
    if (!MK_SPLIT) bar = xcd_barrier_post(ctl + CW_BAR + li * XCD_BAR_WORDS, MISC + 8);
#ifdef L2_PROBE
#define FIX_PROBE(ph) do { if (li == 1 && lo == (ph)) S.fix = bx & 7; } while (0)
#else
#define FIX_PROBE(ph) do { } while (0)
#endif
#define IN(k) (lo <= (k) && (k) < hi)
#define SEAM(k) do { if (IN(k) && IN((k) + 1)) xcd_barrier(bar); } while (0)
    LAS float* scr = (LAS float*)(lds + wave * 16384);

    if (IN(0)) { PHASE_BEGIN();
        constexpr int I0 = (D / 64) * (FF / 32), I2 = (FF / 64) * (D / 32), I3 = (D / 64) * (NA / 32), I4 = (D / 64) * (NGATE / 32), I5 = (RW / 64) * (D / 32), I6 = (S5D / 64) * (D / 32), I7 = (D / 64) * (D / 32), I8 = (128 / 64) * (RW / 32), I9 = (S5D / 64) * (S5D / 32);
        constexpr int NIT = 2 * I0; (void)I2; (void)I3; (void)I4; (void)I5; (void)I6; (void)I7; (void)I8; (void)I9;
        for (int it = gw; it < NIT; it += NGW) { int r = it;
            if (r < I0) { transpose_item(ARGIN(I_F1G), FF, FF, WGU, D, 1, scr, r, lane); continue; } r -= I0;
            transpose_item(ARGIN(I_F1U), FF, FF, WGU, D, 2, scr, r, lane);
        }
        rms_rows<false>(ARGIN(I_XP), ARGIN(I_XS), MP, ARGIN(I_NF1), XN, nullptr, gw, NGW, lane);
    }
    SEAM(0);
    if (IN(1)) { PHASE_BEGIN(); pg8::Gemm g{XN, WGU, M, NGU, D, 0}; pg8::StaticOrder S; S.init(M, NGU, G, bx); FIX_PROBE(1); pg8::EpiSwiGLU E{HB, FF, nullptr, FF / 64};
        pg8::gemm_phase<pg8::EpiSwiGLU, pg8::StaticOrder, true, true>(lds, g, S, E);
        { const int nfull = (M / 256) * (NGU / 256) / G;
          if (nfull * G + bx >= (M / 256) * (NGU / 256)) { const int ntail = (M / 256) * (NGU / 256) - nfull * G, gw2 = (bx - ntail) * NWAVES + wave, NGW2 = (G - ntail) * NWAVES;
            constexpr int I2 = (FF / 64) * (D / 32), I3 = (D / 64) * (NA / 32), I4 = (D / 64) * (NGATE / 32);
            constexpr int NIT2 = I2 + I3 + I4;
            for (int it = gw2; it < NIT2; it += NGW2) { int r = it;
                if (r < I2) { transpose_item(ARGIN(I_F1D), D, D, WDN, FF, 0, scr, r, lane); continue; } r -= I2;
                if (r < I3) { transpose_item(ARGIN(I_WIN), INC, NA, WINA, D, 0, scr, r, lane); continue; } r -= I3;
                transpose_item(ARGIN(I_WIN) + NA, INC, NGATE, WING, D, 0, scr, r, lane); }
            const v4u z = (v4u){0u, 0u, 0u, 0u};
            for (int i = gw2 * 64 + lane; i < (4096 - NA) * D / 8; i += NGW2 * 64) *(v4u*)(WINA + (size_t)NA * D + (size_t)i * 8) = z; } }
    }
    SEAM(1);
    if (IN(2)) { PHASE_BEGIN(); pg8::Gemm g{HB, WDN, M, D, FF, 0, 1}; pg8::PanelOrder S; S.init(M, D, G, bx); S.rev = 1;
        pg8::EpiRes2<0, 0> E{ARGIN(I_XP), ARGIN(I_XS), MP, nullptr, nullptr, XN, ARGIN(I_NMIX), nullptr, D, 0.5f, SS1};
        pg8::gemm_phase<pg8::EpiRes2<0, 0>, pg8::PanelOrder, true, true>(lds, g, S, E); }
    SEAM(2);
    if (IN(4)) { PHASE_BEGIN(); pg8::Gemm g{XN, WINA, M, 4096, D, 0}; pg8::StaticOrder S; S.init(M, 4096, G, bx); pg8::EpiBf<0> E{RKV, RKW, SMALL, SMW, RKW / 256, nullptr, 0, nullptr, 0, 0, nullptr, SS1};
        pg8::gemm_phase<pg8::EpiBf<0>, pg8::StaticOrder, true, true>(lds, g, S, E);
        if (!MK_SPLIT) xcd_barrier(bar);
        { const float* mu = ARGIN(I_MU); const float* kkp = ARGIN(I_KK);
          constexpr int RUN = 32, NRUN = M / RUN;
          for (int item = gw; item < 7 * NRUN; item += NGW) { const int run = item / 7, cb = item - run * 7, tok0 = run * RUN, t0 = tok0 & (SEQL - 1);
            const int sel = lane >> 4;
            const bool rd = cb < 6 || sel < 3;
            const bf16* src = cb < 6 ? RKV + cb * 512 + 8 * lane : SMALL + 8 * lane; const size_t ld = cb < 6 ? RKW : SMW;
            const int mcol = cb < 6 ? cb * 512 + 8 * lane : RKW + 8 * lane;
            f32x4 m0 = (f32x4){0.f, 0.f, 0.f, 0.f}, m1 = m0, k0 = m0, k1 = m0;
            if (rd) { m0 = *(const f32x4*)(mu + mcol); m1 = *(const f32x4*)(mu + mcol + 4); }
            if (cb == 2 || cb == 3) { k0 = *(const f32x4*)(kkp + mcol - RW); k1 = *(const f32x4*)(kkp + mcol - RW + 4); }
            float pv[8], cv[8], nv[8];
            ld8bf(src + (size_t)(tok0 - 1) * ld, rd && t0 > 0, pv); ld8bf(src + (size_t)tok0 * ld, rd, cv);
            v4u nx = (v4u){0u, 0u, 0u, 0u}; if (rd) nx = *(const v4u*)(src + (size_t)(tok0 + 1) * ld);
            for (int j = 0; j < RUN; ++j) { const int tok = tok0 + j;
                nv[0] = bf_lo(nx.x); nv[1] = bf_hi(nx.x); nv[2] = bf_lo(nx.y); nv[3] = bf_hi(nx.y); nv[4] = bf_lo(nx.z); nv[5] = bf_hi(nx.z); nv[6] = bf_lo(nx.w); nv[7] = bf_hi(nx.w);
                { const int tn = t0 + j + 2; nx = (v4u){0u, 0u, 0u, 0u}; if (rd && tn < SEQL) nx = *(const v4u*)(src + (size_t)(tok + 2) * ld); }
                float o[8];
#pragma unroll
                for (int e = 0; e < 8; ++e) { const float mm = e < 4 ? m0[e] : m1[e - 4]; o[e] = cv[e] + (0.5f * (pv[e] + nv[e]) - cv[e]) * mm; pv[e] = cv[e]; cv[e] = nv[e]; }
                bf16* drow = DS + (size_t)tok * DSW;
                if (cb < 6) { v4u w; w.x = cvt_pk_bf16(o[0], o[1]); w.y = cvt_pk_bf16(o[2], o[3]); w.z = cvt_pk_bf16(o[4], o[5]); w.w = cvt_pk_bf16(o[6], o[7]); *(v4u*)(drow + cb * 512 + 8 * lane) = w;
                    if (cb == 2 || cb == 3) { float s = 0.f;
#pragma unroll
                        for (int e = 0; e < 8; ++e) { const float q = o[e] * (e < 4 ? k0[e] : k1[e - 4]); s += q * q; }
                        s = red8(s); if ((lane & 7) == 0) ((float*)(drow + DS_INV))[(mcol - RW) >> 6] = 1.0f / sqrtf(s + 1e-12f); } }
                else { const int c8 = (lane & 15) * 8;
                    if (sel == 0) {
#pragma unroll
                        for (int e = 0; e < 8; ++e) o[e] = ftanh(o[e]); }
                    if (sel == 2) {
#pragma unroll
                        for (int e = 0; e < 8; ++e) o[e] = fsigmoid(o[e]); }
                    v4u w; w.x = cvt_pk_bf16(o[0], o[1]); w.y = cvt_pk_bf16(o[2], o[3]); w.z = cvt_pk_bf16(o[4], o[5]); w.w = cvt_pk_bf16(o[6], o[7]);
                    if (sel == 3) w = (v4u){0u, 0u, 0u, 0u};
                    if (sel >= 2) *(v4u*)(SG + (size_t)tok * 256 + (sel - 2) * 128 + c8) = w; else *(v4u*)(drow + DS_TW + sel * 128 + c8) = w; } } } }
    }
    SEAM(4);
    if (IN(5)) { PHASE_BEGIN();
        { const int job = bx;
#ifdef P5_SKIP
            if (!(li == 1 && ((P5_SKIP == 1) == (job < NSEQ * NH * 2))))
#endif
            if (job < NSEQ * NH * 2) { const int seq = job / (NH * 2), h = (job >> 1) & (NH - 1), d = job & 1;
                RwkvP P{DS, SMALL, ARGIN(I_MU), ARGIN(I_W0), ARGIN(I_W2), ARGIN(I_A0), ARGIN(I_A2), ARGIN(I_KK), ARGIN(I_KA), ARGIN(I_RK), d ? YB : YF, BON
#ifdef TPROBE
                    , (float*)(ws + WS_CTL + 8192)
#endif
                };
#if RWKV_REF
                if (wave == 0) rwkv_ref_wave((LAS float*)lds, P, seq, h, d, lane);
                __syncthreads();
#else
#if RWKV_SEQ
                rwkv_chain(lds, P, seq, h, d, tid, lane, wave); __syncthreads();
#else
#ifdef C3_PROBE
                if (li == 1) rwkv_chain3(lds, P, seq, h, d, tid, lane, wave, C3_PROBE); else
#endif
                rwkv_chain3(lds, P, seq, h, d, tid, lane, wave, 0);
                __syncthreads();
#endif
#endif
            }
            else if (wave < 6) { const int j = (job - NSEQ * NH * 2) * 6 + wave;        const int seq = j / (S5G * 2), g = (j >> 1) & (S5G - 1), d = j & 1;
                S5Pm P{SMALL, ARGIN(I_SARE), ARGIN(I_SAIM), ARGIN(I_SLOG), ARGIN(I_SBRE), ARGIN(I_SBIM), ARGIN(I_SCRE), ARGIN(I_SCIM), d ? S5B : S5F};
#if S5_REF
                s5_ref_wave(P, seq, g, d, lane);
#else
                s5_wave(lds + wave * S5_WL, P, seq, g, d, lane);
#endif
            }
        }
    }
    if (IN(5) && bx >= NSEQ * NH * 2) {
        PHASE_BEGIN();
        __syncthreads();
            { const int gw2 = (bx - NSEQ * NH * 2) * NWAVES + wave, NGW2 = (G - NSEQ * NH * 2) * NWAVES;
              constexpr int I5 = (RW / 64) * (D / 32), I6 = (S5D / 64) * (D / 32), I7 = (D / 64) * (D / 32), I8 = (128 / 64) * (RW / 32), I9 = (S5D / 64) * (S5D / 32);
              for (int it = gw2; it < I5 + I6 + I7 + I8 + I9; it += NGW2) { int r = it;
                  if (r < I5) { transpose_item(ARGIN(I_PR), D, D, WPRS, RW + S5D, 0, scr, r, lane); continue; } r -= I5;
                  if (r < I6) { transpose_item(ARGIN(I_PS), D, D, WPRS + RW, RW + S5D, 0, scr, r, lane); continue; } r -= I6;
                  if (r < I7) { transpose_item(ARGIN(I_WO), D, D, WOUT, D, 0, scr, r, lane); continue; } r -= I7;
                  if (r < I8) { transpose_item(ARGIN(I_G2), RW, RW, G2T, 256, 0, scr, r, lane); continue; } r -= I8;
                  transpose_item(ARGIN(I_SWGLU), S5D, S5D, WGLU, S5D, 0, scr, r, lane); }
              const v4u z = (v4u){0u, 0u, 0u, 0u};
              for (int i = gw2 * 64 + lane; i < RW * 16; i += NGW2 * 64) *(v4u*)(G2T + (size_t)(i >> 4) * 256 + 128 + (i & 15) * 8) = z; }
            if (ECV) { constexpr int I0 = (D / 64) * (FF / 32); const int gw2 = (bx - NSEQ * NH * 2) * NWAVES + wave, NGW2 = (G - NSEQ * NH * 2) * NWAVES;
                for (int it = gw2; it < 2 * I0; it += NGW2) { if (it < I0) transpose_item(ARGIN(I_F2G), FF, FF, WGU2, D, 1, scr, it, lane); else transpose_item(ARGIN(I_F2U), FF, FF, WGU2, D, 2, scr, it - I0, lane); } }
    }
    SEAM(5);
    if (IN(6)) { PHASE_BEGIN();
        const int c0 = 16 * lane, h = lane >> 2;
        for (int tok = gw; tok < M; tok += NGW) { const int t = tok & (SEQL - 1);
            { const h16x8 f0 = *(const h16x8*)(YF + (size_t)tok * RW + c0), f1 = *(const h16x8*)(YF + (size_t)tok * RW + c0 + 8), b0 = *(const h16x8*)(YB + (size_t)tok * RW + c0), b1 = *(const h16x8*)(YB + (size_t)tok * RW + c0 + 8);
              float y[16]; float s = 0.f;
#pragma unroll
              for (int j = 0; j < 8; ++j) { y[j] = (float)f0[j] + (float)b0[j]; y[8 + j] = (float)f1[j] + (float)b1[j]; }
#pragma unroll
              for (int j = 0; j < 16; ++j) s += y[j];
              const float mean = red4(s) * (1.f / 64.f); float q = 0.f;
#pragma unroll
              for (int j = 0; j < 16; ++j) { y[j] -= mean; q += y[j] * y[j]; }
              const float rstd = 1.0f / sqrtf(red4(q) * (1.f / 64.f) + GN_EPS);
              const float bonus = BON[(size_t)tok * NH + h] + BON[((size_t)M + tok) * NH + h];
              float v0[8], v1[8]; ld8bf(DS + (size_t)tok * DSW + 2 * RW + c0, true, v0); ld8bf(DS + (size_t)tok * DSW + 2 * RW + c0 + 8, true, v1); (void)t;
              const float* lw = ARGIN(I_LNW) + c0; const float* lb = ARGIN(I_LNB) + c0; float o[16];
#pragma unroll
              for (int j = 0; j < 16; ++j) o[j] = y[j] * rstd * lw[j] + lb[j] + bonus * (j < 8 ? v0[j] : v1[j - 8]);
              v4u w0, w1; w0.x = cvt_pk_bf16(o[0], o[1]); w0.y = cvt_pk_bf16(o[2], o[3]); w0.z = cvt_pk_bf16(o[4], o[5]); w0.w = cvt_pk_bf16(o[6], o[7]);
              w1.x = cvt_pk_bf16(o[8], o[9]); w1.y = cvt_pk_bf16(o[10], o[11]); w1.z = cvt_pk_bf16(o[12], o[13]); w1.w = cvt_pk_bf16(o[14], o[15]);
              *(v4u*)(TB + (size_t)tok * RW + c0) = w0; *(v4u*)(TB + (size_t)tok * RW + c0 + 8) = w1; }
            { const int c = 8 * lane; const h16x8 pf = *(const h16x8*)(S5F + (size_t)tok * S5D + c), pb = *(const h16x8*)(S5B + (size_t)tok * S5D + c);
              float uu[8]; ld8bf(SMALL + (size_t)tok * SMW + SM_U + c, true, uu); const f32x4 d0 = *(const f32x4*)(ARGIN(I_SD) + c), d1 = *(const f32x4*)(ARGIN(I_SD) + c + 4); float o[8];
#pragma unroll
              for (int j = 0; j < 8; ++j) { const float yy = (float)pf[j] + (float)pb[j] + (j < 4 ? d0[j] : d1[j - 4]) * uu[j]; o[j] = 0.5f * yy * (1.0f + ftanh(0.7978845608028654f * (yy + 0.044715f * yy * yy * yy))); }
              v4u w; w.x = cvt_pk_bf16(o[0], o[1]); w.y = cvt_pk_bf16(o[2], o[3]); w.z = cvt_pk_bf16(o[4], o[5]); w.w = cvt_pk_bf16(o[6], o[7]);
              *(v4u*)(YS0 + (size_t)tok * S5D + c) = w; }
        }
    }
    SEAM(6);
    if (IN(7)) { PHASE_BEGIN();
        { pg8::Gemm g{XN, WING, M, NGATE, D, 0}; pg8::StaticOrder S; S.init(M, NGATE, G, bx);
          pg8::EpiBf<1> E{GATES, NGATE, nullptr, 0, 0, nullptr, 0, nullptr, 0, 0, nullptr, SS1};
          pg8::gemm_phase<pg8::EpiBf<1>, pg8::StaticOrder, true, true>(lds, g, S, E); }
        __syncthreads();
        { pg8::Gemm g{SG, G2T, M, RW, 256, 0}; pg8::StaticOrder S; S.init(M, RW, G, bx); pg8::EpiBf<2> E{YRS, RW + S5D, nullptr, 0, 0, TB, RW, nullptr, 0, 0, nullptr, nullptr};
          pg8::gemm_phase<pg8::EpiBf<2>, pg8::StaticOrder, true, true>(lds, g, S, E); }
        __syncthreads();
        { pg8::Gemm g{YS0, WGLU, M, S5D, S5D, 0}; pg8::StaticOrder S; S.init(M, S5D, G, bx); pg8::EpiBf<3> E{YRS + RW, RW + S5D, nullptr, 0, 0, YS0, S5D, nullptr, 0, 0, ARGIN(I_SBGLU), nullptr};
          pg8::gemm_phase<pg8::EpiBf<3>, pg8::StaticOrder, true, true>(lds, g, S, E); }
    }
    SEAM(7);
    if (IN(9)) { PHASE_BEGIN();
        { pg8::Gemm g{YRS, WPRS, M, D, RW + S5D, 0}; pg8::PanelOrder S; S.init(M, D, G, bx); pg8::EpiMerge E{GATES, NGATE, D, RW / 64};
          pg8::gemm_phase<pg8::EpiMerge, pg8::PanelOrder, true, true>(lds, g, S, E); }
    }
    SEAM(9);
    if (IN(10)) { PHASE_BEGIN(); pg8::Gemm g{GATES, WOUT, M, D, D, NGATE}; pg8::PanelOrder S; S.init(M, D, G, bx);
        pg8::EpiRes2<1, 0> E{nullptr, nullptr, 0, XN, ARGIN(I_NMIX), XN, ARGIN(I_NF2), nullptr, D, 1.0f, SS2};
        pg8::gemm_phase<pg8::EpiRes2<1, 0>, pg8::PanelOrder, true, true>(lds, g, S, E); }
    SEAM(10);
    if (!ECV) {
    if (IN(11)) { PHASE_BEGIN();
        constexpr int I0 = (D / 64) * (FF / 32);
        for (int it = gw; it < 2 * I0; it += NGW) { if (it < I0) transpose_item(ARGIN(I_F2G), FF, FF, WGU, D, 1, scr, it, lane); else transpose_item(ARGIN(I_F2U), FF, FF, WGU, D, 2, scr, it - I0, lane); }
    }
    SEAM(11);
    }
    if (IN(12)) { PHASE_BEGIN(); pg8::Gemm g{XN, ECV ? WGU2 : WGU, M, NGU, D, 0}; pg8::StaticOrder S; S.init(M, NGU, G, bx); pg8::EpiSwiGLU E{HB, FF, SS2, FF / 64};
        pg8::gemm_phase<pg8::EpiSwiGLU, pg8::StaticOrder, true, true>(lds, g, S, E);
        { const int nfull = (M / 256) * (NGU / 256) / G;
          if (nfull * G + bx >= (M / 256) * (NGU / 256)) { const int ntail = (M / 256) * (NGU / 256) - nfull * G, gw2 = (bx - ntail) * NWAVES + wave, NGW2 = (G - ntail) * NWAVES;
            constexpr int I2 = (FF / 64) * (D / 32);
            for (int it = gw2; it < I2; it += NGW2) transpose_item(ARGIN(I_F2D), D, D, WDN, FF, 0, scr, it, lane); } }
    }
    SEAM(12);
    if (IN(13)) { PHASE_BEGIN(); pg8::Gemm g{HB, WDN, M, D, FF, 0, 1}; pg8::PanelOrder S; S.init(M, D, G, bx); S.rev = 1;
        pg8::EpiRes2<1, 0> E{nullptr, nullptr, 0, XN, ARGIN(I_NF2), XN, ARGIN(I_NFIN), nullptr, D, 0.5f, SS3};
        pg8::gemm_phase<pg8::EpiRes2<1, 0>, pg8::PanelOrder, true, true>(lds, g, S, E); }
    SEAM(13);
    if (IN(14)) { PHASE_BEGIN(); scale_rows(XN, SS3, X, gw, NGW, lane); }
#undef IN
#undef SEAM
}


#ifndef MK_CHECK
#define MK_CHECK 0
#endif
#if MK_CHECK
constexpr int CK_R = 512, CK_C = 128, CW_ERR = 16;
constexpr size_t CK_EXP = 512 * 1024;
__device__ __forceinline__ int ck_row(int i) { return i < 8 ? (i == 0 ? 0 : i == 1 ? 255 : i == 2 ? 256 : i == 3 ? 8191 : i == 4 ? 8192 : i == 5 ? M - 1 : i == 6 ? 4095 : 4096) : (int)(((long)i * 9973 + 131) % M); }
__device__ __forceinline__ int ck_col(int j, int N) { return j == 0 ? 0 : j == 1 ? N - 1 : (int)(((long)j * 7919 + 17) % N); }
__device__ __forceinline__ float dotbb(const bf16* a, const bf16* b, int K) { float s = 0.f; for (int k = 0; k < K; ++k) s += bf2f(a[k]) * bf2f(b[k]); return s; }
__device__ __forceinline__ float rbf(float x) { return bf2f((bf16)f2bf(x)); }
#ifndef CK_WATCH
#define CK_WATCH 80
#endif
#ifndef CK_SEL
#define CK_SEL 0
#endif
__device__ int ck_m, ck_n;
__device__ __forceinline__ void ck_fail_at(unsigned* ctl, int stage, float got, float exp, float tolr, float tola, int m, int n) {
    if (!(fabsf(got - exp) <= tolr * fabsf(exp) + tola)) { atomicMin(&ctl[CW_ERR], (unsigned)stage);
        if (stage == CK_WATCH) { atomicAdd(&ctl[32], 1u); if (!(got >= 0.f && got <= 1.f)) atomicAdd(&ctl[41], 1u); atomicMin(&ctl[33], (unsigned)(m >> 8)); atomicMax(&ctl[34], (unsigned)(m >> 8)); atomicMin(&ctl[35], (unsigned)(n >> 8)); atomicMax(&ctl[36], (unsigned)(n >> 8));
            atomicMin(&ctl[37], (unsigned)(m & 255)); atomicMax(&ctl[38], (unsigned)(m & 255)); atomicMin(&ctl[39], (unsigned)(n & 255)); atomicMax(&ctl[40], (unsigned)(n & 255)); } } }
#define ck_fail(ctl, stage, got, exp, tolr, tola) ck_fail_at(ctl, stage, got, exp, tolr, tola, m, (int)(j))
__device__ __forceinline__ float sigm(float x) { return 1.0f / (1.0f + expf(-x)); }
__global__ void hyb_chk(Args a, int stage, int pre) {
    unsigned char* ws = a.ws; unsigned* ctl = (unsigned*)(ws + WS_CTL); float* EXP = (float*)(ws + CK_EXP); float* X = a.out;
    const int i = blockIdx.x, m = ck_row(i);
    const float* xin = m < MP ? a.in[I_XP] + (size_t)m * D : a.in[I_XS] + (size_t)(m - MP) * D;
    for (int j = threadIdx.x; j < CK_C; j += blockDim.x) {
        if (stage == 1 || stage == 12) {
            const float* g = stage == 1 ? a.in[I_NF1] : a.in[I_NF2]; const float* xr = stage == 1 ? xin : X + (size_t)m * D; const int n = ck_col(j, D);
            float ss = 0.f; for (int k = 0; k < D; ++k) ss += xr[k] * xr[k]; const float e = xr[n] / sqrtf(ss / D + RMS_EPS) * g[n];
            ck_fail(ctl, stage * 10 + 0, bf2f(XN[(size_t)m * D + n]), e, 0.01f, 0.01f);
            const float* wg = a.in[stage == 1 ? I_F1G : I_F2G]; const float* wu = a.in[stage == 1 ? I_F1U : I_F2U]; const float* wd = a.in[stage == 1 ? I_F1D : I_F2D];
            { const int k = m % D, c = ck_col(j, FF); ck_fail(ctl, stage * 10 + 1, bf2f(WGU[(size_t)((c >> 7) * 256 + (c & 127)) * D + k]), wg[(size_t)k * FF + c], 0.005f, 1e-6f);
              ck_fail(ctl, stage * 10 + 2, bf2f(WGU[(size_t)((c >> 7) * 256 + 128 + (c & 127)) * D + k]), wu[(size_t)k * FF + c], 0.005f, 1e-6f); }
            { const int k = m % FF, c = ck_col(j, D); ck_fail(ctl, stage * 10 + 3, bf2f(WDN[(size_t)c * FF + k]), wd[(size_t)k * D + c], 0.005f, 1e-6f); }
            if (stage == 1) { const int k = m % D; { const int c = ck_col(j, 4096); ck_fail(ctl, 14, bf2f(WINA[(size_t)c * D + k]), c < NA ? a.in[I_WIN][(size_t)k * INC + c] : 0.f, 0.005f, 1e-6f);
                ck_fail(ctl, 15, bf2f(WING[(size_t)c * D + k]), a.in[I_WIN][(size_t)k * INC + NA + c], 0.005f, 1e-6f); }
              { const int c = ck_col(j, D); ck_fail(ctl, 16, bf2f(WPR[(size_t)c * RW + (k % RW)]), a.in[I_PR][(size_t)(k % RW) * D + c], 0.005f, 1e-6f);
                ck_fail(ctl, 17, bf2f(WPS[(size_t)c * S5D + (k % S5D)]), a.in[I_PS][(size_t)(k % S5D) * D + c], 0.005f, 1e-6f);
                ck_fail(ctl, 18, bf2f(WOUT[(size_t)c * D + k]), a.in[I_WO][(size_t)k * D + c], 0.005f, 1e-6f); }
              { const int c = ck_col(j, RW), kk = k % 256; ck_fail(ctl, 19, bf2f(G2T[(size_t)c * 256 + kk]), kk < 128 ? a.in[I_G2][(size_t)kk * RW + c] : 0.f, 0.005f, 1e-6f); }
              { const int c = ck_col(j, S5D), kk = k % S5D; ck_fail(ctl, 19, bf2f(WGLU[(size_t)c * S5D + kk]), a.in[I_SWGLU][(size_t)kk * S5D + c], 0.005f, 1e-6f); } }
        }
        if (stage == 2 || stage == 13) { const int c = ck_col(j, FF); const bf16* xr = XN + (size_t)m * D;
            const float gg = dotbb(xr, WGU + (size_t)((c >> 7) * 256 + (c & 127)) * D, D), uu = dotbb(xr, WGU + (size_t)((c >> 7) * 256 + 128 + (c & 127)) * D, D);
            ck_fail(ctl, stage * 10, bf2f(HB[(size_t)m * FF + c]), gg * sigm(gg) * uu, 0.02f, 0.01f); }
        if (stage == 3) { const int n = ck_col(j, D); ck_fail(ctl, 30, X[(size_t)m * D + n], xin[n] + 0.5f * dotbb(HB + (size_t)m * FF, WDN + (size_t)n * FF, FF), 0.005f, 0.005f); }
        if (stage == 4) { const int n = ck_col(j, D); const float* xr = X + (size_t)m * D; float ss = 0.f; for (int k = 0; k < D; ++k) ss += xr[k] * xr[k];
            ck_fail(ctl, 40, bf2f(XN[(size_t)m * D + n]), xr[n] / sqrtf(ss / D + RMS_EPS) * a.in[I_NMIX][n], 0.01f, 0.01f); }
        if (stage == 5) { const int n = ck_col(j, 4096); const float e = dotbb(XN + (size_t)m * D, WINA + (size_t)n * D, D);
            const float got = n < RKW ? bf2f(RKV[(size_t)m * RKW + n]) : bf2f(SMALL[(size_t)m * SMW + n - RKW]); ck_fail(ctl, 50, got, e, 0.01f, 0.01f); }
        if (stage == 7) { const int n = ck_col(j, 128); const int t = m & (SEQL - 1);
            const float c = bf2f(SMALL[(size_t)m * SMW + SM_GLOW + n]), pv = t > 0 ? bf2f(SMALL[(size_t)(m - 1) * SMW + SM_GLOW + n]) : 0.f, nx = t < SEQL - 1 ? bf2f(SMALL[(size_t)(m + 1) * SMW + SM_GLOW + n]) : 0.f;
            ck_fail(ctl, 70, bf2f(SG[(size_t)m * 256 + n]), sigm(c + (0.5f * (pv + nx) - c) * a.in[I_MU][MU_GLOW + n]), 0.01f, 0.005f);
            ck_fail(ctl, 71, bf2f(SG[(size_t)m * 256 + 128 + n]), 0.f, 0.f, 0.f); }
        if (stage == 8) { const int n = ck_col(j, NGATE); const float e = sigm(dotbb(XN + (size_t)m * D, WING + (size_t)n * D, D));
            if (pre) EXP[i * CK_C + j] = e; else { ck_fail_at(ctl, 89, bf2f(GATES[(size_t)m * NGATE + n]), EXP[i * CK_C + j], 0.01f, 0.005f, m, n); ck_fail(ctl, 85, e, EXP[i * CK_C + j], 0.001f, 0.0001f);
                const int k = (m * 7 + j) % D; ck_fail(ctl, 86, bf2f(WING[(size_t)n * D + k]), a.in[I_WIN][(size_t)k * INC + NA + n], 0.005f, 1e-6f);
                const float* xr = X + (size_t)m * D; float ss = 0.f; for (int q = 0; q < D; ++q) ss += xr[q] * xr[q]; const int nn = ck_col(j, D);
                ck_fail(ctl, 87, bf2f(XN[(size_t)m * D + nn]), xr[nn] / sqrtf(ss / D + RMS_EPS) * a.in[I_NMIX][nn], 0.01f, 0.01f); } }
        if (stage == 9) { { const int n = ck_col(j, RW); ck_fail(ctl, 90, bf2f(YR[(size_t)m * RW + n]), dotbb(SG + (size_t)m * 256, G2T + (size_t)n * 256, 256) * bf2f(TB[(size_t)m * RW + n]), 0.02f, 0.01f); }
            { const int n = ck_col(j, S5D); const float y0 = bf2f(YS0[(size_t)m * S5D + n]); ck_fail(ctl, 91, bf2f(YS[(size_t)m * S5D + n]), sigm(dotbb(YS0 + (size_t)m * S5D, WGLU + (size_t)n * S5D, S5D) + a.in[I_SBGLU][n]) * y0, 0.02f, 0.01f); } }
        if (stage == 10) { const int n = ck_col(j, D); const float t1 = rbf(bf2f(GATES[(size_t)m * NGATE + n]) * dotbb(YR + (size_t)m * RW, WPR + (size_t)n * RW, RW));
            ck_fail(ctl, 100, bf2f(MRG[(size_t)m * D + n]), t1 + bf2f(GATES[(size_t)m * NGATE + D + n]) * dotbb(YS + (size_t)m * S5D, WPS + (size_t)n * S5D, S5D), 0.02f, 0.01f); }
        if (stage == 11 || stage == 14) { const int n = ck_col(j, D);
            if (pre) EXP[i * CK_C + j] = X[(size_t)m * D + n] + (stage == 11 ? dotbb(MRG + (size_t)m * D, WOUT + (size_t)n * D, D) : 0.5f * dotbb(HB + (size_t)m * FF, WDN + (size_t)n * FF, FF));
            else ck_fail(ctl, stage * 10, X[(size_t)m * D + n], EXP[i * CK_C + j], 0.005f, 0.005f); }
        if (stage == 15) { const int n = ck_col(j, D); const float* xr = X + (size_t)m * D;
            if (pre) { float ss = 0.f; for (int k = 0; k < D; ++k) ss += xr[k] * xr[k]; EXP[i * CK_C + j] = xr[n] / sqrtf(ss / D + RMS_EPS) * a.in[I_NFIN][n]; }
            else ck_fail(ctl, 150, xr[n], EXP[i * CK_C + j], 0.001f, 0.001f); }
    }
}
__global__ void hyb_chk_report(Args a) { unsigned* ctl = (unsigned*)(a.ws + WS_CTL); const unsigned e = ctl[CW_ERR]; if (e == 0xffffffffu) return;
    unsigned va, vb;
    if (CK_SEL == 0) { va = 0; vb = e; }
    else if (CK_SEL == 1) { va = ctl[33] + 1; vb = ctl[34] + 1; }
    else if (CK_SEL == 2) { va = ctl[35] + 1; vb = ctl[36] + 1; }
    else if (CK_SEL == 3) { va = (ctl[37] >> 2) + 1; vb = (ctl[38] >> 2) + 1; }
    else if (CK_SEL == 4) { va = (ctl[39] >> 2) + 1; vb = (ctl[40] >> 2) + 1; }
    else if (CK_SEL == 5) { const unsigned c = ctl[32]; va = 1; vb = c > 99 ? 99 : c; }
    else { const unsigned c = ctl[32], o = ctl[41]; va = 1 + (98u * o) / (c ? c : 1u); vb = 1 + c / 1000u; }
    const size_t i = (size_t)blockIdx.x * blockDim.x + threadIdx.x;
    if (va && i < 4000000) a.out[i] = (float)va * 10.0f;
    if (i == 0) a.out[(size_t)MP * D + 12345] = (float)vb * 1000.0f; }
__global__ void hyb_chk_init(Args a) { unsigned* ctl = (unsigned*)(a.ws + WS_CTL); if (threadIdx.x == 0) { ctl[CW_ERR] = 0xffffffffu; ctl[33] = 0xffffffffu; ctl[35] = 0xffffffffu; ctl[37] = 0xffffffffu; ctl[39] = 0xffffffffu; } }
#endif

#ifdef TPROBE
__global__ void hyb_tp_report(Args a) { const float* tp = (const float*)(a.ws + WS_CTL + 8192); const size_t i = (size_t)blockIdx.x * blockDim.x + threadIdx.x; if (i == 0) a.out[0] = rintf(tp[0] * 0.2f) * 500.f; if (i < 3355443) a.out[(size_t)MP * D + i] = rintf(tp[1] * 0.2f) * 5.f; }
#endif
extern "C" void kernel_launch(void* const* d_in, const int* in_sizes, int n_in, void* d_out, int out_size, void* d_ws, size_t ws_size, hipStream_t stream) {
    static int grid = 0;
    if (grid == 0) {
        if (n_in != 37 || in_sizes[0] != MP * D || out_size != M * D || ws_size < WS_END) { fprintf(stderr, "kernel_launch: unexpected problem (n_in %d, in0 %d, out %d, ws %zu, need %zu); nothing launched\n", n_in, n_in > 0 ? in_sizes[0] : -1, out_size, ws_size, (size_t)WS_END); grid = -1; return; }
        int dev = 0, cus = 0, per_cu = 0;
        if (hipGetDevice(&dev) != hipSuccess || hipDeviceGetAttribute(&cus, hipDeviceAttributeMultiprocessorCount, dev) != hipSuccess) { grid = -1; return; }
        if (hipFuncSetAttribute((const void*)hyb_fwd, hipFuncAttributeMaxDynamicSharedMemorySize, LDS_BYTES) != hipSuccess) { fprintf(stderr, "kernel_launch: hipFuncSetAttribute failed\n"); grid = -1; return; }
        if (hipOccupancyMaxActiveBlocksPerMultiprocessor(&per_cu, (const void*)hyb_fwd, NWAVES * 64, LDS_BYTES) != hipSuccess || per_cu < 1) fprintf(stderr, "kernel_launch: occupancy query reports %d\n", per_cu);
        (void)hipGetLastError();
        grid = cus;
        if (grid != 256) { fprintf(stderr, "kernel_launch: needs exactly 256 CUs (got %d); nothing launched\n", grid); grid = -1; return; }
        fprintf(stderr, "kernel_launch: grid %d, ws %zu\n", grid, ws_size);
    }
    if (grid < 0) return;
    if (hipMemsetAsync((char*)d_ws + WS_CTL, 0, CTL_ZERO_BYTES, stream) != hipSuccess) return;
    Args a{};
    for (int i = 0; i < 37; ++i) a.in[i] = (const float*)d_in[i];
    a.out = (float*)d_out; a.ws = (unsigned char*)d_ws; a.pad = ws_size >= WS_END2 ? 1 : 0;
#if MK_SPLIT
#if MK_CHECK
    hipLaunchKernelGGL(hyb_chk_init, dim3(1), dim3(64), 0, stream, a);
#endif
    for (int p = 0; p < N_PHASES; ++p) { a.ph_lo = p; a.ph_hi = p + 1;
#if MK_CHECK
        if (p == 7 || p == 10 || p == 13 || p == 14) hipLaunchKernelGGL(hyb_chk, dim3(CK_R), dim3(128), 0, stream, a, p + 1, 1);
#endif
        hipLaunchKernelGGL(hyb_fwd, dim3(grid), dim3(NWAVES * 64), LDS_BYTES, stream, a);
#if MK_CHECK
        if (p != 5) hipLaunchKernelGGL(hyb_chk, dim3(CK_R), dim3(128), 0, stream, a, p + 1, 0);
#endif
    }
#if MK_CHECK
    hipLaunchKernelGGL(hyb_chk_report, dim3(4000000 / 256), dim3(256), 0, stream, a);
#endif
#else
#ifdef DUP_PHASE
    a.ph_lo = 0; a.ph_hi = DUP_PHASE + 1; a.li = 0; hipLaunchKernelGGL(hyb_fwd, dim3(grid), dim3(NWAVES * 64), LDS_BYTES, stream, a);
    a.ph_lo = DUP_PHASE; a.ph_hi = N_PHASES; a.li = 1; hipLaunchKernelGGL(hyb_fwd, dim3(grid), dim3(NWAVES * 64), LDS_BYTES, stream, a);
#else
    a.ph_lo = 0; a.ph_hi = N_PHASES; hipLaunchKernelGGL(hyb_fwd, dim3(grid), dim3(NWAVES * 64), LDS_BYTES, stream, a);
#ifdef TPROBE
    hipLaunchKernelGGL(hyb_tp_report, dim3(13108), dim3(256), 0, stream, a);
#endif
#endif
#endif
}
```
